# Optimizing an MI355X kernel written in HIP

```python
import math
import jax, jax.numpy as jnp
from jax import lax
import numpy as np

D_MODEL = 1024
BATCH = 2
SEQ = 16384
DEPTH = 1

N_Q_HEADS = 8
N_KV_HEADS = 2
HEAD_DIM = 64
ATTN_WIDTH = N_Q_HEADS * HEAD_DIM
WINDOW = 128
BLOCK = 128
CONV_WIDTH = D_MODEL - ATTN_WIDTH
CONV_K = 3
QKV_COLS = (N_Q_HEADS + 2 * N_KV_HEADS) * HEAD_DIM
IN_COLS = QKV_COLS + 3 * CONV_WIDTH
N_EXPERTS = 32
TOP_K = 4
D_FF = D_MODEL
SWIGLU_ALPHA = 1.702
SWIGLU_LIMIT = 7.0
MOE_BLOCK = 128
EPS = 1e-5

kernel_name = "hymba_conv_swa_sink_alibi_moe"


def rmsnorm(x, g):
    x32 = x.astype(jnp.float32)
    y = x32 * lax.rsqrt(jnp.mean(x32 * x32, axis=-1, keepdims=True) + EPS)
    return (y * g.astype(jnp.float32)).astype(x.dtype)


def alibi_slopes(n_heads):
    return jnp.exp2(-8.0 * jnp.arange(1, n_heads + 1, dtype=jnp.float32) / n_heads)


def sliding_window_attention(q, k, v, sinks):
    bsz, s_len = q.shape[0], q.shape[1]
    nb = s_len // BLOCK
    grp = N_Q_HEADS // N_KV_HEADS
    qb = q.reshape(bsz, nb, BLOCK, N_KV_HEADS, grp, HEAD_DIM)
    kb = k.reshape(bsz, nb, BLOCK, N_KV_HEADS, HEAD_DIM)
    vb = v.reshape(bsz, nb, BLOCK, N_KV_HEADS, HEAD_DIM)

    def band(t):
        prev = jnp.concatenate([jnp.zeros_like(t[:, :1]), t[:, :-1]], axis=1)
        return jnp.concatenate([prev, t], axis=2)

    kband, vband = band(kb), band(vb)
    scale = 1.0 / math.sqrt(HEAD_DIM)
    s = jnp.einsum('bnqhgd,bnshd->bnhgqs', qb, kband,
                   preferred_element_type=jnp.float32) * scale

    qi = jnp.arange(BLOCK)[:, None]
    kj = jnp.arange(2 * BLOCK)[None, :]
    dist = qi + BLOCK - kj
    kpos = jnp.arange(nb)[:, None, None] * BLOCK + kj[None] - BLOCK
    valid = (dist >= 0) & (dist < WINDOW) & (kpos >= 0)

    slopes = alibi_slopes(N_Q_HEADS).reshape(N_KV_HEADS, grp)
    s = s - slopes[:, :, None, None] * dist.astype(jnp.float32)
    s = jnp.where(valid[None, :, None, None], s, -jnp.inf)

    sink = sinks.astype(jnp.float32).reshape(N_KV_HEADS, grp)[None, None, :, :, None, None]
    sink = jnp.broadcast_to(sink, s.shape[:-1] + (1,))
    p = jax.nn.softmax(jnp.concatenate([s, sink], axis=-1), axis=-1)[..., :-1]
    o = jnp.einsum('bnhgqs,bnshd->bnqhgd', p.astype(v.dtype), vband)
    return o.reshape(bsz, s_len, ATTN_WIDTH)


def short_conv(b_gate, c_gate, x_in, conv_w):
    u = c_gate * x_in
    s_len = u.shape[1]
    u_pad = jnp.pad(u, ((0, 0), (CONV_K - 1, 0), (0, 0)))
    y = (conv_w[0] * u_pad[:, 0:s_len]
         + conv_w[1] * u_pad[:, 1:s_len + 1]
         + conv_w[2] * u_pad[:, 2:s_len + 2])
    return b_gate * y


def clamped_swiglu(hu):
    x_glu, x_lin = hu[..., :D_FF], hu[..., D_FF:]
    x_glu = jnp.minimum(x_glu, SWIGLU_LIMIT)
    x_lin = jnp.clip(x_lin, -SWIGLU_LIMIT, SWIGLU_LIMIT)
    return x_glu * jax.nn.sigmoid(SWIGLU_ALPHA * x_glu) * (x_lin + 1.0)


def moe(h, w_router, b_router, w1, b1, w2, b2):
    bsz, s_len, d = h.shape
    n_tok = bsz * s_len
    xt = h.reshape(n_tok, d)
    logits = (xt @ w_router + b_router).astype(jnp.float32)
    top_val, top_idx = lax.top_k(logits, TOP_K)
    gates = jax.nn.softmax(top_val, axis=-1).astype(h.dtype)

    nk = n_tok * TOP_K
    e_flat = top_idx.reshape(nk)
    tok_flat = jnp.arange(nk, dtype=jnp.int32) // TOP_K
    g_flat = gates.reshape(nk)
    order = jnp.argsort(e_flat)
    e_sorted, tok_sorted, g_sorted = e_flat[order], tok_flat[order], g_flat[order]

    counts = jnp.bincount(e_flat, length=N_EXPERTS)
    padded = (counts + MOE_BLOCK - 1) // MOE_BLOCK * MOE_BLOCK
    starts = jnp.cumsum(counts) - counts
    pstarts = jnp.cumsum(padded) - padded
    pends = pstarts + padded
    dest = pstarts[e_sorted] + (jnp.arange(nk, dtype=jnp.int32) - starts[e_sorted])

    n_rows = (nk + MOE_BLOCK - 1) // MOE_BLOCK * MOE_BLOCK + N_EXPERTS * MOE_BLOCK
    n_blocks = n_rows // MOE_BLOCK
    row_tok = jnp.full((n_rows,), n_tok, jnp.int32).at[dest].set(tok_sorted)
    row_gate = jnp.zeros((n_rows,), h.dtype).at[dest].set(g_sorted)
    blk_start = jnp.arange(n_blocks, dtype=jnp.int32) * MOE_BLOCK
    blk_expert = jnp.minimum(jnp.searchsorted(pends, blk_start, side='right'), N_EXPERTS - 1)

    x_pad = jnp.concatenate([xt, jnp.zeros((1, d), xt.dtype)], axis=0)
    x_rows = x_pad[row_tok].reshape(n_blocks, MOE_BLOCK, d)

    def expert_block(args):
        xb, e = args
        act = clamped_swiglu(xb @ w1[e] + b1[e])
        return act @ w2[e] + b2[e]

    y_rows = lax.map(expert_block, (x_rows, blk_expert)).reshape(n_rows, d)
    out = jax.ops.segment_sum(y_rows * row_gate[:, None], row_tok, num_segments=n_tok + 1)[:n_tok]
    return out.reshape(bsz, s_len, d)


def setup_inputs(seed: int = 0) -> dict:
    key = jax.random.key(seed)
    ks = jax.random.split(key, 16)
    f32 = jnp.float32
    nrm = lambda k, shape, scale: jax.random.normal(k, shape, f32) * scale
    return {
        'x': nrm(ks[0], (BATCH, SEQ, D_MODEL), 1.0),
        'g_mix': 1.0 + nrm(ks[1], (DEPTH, D_MODEL), 0.02),
        'w_in': nrm(ks[2], (DEPTH, D_MODEL, IN_COLS), D_MODEL ** -0.5),
        'conv_w': nrm(ks[3], (DEPTH, CONV_K, CONV_WIDTH), CONV_K ** -0.5),
        'sinks': nrm(ks[4], (DEPTH, N_Q_HEADS), 0.5),
        'g_attn_out': 1.0 + nrm(ks[5], (DEPTH, ATTN_WIDTH), 0.02),
        'g_conv_out': 1.0 + nrm(ks[6], (DEPTH, CONV_WIDTH), 0.02),
        'w_out': nrm(ks[7], (DEPTH, D_MODEL, D_MODEL), D_MODEL ** -0.5),
        'g_ffn': 1.0 + nrm(ks[8], (DEPTH, D_MODEL), 0.02),
        'w_router': nrm(ks[9], (DEPTH, D_MODEL, N_EXPERTS), D_MODEL ** -0.5),
        'b_router': nrm(ks[10], (DEPTH, N_EXPERTS), 0.01),
        'w1': nrm(ks[11], (DEPTH, N_EXPERTS, D_MODEL, 2 * D_FF), D_MODEL ** -0.5),
        'b1': nrm(ks[12], (DEPTH, N_EXPERTS, 2 * D_FF), 0.02),
        'w2': nrm(ks[13], (DEPTH, N_EXPERTS, D_FF, D_MODEL), D_FF ** -0.5),
        'b2': nrm(ks[14], (DEPTH, N_EXPERTS, D_MODEL), 0.02),
        'g_final': 1.0 + nrm(ks[15], (D_MODEL,), 0.02),
    }


def reference(x, g_mix, w_in, conv_w, sinks, g_attn_out, g_conv_out, w_out,
              g_ffn, w_router, b_router, w1, b1, w2, b2, g_final):
    bsz, s_len, _ = x.shape
    split_at = [ATTN_WIDTH, ATTN_WIDTH + N_KV_HEADS * HEAD_DIM, QKV_COLS,
                QKV_COLS + CONV_WIDTH, QKV_COLS + 2 * CONV_WIDTH]
    for l in range(DEPTH):
        h = rmsnorm(x, g_mix[l])
        p = h @ w_in[l]
        q, k, v, b_gate, c_gate, x_in = jnp.split(p, split_at, axis=-1)
        q = q.reshape(bsz, s_len, N_Q_HEADS, HEAD_DIM)
        k = k.reshape(bsz, s_len, N_KV_HEADS, HEAD_DIM)
        v = v.reshape(bsz, s_len, N_KV_HEADS, HEAD_DIM)
        attn = sliding_window_attention(q, k, v, sinks[l])
        conv = short_conv(b_gate, c_gate, x_in, conv_w[l])
        mix = jnp.concatenate([rmsnorm(attn, g_attn_out[l]),
                               rmsnorm(conv, g_conv_out[l])], axis=-1)
        x = x + mix @ w_out[l]
        h = rmsnorm(x, g_ffn[l])
        x = x + moe(h, w_router[l], b_router[l], w1[l], b1[l], w2[l], b2[l])
    return rmsnorm(x, g_final)
```

```cpp
#include <hip/hip_runtime.h>
#include <cstdint>
#include <cstdio>

typedef unsigned short bf16_t;
typedef short bf16x8 __attribute__((ext_vector_type(8)));
typedef float f32x4 __attribute__((ext_vector_type(4)));

constexpr int BATCH = 2, SEQ = 16384, DM = 1024, NTOK = BATCH * SEQ;
constexpr int NQH = 8, HD = 64, ATTW = 512, CONVW = 512, INC = 2304;
constexpr int NE = 32, DFF = 1024;
constexpr int MAXTILES = 544, PADROWS = MAXTILES * 256;
constexpr float EPS = 1e-5f;
constexpr float LOG2E = 1.4426950408889634f;
constexpr float C2 = 0.125f * LOG2E;

constexpr size_t MiB = 1u << 20;
constexpr size_t WS_CTL = 0, CTL_BYTES = 64 * 1024;
constexpr size_t WS_WIN = 1 * MiB, WS_WOUT = 6 * MiB, WS_WR = 8 * MiB, WS_LIST = 9 * MiB;
constexpr size_t WS_TE = 13 * MiB, WS_TP = 13 * MiB + 512 * 1024, WS_TG = 14 * MiB, WS_TAB = 14 * MiB + 512 * 1024;
constexpr size_t WS_W1 = 16 * MiB, WS_W2 = 144 * MiB, WS_XN = 208 * MiB, WS_P = 272 * MiB, WS_MIX = 416 * MiB;
constexpr size_t WS_ACT = 272 * MiB, WS_Y = 544 * MiB, WS_ATT = 816 * MiB, WS_END = 880 * MiB;
constexpr int CW_CNT = 0;

__device__ __forceinline__ float bf2f(bf16_t v) { return __uint_as_float((unsigned)v << 16); }
__device__ __forceinline__ bf16_t f2bf(float f) { unsigned u = __float_as_uint(f); return (bf16_t)((u + 0x7fffu + ((u >> 16) & 1u)) >> 16); }

__device__ __forceinline__ float wave_sum(float v) {
#pragma unroll
    for (int o = 1; o < 64; o <<= 1) v += __shfl_xor(v, o);
    return v;
}
__device__ __forceinline__ float wave_max(float v) {
#pragma unroll
    for (int o = 1; o < 64; o <<= 1) v = fmaxf(v, __shfl_xor(v, o));
    return v;
}
__device__ __forceinline__ float block_sum256(float v, float* red) {
    v = wave_sum(v);
    __syncthreads();
    if ((threadIdx.x & 63) == 0) red[threadIdx.x >> 6] = v;
    __syncthreads();
    return red[0] + red[1] + red[2] + red[3];
}

__global__ void n_transpose(const float* W, bf16_t* WT, int K, int N, const float* g) {
    __shared__ float tile[32][33];
    const size_t zoff = (size_t)blockIdx.z * K * N;
    const int k0 = blockIdx.x * 32, n0 = blockIdx.y * 32, tx = threadIdx.x, ty = threadIdx.y;
#pragma unroll
    for (int i = 0; i < 4; ++i) { const int kk = ty + 8 * i; tile[kk][tx] = W[zoff + (size_t)(k0 + kk) * N + n0 + tx] * (g ? g[k0 + kk] : 1.f); }
    __syncthreads();
#pragma unroll
    for (int i = 0; i < 4; ++i) { const int nn = ty + 8 * i; WT[zoff + (size_t)(n0 + nn) * K + k0 + tx] = f2bf(tile[tx][nn]); }
}
__global__ void n_wr(const float* wr, const float* g, float* out) {
    const int i = blockIdx.x * 256 + threadIdx.x; if (i < DM * NE) out[i] = wr[i] * g[i >> 5];
}
__global__ void n_gcat(const float* ga, const float* gc, float* out) { const int i = blockIdx.x * 256 + threadIdx.x; if (i < DM) out[i] = i < 512 ? ga[i] : gc[i - 512]; }
__global__ __launch_bounds__(256) void n_xn(const float* x, bf16_t* XN) {
    __shared__ float red[4];
    const int row = blockIdx.x, t = threadIdx.x;
    const f32x4 v = *(const f32x4*)(x + (size_t)row * DM + 4 * t);
    const float ss = block_sum256(v.x * v.x + v.y * v.y + v.z * v.z + v.w * v.w, red);
    const float rstd = rsqrtf(ss * (1.f / DM) + EPS);
    bf16_t* o = XN + (size_t)row * DM + 4 * t;
    o[0] = f2bf(v.x * rstd); o[1] = f2bf(v.y * rstd); o[2] = f2bf(v.z * rstd); o[3] = f2bf(v.w * rstd);
}

struct NG {
    const bf16_t* A; const bf16_t* Bt; bf16_t* Ob; float* Of; const float* X; const float* bias;
    const int* list; const unsigned* cnt; const int* tab;
};
__device__ __forceinline__ float swiglu(float g, float l) {
    g = fminf(g, 7.f); l = fminf(fmaxf(l, -7.f), 7.f);
    const float s = __builtin_amdgcn_rcpf(1.f + __builtin_amdgcn_exp2f(-1.702f * LOG2E * g));
    return g * s * (l + 1.f);
}
template <int MODE> __global__ __launch_bounds__(256) void n_gemm(NG a) {
    const int lane = threadIdx.x & 63, w = threadIdx.x >> 6, row = lane & 15, quad = lane >> 4;
    const int m0 = blockIdx.x * 128 + (w >> 1) * 64, n0 = blockIdx.y * 128 + (w & 1) * 64;
    int e = 0, rbase = 0, cnt = 0;
    if (MODE >= 2) {
        const int pm = (blockIdx.x * 128) >> 8;
        if (pm >= a.tab[32]) return;
        e = a.tab[64 + pm]; rbase = m0 - 256 * a.tab[e]; cnt = (int)a.cnt[e];
    }
    const bf16_t* ar[4]; const bf16_t* br[4]; const bf16_t* br2[4];
#pragma unroll
    for (int i = 0; i < 4; ++i) {
        const int m = m0 + 16 * i + row;
        if (MODE == 2) { const int rr = rbase + 16 * i + row; const int tok = rr < cnt ? a.list[e * NTOK + rr] : 0; ar[i] = a.A + (size_t)tok * DM; }
        else ar[i] = a.A + (size_t)m * DM;
        const int n = n0 + 16 * i + row;
        if (MODE == 2) { br[i] = a.Bt + ((size_t)e * 2048 + n) * DM; br2[i] = br[i] + (size_t)1024 * DM; }
        else if (MODE == 3) { br[i] = a.Bt + ((size_t)e * 1024 + n) * DM; br2[i] = br[i]; }
        else { br[i] = a.Bt + (size_t)n * DM; br2[i] = br[i]; }
    }
    f32x4 acc[4][4], acc2[4][4];
#pragma unroll
    for (int i = 0; i < 4; ++i)
#pragma unroll
        for (int j = 0; j < 4; ++j) { acc[i][j] = (f32x4){0.f, 0.f, 0.f, 0.f}; acc2[i][j] = (f32x4){0.f, 0.f, 0.f, 0.f}; }
    for (int k0 = 0; k0 < DM; k0 += 32) {
        bf16x8 fa[4], fb[4], fb2[4];
#pragma unroll
        for (int i = 0; i < 4; ++i) { fa[i] = *(const bf16x8*)(ar[i] + k0 + quad * 8); fb[i] = *(const bf16x8*)(br[i] + k0 + quad * 8); if (MODE == 2) fb2[i] = *(const bf16x8*)(br2[i] + k0 + quad * 8); }
#pragma unroll
        for (int i = 0; i < 4; ++i)
#pragma unroll
            for (int j = 0; j < 4; ++j) {
                acc[i][j] = __builtin_amdgcn_mfma_f32_16x16x32_bf16(fa[i], fb[j], acc[i][j], 0, 0, 0);
                if (MODE == 2) acc2[i][j] = __builtin_amdgcn_mfma_f32_16x16x32_bf16(fa[i], fb2[j], acc2[i][j], 0, 0, 0);
            }
    }
#pragma unroll
    for (int i = 0; i < 4; ++i)
#pragma unroll
        for (int j = 0; j < 4; ++j)
#pragma unroll
            for (int r = 0; r < 4; ++r) {
                const int m = m0 + 16 * i + quad * 4 + r, n = n0 + 16 * j + row;
                const float v = acc[i][j][r];
                if (MODE == 0) a.Ob[(size_t)m * INC + n] = f2bf(n < 512 ? v * C2 : v);
                else if (MODE == 1) a.Of[(size_t)m * DM + n] = a.X[(size_t)m * DM + n] + v;
                else if (MODE == 2) a.Ob[(size_t)m * DM + n] = f2bf(swiglu(v + a.bias[e * 2048 + n], acc2[i][j][r] + a.bias[e * 2048 + 1024 + n]));
                else a.Ob[(size_t)m * DM + n] = f2bf(v + a.bias[e * 1024 + n]);
            }
}

__global__ __launch_bounds__(256) void n_attn(const bf16_t* P, const float* sinks, float* ATT) {
    const int gw = blockIdx.x * 4 + (threadIdx.x >> 6), lane = threadIdx.x & 63;
    const int tok = gw >> 3, h = gw & 7, hk = h >> 2, t = tok % SEQ;
    const float slope2 = exp2f(-(float)(h + 1)) * LOG2E, sink2 = sinks[h] * LOG2E;
    float q[64];
    const bf16_t* qp = P + (size_t)tok * INC + h * 64;
#pragma unroll
    for (int d = 0; d < 64; ++d) q[d] = bf2f(qp[d]);
    float s[2];
#pragma unroll
    for (int jj = 0; jj < 2; ++jj) {
        const int j = lane + 64 * jj, kp = t - 127 + j;
        float acc = -INFINITY;
        if (kp >= 0) {
            const bf16_t* kr = P + (size_t)(tok - 127 + j) * INC + 512 + hk * 64;
            acc = 0.f;
#pragma unroll
            for (int d = 0; d < 64; ++d) acc += q[d] * bf2f(kr[d]);
            acc -= slope2 * (float)(127 - j);
        }
        s[jj] = acc;
    }
    const float m = fmaxf(wave_max(fmaxf(s[0], s[1])), sink2);
    const float e0 = exp2f(s[0] - m), e1 = exp2f(s[1] - m);
    const float l = wave_sum(e0 + e1) + exp2f(sink2 - m);
    const float p0 = e0 / l, p1 = e1 / l;
    float o = 0.f;
    for (int j = 0; j < 128; ++j) {
        const float pj = __shfl(j < 64 ? p0 : p1, j & 63);
        if (t - 127 + j >= 0) o += pj * bf2f(P[(size_t)(tok - 127 + j) * INC + 640 + hk * 64 + lane]);
    }
    ATT[(size_t)tok * ATTW + h * 64 + lane] = o;
}
__global__ __launch_bounds__(256) void n_mix(const bf16_t* P, const float* ATT, const float* convw, bf16_t* MIX) {
    __shared__ float red[4];
    const int tok = blockIdx.x, tid = threadIdx.x, t = tok % SEQ;
    const float a0 = ATT[(size_t)tok * ATTW + tid], a1 = ATT[(size_t)tok * ATTW + 256 + tid];
    const float ssa = block_sum256(a0 * a0 + a1 * a1, red);
    const float ra = rsqrtf(ssa * (1.f / ATTW) + EPS);
    MIX[(size_t)tok * DM + tid] = f2bf(a0 * ra); MIX[(size_t)tok * DM + 256 + tid] = f2bf(a1 * ra);
    float y[2];
#pragma unroll
    for (int i = 0; i < 2; ++i) {
        const int c = tid + 256 * i;
        float acc = 0.f;
#pragma unroll
        for (int dt = 0; dt < 3; ++dt) {
            const int tt = t - 2 + dt;
            if (tt >= 0) { const bf16_t* pr = P + (size_t)(tok - 2 + dt) * INC; acc += convw[dt * CONVW + c] * (bf2f(pr[1280 + c]) * bf2f(pr[1792 + c])); }
        }
        y[i] = bf2f(P[(size_t)tok * INC + 768 + c]) * acc;
    }
    const float ssc = block_sum256(y[0] * y[0] + y[1] * y[1], red);
    const float rc = rsqrtf(ssc * (1.f / CONVW) + EPS);
    MIX[(size_t)tok * DM + 512 + tid] = f2bf(y[0] * rc); MIX[(size_t)tok * DM + 768 + tid] = f2bf(y[1] * rc);
}
__global__ __launch_bounds__(256) void n_router(const float* X1, const float* WR, const float* br, bf16_t* H2, unsigned* cnt, int* list, int* TE, int* TP, float* TG) {
    __shared__ float red[4]; __shared__ float xs[DM]; __shared__ float part[8][32]; __shared__ float lg[32];
    const int tok = blockIdx.x, tid = threadIdx.x;
    const f32x4 v = *(const f32x4*)(X1 + (size_t)tok * DM + 4 * tid);
    const float ss = block_sum256(v.x * v.x + v.y * v.y + v.z * v.z + v.w * v.w, red);
    const float rstd = rsqrtf(ss * (1.f / DM) + EPS);
    bf16_t* o = H2 + (size_t)tok * DM + 4 * tid;
    o[0] = f2bf(v.x * rstd); o[1] = f2bf(v.y * rstd); o[2] = f2bf(v.z * rstd); o[3] = f2bf(v.w * rstd);
    xs[4 * tid] = v.x; xs[4 * tid + 1] = v.y; xs[4 * tid + 2] = v.z; xs[4 * tid + 3] = v.w;
    __syncthreads();
    const int e = tid & 31, pt = tid >> 5;
    float acc = 0.f;
    for (int k = pt * 128; k < pt * 128 + 128; ++k) acc += xs[k] * WR[k * NE + e];
    part[pt][e] = acc;
    __syncthreads();
    if (tid < 32) { float sum = 0.f; for (int p = 0; p < 8; ++p) sum += part[p][tid]; lg[tid] = sum * rstd + br[tid]; }
    __syncthreads();
    if (tid == 0) {
        int idx[4]; float val[4]; unsigned used = 0u;
        for (int k = 0; k < 4; ++k) { float best = -INFINITY; int bi = 0; for (int j = 0; j < 32; ++j) if (!((used >> j) & 1u) && lg[j] > best) { best = lg[j]; bi = j; } used |= 1u << bi; idx[k] = bi; val[k] = best; }
        float es[4], sum = 0.f; for (int k = 0; k < 4; ++k) { es[k] = expf(val[k] - val[0]); sum += es[k]; }
        for (int k = 0; k < 4; ++k) {
            const unsigned pos = atomicAdd(&cnt[idx[k]], 1u);
            list[idx[k] * NTOK + pos] = tok; TE[tok * 4 + k] = idx[k]; TP[tok * 4 + k] = (int)pos; TG[tok * 4 + k] = es[k] / sum;
        }
    }
}
__global__ void n_tables(const unsigned* cnt, int* tab) {
    if (threadIdx.x == 0) { int s = 0; for (int e = 0; e < NE; ++e) { tab[e] = s; const int nt = ((int)cnt[e] + 255) >> 8; for (int i = 0; i < nt; ++i) tab[64 + s + i] = e; s += nt; } tab[32] = s; }
}
__global__ __launch_bounds__(256) void n_combine(const float* X1, const bf16_t* Y, const int* TE, const int* TP, const float* TG, const int* tab, const float* gf, float* out) {
    __shared__ float red[4];
    const int tok = blockIdx.x, tid = threadIdx.x;
    f32x4 v = *(const f32x4*)(X1 + (size_t)tok * DM + 4 * tid);
#pragma unroll
    for (int k = 0; k < 4; ++k) {
        const int e = TE[tok * 4 + k]; const size_t slot = (size_t)256 * tab[e] + TP[tok * 4 + k]; const float g = TG[tok * 4 + k];
        const bf16_t* yr = Y + slot * DM + 4 * tid;
        v.x += g * bf2f(yr[0]); v.y += g * bf2f(yr[1]); v.z += g * bf2f(yr[2]); v.w += g * bf2f(yr[3]);
    }
    const float ss = block_sum256(v.x * v.x + v.y * v.y + v.z * v.z + v.w * v.w, red);
    const float rstd = rsqrtf(ss * (1.f / DM) + EPS);
    const f32x4 g4 = *(const f32x4*)(gf + 4 * tid);
    *(f32x4*)(out + (size_t)tok * DM + 4 * tid) = (f32x4){v.x * rstd * g4.x, v.y * rstd * g4.y, v.z * rstd * g4.z, v.w * rstd * g4.w};
}

extern "C" void kernel_launch(void* const* d_in, const int* in_sizes, int n_in, void* d_out, int out_size, void* d_ws, size_t ws_size, hipStream_t stream) {
    if (n_in != 16 || out_size != NTOK * DM || ws_size < WS_END) { fprintf(stderr, "kernel_launch: unexpected shapes (n_in %d out %d ws %zu)\n", n_in, out_size, ws_size); return; }
    const float* x = (const float*)d_in[0]; const float* g_mix = (const float*)d_in[1]; const float* w_in = (const float*)d_in[2]; const float* conv_w = (const float*)d_in[3];
    const float* sinks = (const float*)d_in[4]; const float* g_ao = (const float*)d_in[5]; const float* g_co = (const float*)d_in[6]; const float* w_out = (const float*)d_in[7];
    const float* g_ffn = (const float*)d_in[8]; const float* w_router = (const float*)d_in[9]; const float* b_router = (const float*)d_in[10]; const float* w1 = (const float*)d_in[11];
    const float* b1 = (const float*)d_in[12]; const float* w2 = (const float*)d_in[13]; const float* b2 = (const float*)d_in[14]; const float* g_final = (const float*)d_in[15];
    unsigned char* ws = (unsigned char*)d_ws; float* out = (float*)d_out;
    unsigned* ctl = (unsigned*)(ws + WS_CTL);
    bf16_t* Win_t = (bf16_t*)(ws + WS_WIN); bf16_t* Wout_t = (bf16_t*)(ws + WS_WOUT); float* WR = (float*)(ws + WS_WR); int* list = (int*)(ws + WS_LIST);
    int* TE = (int*)(ws + WS_TE); int* TP = (int*)(ws + WS_TP); float* TG = (float*)(ws + WS_TG); int* tab = (int*)(ws + WS_TAB); float* gcat = (float*)(ws + WS_TAB + 16384);
    bf16_t* W1_t = (bf16_t*)(ws + WS_W1); bf16_t* W2_t = (bf16_t*)(ws + WS_W2); bf16_t* XN = (bf16_t*)(ws + WS_XN); bf16_t* P = (bf16_t*)(ws + WS_P);
    bf16_t* MIX = (bf16_t*)(ws + WS_MIX); bf16_t* ACT = (bf16_t*)(ws + WS_ACT); bf16_t* Y = (bf16_t*)(ws + WS_Y); float* ATT = (float*)(ws + WS_ATT);
    hipMemsetAsync(ws + WS_CTL, 0, CTL_BYTES, stream);
    n_gcat<<<4, 256, 0, stream>>>(g_ao, g_co, gcat);
    n_transpose<<<dim3(DM / 32, INC / 32, 1), dim3(32, 8), 0, stream>>>(w_in, Win_t, DM, INC, g_mix);
    n_transpose<<<dim3(DM / 32, DM / 32, 1), dim3(32, 8), 0, stream>>>(w_out, Wout_t, DM, DM, gcat);
    n_transpose<<<dim3(DM / 32, 2048 / 32, NE), dim3(32, 8), 0, stream>>>(w1, W1_t, DM, 2048, g_ffn);
    n_transpose<<<dim3(DFF / 32, DM / 32, NE), dim3(32, 8), 0, stream>>>(w2, W2_t, DFF, DM, nullptr);
    n_wr<<<DM * NE / 256, 256, 0, stream>>>(w_router, g_ffn, WR);
    n_xn<<<NTOK, 256, 0, stream>>>(x, XN);
    { NG a{}; a.A = XN; a.Bt = Win_t; a.Ob = P; n_gemm<0><<<dim3(NTOK / 128, INC / 128), 256, 0, stream>>>(a); }
    n_attn<<<NTOK * NQH / 4, 256, 0, stream>>>(P, sinks, ATT);
    n_mix<<<NTOK, 256, 0, stream>>>(P, ATT, conv_w, MIX);
    { NG a{}; a.A = MIX; a.Bt = Wout_t; a.Of = out; a.X = x; n_gemm<1><<<dim3(NTOK / 128, DM / 128), 256, 0, stream>>>(a); }
    n_router<<<NTOK, 256, 0, stream>>>(out, WR, b_router, XN, ctl + CW_CNT, list, TE, TP, TG);
    n_tables<<<1, 64, 0, stream>>>(ctl + CW_CNT, tab);
    { NG a{}; a.A = XN; a.Bt = W1_t; a.Ob = ACT; a.bias = b1; a.list = list; a.cnt = ctl + CW_CNT; a.tab = tab; n_gemm<2><<<dim3(PADROWS / 128, DFF / 128), 256, 0, stream>>>(a); }
    { NG a{}; a.A = ACT; a.Bt = W2_t; a.Ob = Y; a.bias = b2; a.list = list; a.cnt = ctl + CW_CNT; a.tab = tab; n_gemm<3><<<dim3(PADROWS / 128, DM / 128), 256, 0, stream>>>(a); }
    n_combine<<<NTOK, 256, 0, stream>>>(out, Y, TE, TP, TG, tab, g_final, out);
}
```

```cpp
#include <hip/hip_runtime.h>
#include <cstdint>
#include <cstdio>

typedef unsigned short bf16_t;
typedef short bf16x8 __attribute__((ext_vector_type(8)));
typedef float f32x4 __attribute__((ext_vector_type(4)));

constexpr int BATCH = 2, SEQ = 16384, DM = 1024, NTOK = BATCH * SEQ;
constexpr int NQH = 8, HD = 64, ATTW = 512, CONVW = 512, INC = 2304;
constexpr int NE = 32, DFF = 1024;
constexpr int MAXTILES = 544, PADROWS = MAXTILES * 256;
constexpr float EPS = 1e-5f;
constexpr float LOG2E = 1.4426950408889634f;
constexpr float C2 = 0.125f * LOG2E;

constexpr size_t MiB = 1u << 20;
constexpr size_t WS_CTL = 0, CTL_BYTES = 64 * 1024;
constexpr size_t WS_WIN = 1 * MiB, WS_WOUT = 6 * MiB, WS_WR = 8 * MiB, WS_LIST = 9 * MiB;
constexpr size_t WS_TE = 13 * MiB, WS_TP = 13 * MiB + 512 * 1024, WS_TG = 14 * MiB, WS_TAB = 14 * MiB + 512 * 1024;
constexpr size_t WS_W1 = 16 * MiB, WS_W2 = 144 * MiB, WS_XN = 208 * MiB, WS_P = 272 * MiB, WS_MIX = 416 * MiB;
constexpr size_t WS_ACT = 272 * MiB, WS_Y = 544 * MiB, WS_ATT = 816 * MiB, WS_END = 880 * MiB;
constexpr int CW_CNT = 0;

__device__ __forceinline__ float bf2f(bf16_t v) { return __uint_as_float((unsigned)v << 16); }
__device__ __forceinline__ bf16_t f2bf(float f) { unsigned u = __float_as_uint(f); return (bf16_t)((u + 0x7fffu + ((u >> 16) & 1u)) >> 16); }

__device__ __forceinline__ float wave_sum(float v) {
#pragma unroll
    for (int o = 1; o < 64; o <<= 1) v += __shfl_xor(v, o);
    return v;
}
__device__ __forceinline__ float wave_max(float v) {
#pragma unroll
    for (int o = 1; o < 64; o <<= 1) v = fmaxf(v, __shfl_xor(v, o));
    return v;
}
__device__ __forceinline__ float block_sum256(float v, float* red) {
    v = wave_sum(v);
    __syncthreads();
    if ((threadIdx.x & 63) == 0) red[threadIdx.x >> 6] = v;
    __syncthreads();
    return red[0] + red[1] + red[2] + red[3];
}

__global__ void n_transpose(const float* W, bf16_t* WT, int K, int N, const float* g) {
    __shared__ float tile[32][33];
    const size_t zoff = (size_t)blockIdx.z * K * N;
    const int k0 = blockIdx.x * 32, n0 = blockIdx.y * 32, tx = threadIdx.x, ty = threadIdx.y;
#pragma unroll
    for (int i = 0; i < 4; ++i) { const int kk = ty + 8 * i; tile[kk][tx] = W[zoff + (size_t)(k0 + kk) * N + n0 + tx] * (g ? g[k0 + kk] : 1.f); }
    __syncthreads();
#pragma unroll
    for (int i = 0; i < 4; ++i) { const int nn = ty + 8 * i; WT[zoff + (size_t)(n0 + nn) * K + k0 + tx] = f2bf(tile[tx][nn]); }
}
__global__ void n_wr(const float* wr, const float* g, float* out) {
    const int i = blockIdx.x * 256 + threadIdx.x; if (i < DM * NE) out[i] = wr[i] * g[i >> 5];
}
__global__ void n_gcat(const float* ga, const float* gc, float* out) { const int i = blockIdx.x * 256 + threadIdx.x; if (i < DM) out[i] = i < 512 ? ga[i] : gc[i - 512]; }
__global__ __launch_bounds__(256) void n_xn(const float* x, bf16_t* XN) {
    __shared__ float red[4];
    const int row = blockIdx.x, t = threadIdx.x;
    const f32x4 v = *(const f32x4*)(x + (size_t)row * DM + 4 * t);
    const float ss = block_sum256(v.x * v.x + v.y * v.y + v.z * v.z + v.w * v.w, red);
    const float rstd = rsqrtf(ss * (1.f / DM) + EPS);
    bf16_t* o = XN + (size_t)row * DM + 4 * t;
    o[0] = f2bf(v.x * rstd); o[1] = f2bf(v.y * rstd); o[2] = f2bf(v.z * rstd); o[3] = f2bf(v.w * rstd);
}

struct NG {
    const bf16_t* A; const bf16_t* Bt; bf16_t* Ob; float* Of; const float* X; const float* bias;
    const int* list; const unsigned* cnt; const int* tab;
};
__device__ __forceinline__ float swiglu(float g, float l) {
    g = fminf(g, 7.f); l = fminf(fmaxf(l, -7.f), 7.f);
    const float s = __builtin_amdgcn_rcpf(1.f + __builtin_amdgcn_exp2f(-1.702f * LOG2E * g));
    return g * s * (l + 1.f);
}
template <int MODE> __global__ __launch_bounds__(256) void n_gemm(NG a) {
    const int lane = threadIdx.x & 63, w = threadIdx.x >> 6, row = lane & 15, quad = lane >> 4;
    const int m0 = blockIdx.x * 128 + (w >> 1) * 64, n0 = blockIdx.y * 128 + (w & 1) * 64;
    int e = 0, rbase = 0, cnt = 0;
    if (MODE >= 2) {
        const int pm = (blockIdx.x * 128) >> 8;
        if (pm >= a.tab[32]) return;
        e = a.tab[64 + pm]; rbase = m0 - 256 * a.tab[e]; cnt = (int)a.cnt[e];
    }
    const bf16_t* ar[4]; const bf16_t* br[4]; const bf16_t* br2[4];
#pragma unroll
    for (int i = 0; i < 4; ++i) {
        const int m = m0 + 16 * i + row;
        if (MODE == 2) { const int rr = rbase + 16 * i + row; const int tok = rr < cnt ? a.list[e * NTOK + rr] : 0; ar[i] = a.A + (size_t)tok * DM; }
        else ar[i] = a.A + (size_t)m * DM;
        const int n = n0 + 16 * i + row;
        if (MODE == 2) { br[i] = a.Bt + ((size_t)e * 2048 + n) * DM; br2[i] = br[i] + (size_t)1024 * DM; }
        else if (MODE == 3) { br[i] = a.Bt + ((size_t)e * 1024 + n) * DM; br2[i] = br[i]; }
        else { br[i] = a.Bt + (size_t)n * DM; br2[i] = br[i]; }
    }
    f32x4 acc[4][4], acc2[4][4];
#pragma unroll
    for (int i = 0; i < 4; ++i)
#pragma unroll
        for (int j = 0; j < 4; ++j) { acc[i][j] = (f32x4){0.f, 0.f, 0.f, 0.f}; acc2[i][j] = (f32x4){0.f, 0.f, 0.f, 0.f}; }
    for (int k0 = 0; k0 < DM; k0 += 32) {
        bf16x8 fa[4], fb[4], fb2[4];
#pragma unroll
        for (int i = 0; i < 4; ++i) { fa[i] = *(const bf16x8*)(ar[i] + k0 + quad * 8); fb[i] = *(const bf16x8*)(br[i] + k0 + quad * 8); if (MODE == 2) fb2[i] = *(const bf16x8*)(br2[i] + k0 + quad * 8); }
#pragma unroll
        for (int i = 0; i < 4; ++i)
#pragma unroll
            for (int j = 0; j < 4; ++j) {
                acc[i][j] = __builtin_amdgcn_mfma_f32_16x16x32_bf16(fa[i], fb[j], acc[i][j], 0, 0, 0);
                if (MODE == 2) acc2[i][j] = __builtin_amdgcn_mfma_f32_16x16x32_bf16(fa[i], fb2[j], acc2[i][j], 0, 0, 0);
            }
    }
#pragma unroll
    for (int i = 0; i < 4; ++i)
#pragma unroll
        for (int j = 0; j < 4; ++j)
#pragma unroll
            for (int r = 0; r < 4; ++r) {
                const int m = m0 + 16 * i + quad * 4 + r, n = n0 + 16 * j + row;
                const float v = acc[i][j][r];
                if (MODE == 0) a.Ob[(size_t)m * INC + n] = f2bf(n < 512 ? v * C2 : v);
                else if (MODE == 1) a.Of[(size_t)m * DM + n] = a.X[(size_t)m * DM + n] + v;
                else if (MODE == 2) a.Ob[(size_t)m * DM + n] = f2bf(swiglu(v + a.bias[e * 2048 + n], acc2[i][j][r] + a.bias[e * 2048 + 1024 + n]));
                else a.Ob[(size_t)m * DM + n] = f2bf(v + a.bias[e * 1024 + n]);
            }
}

__global__ __launch_bounds__(256) void n_attn(const bf16_t* P, const float* sinks, float* ATT) {
    const int gw = blockIdx.x * 4 + (threadIdx.x >> 6), lane = threadIdx.x & 63;
    const int tok = gw >> 3, h = gw & 7, hk = h >> 2, t = tok % SEQ;
    const float slope2 = exp2f(-(float)(h + 1)) * LOG2E, sink2 = sinks[h] * LOG2E;
    float q[64];
    const bf16_t* qp = P + (size_t)tok * INC + h * 64;
#pragma unroll
    for (int d = 0; d < 64; ++d) q[d] = bf2f(qp[d]);
    float s[2];
#pragma unroll
    for (int jj = 0; jj < 2; ++jj) {
        const int j = lane + 64 * jj, kp = t - 127 + j;
        float acc = -INFINITY;
        if (kp >= 0) {
            const bf16_t* kr = P + (size_t)(tok - 127 + j) * INC + 512 + hk * 64;
            acc = 0.f;
#pragma unroll
            for (int d = 0; d < 64; ++d) acc += q[d] * bf2f(kr[d]);
            acc -= slope2 * (float)(127 - j);
        }
        s[jj] = acc;
    }
    const float m = fmaxf(wave_max(fmaxf(s[0], s[1])), sink2);
    const float e0 = exp2f(s[0] - m), e1 = exp2f(s[1] - m);
    const float l = wave_sum(e0 + e1) + exp2f(sink2 - m);
    const float p0 = e0 / l, p1 = e1 / l;
    float o = 0.f;
    for (int j = 0; j < 128; ++j) {
        const float pj = __shfl(j < 64 ? p0 : p1, j & 63);
        if (t - 127 + j >= 0) o += pj * bf2f(P[(size_t)(tok - 127 + j) * INC + 640 + hk * 64 + lane]);
    }
    ATT[(size_t)tok * ATTW + h * 64 + lane] = o;
}
__global__ __launch_bounds__(256) void n_mix(const bf16_t* P, const float* ATT, const float* convw, bf16_t* MIX) {
    __shared__ float red[4];
    const int tok = blockIdx.x, tid = threadIdx.x, t = tok % SEQ;
    const float a0 = ATT[(size_t)tok * ATTW + tid], a1 = ATT[(size_t)tok * ATTW + 256 + tid];
    const float ssa = block_sum256(a0 * a0 + a1 * a1, red);
    const float ra = rsqrtf(ssa * (1.f / ATTW) + EPS);
    MIX[(size_t)tok * DM + tid] = f2bf(a0 * ra); MIX[(size_t)tok * DM + 256 + tid] = f2bf(a1 * ra);
    float y[2];
#pragma unroll
    for (int i = 0; i < 2; ++i) {
        const int c = tid + 256 * i;
        float acc = 0.f;
#pragma unroll
        for (int dt = 0; dt < 3; ++dt) {
            const int tt = t - 2 + dt;
            if (tt >= 0) { const bf16_t* pr = P + (size_t)(tok - 2 + dt) * INC; acc += convw[dt * CONVW + c] * (bf2f(pr[1280 + c]) * bf2f(pr[1792 + c])); }
        }
        y[i] = bf2f(P[(size_t)tok * INC + 768 + c]) * acc;
    }
    const float ssc = block_sum256(y[0] * y[0] + y[1] * y[1], red);
    const float rc = rsqrtf(ssc * (1.f / CONVW) + EPS);
    MIX[(size_t)tok * DM + 512 + tid] = f2bf(y[0] * rc); MIX[(size_t)tok * DM + 768 + tid] = f2bf(y[1] * rc);
}
__global__ __launch_bounds__(256) void n_router(const float* X1, const float* WR, const float* br, bf16_t* H2, unsigned* cnt, int* list, int* TE, int* TP, float* TG) {
    __shared__ float red[4]; __shared__ float xs[DM]; __shared__ float part[8][32]; __shared__ float lg[32];
    const int tok = blockIdx.x, tid = threadIdx.x;
    const f32x4 v = *(const f32x4*)(X1 + (size_t)tok * DM + 4 * tid);
    const float ss = block_sum256(v.x * v.x + v.y * v.y + v.z * v.z + v.w * v.w, red);
    const float rstd = rsqrtf(ss * (1.f / DM) + EPS);
    bf16_t* o = H2 + (size_t)tok * DM + 4 * tid;
    o[0] = f2bf(v.x * rstd); o[1] = f2bf(v.y * rstd); o[2] = f2bf(v.z * rstd); o[3] = f2bf(v.w * rstd);
    xs[4 * tid] = v.x; xs[4 * tid + 1] = v.y; xs[4 * tid + 2] = v.z; xs[4 * tid + 3] = v.w;
    __syncthreads();
    const int e = tid & 31, pt = tid >> 5;
    float acc = 0.f;
    for (int k = pt * 128; k < pt * 128 + 128; ++k) acc += xs[k] * WR[k * NE + e];
    part[pt][e] = acc;
    __syncthreads();
    if (tid < 32) { float sum = 0.f; for (int p = 0; p < 8; ++p) sum += part[p][tid]; lg[tid] = sum * rstd + br[tid]; }
    __syncthreads();
    if (tid == 0) {
        int idx[4]; float val[4]; unsigned used = 0u;
        for (int k = 0; k < 4; ++k) { float best = -INFINITY; int bi = 0; for (int j = 0; j < 32; ++j) if (!((used >> j) & 1u) && lg[j] > best) { best = lg[j]; bi = j; } used |= 1u << bi; idx[k] = bi; val[k] = best; }
        float es[4], sum = 0.f; for (int k = 0; k < 4; ++k) { es[k] = expf(val[k] - val[0]); sum += es[k]; }
        for (int k = 0; k < 4; ++k) {
            const unsigned pos = atomicAdd(&cnt[idx[k]], 1u);
            list[idx[k] * NTOK + pos] = tok; TE[tok * 4 + k] = idx[k]; TP[tok * 4 + k] = (int)pos; TG[tok * 4 + k] = es[k] / sum;
        }
    }
}
__global__ void n_tables(const unsigned* cnt, int* tab) {
    if (threadIdx.x == 0) { int s = 0; for (int e = 0; e < NE; ++e) { tab[e] = s; const int nt = ((int)cnt[e] + 255) >> 8; for (int i = 0; i < nt; ++i) tab[64 + s + i] = e; s += nt; } tab[32] = s; }
}
__global__ __launch_bounds__(256) void n_combine(const float* X1, const bf16_t* Y, const int* TE, const int* TP, const float* TG, const int* tab, const float* gf, float* out) {
    __shared__ float red[4];
    const int tok = blockIdx.x, tid = threadIdx.x;
    f32x4 v = *(const f32x4*)(X1 + (size_t)tok * DM + 4 * tid);
#pragma unroll
    for (int k = 0; k < 4; ++k) {
        const int e = TE[tok * 4 + k]; const size_t slot = (size_t)256 * tab[e] + TP[tok * 4 + k]; const float g = TG[tok * 4 + k];
        const bf16_t* yr = Y + slot * DM + 4 * tid;
        v.x += g * bf2f(yr[0]); v.y += g * bf2f(yr[1]); v.z += g * bf2f(yr[2]); v.w += g * bf2f(yr[3]);
    }
    const float ss = block_sum256(v.x * v.x + v.y * v.y + v.z * v.z + v.w * v.w, red);
    const float rstd = rsqrtf(ss * (1.f / DM) + EPS);
    const f32x4 g4 = *(const f32x4*)(gf + 4 * tid);
    *(f32x4*)(out + (size_t)tok * DM + 4 * tid) = (f32x4){v.x * rstd * g4.x, v.y * rstd * g4.y, v.z * rstd * g4.z, v.w * rstd * g4.w};
}


#define LAS __attribute__((address_space(3)))
#define GAS __attribute__((address_space(1)))
typedef unsigned u32x4 __attribute__((ext_vector_type(4)));
typedef unsigned u32x2 __attribute__((ext_vector_type(2)));
typedef float f32x16 __attribute__((ext_vector_type(16)));
typedef float f32x2 __attribute__((ext_vector_type(2)));
typedef short s16x4 __attribute__((ext_vector_type(4)));
typedef __bf16 bf16x2_t __attribute__((ext_vector_type(2)));
typedef GAS unsigned gu32;
#define RLX_AGENT __ATOMIC_RELAXED, __HIP_MEMORY_SCOPE_AGENT
#define LDS_WAIT() asm volatile("s_waitcnt lgkmcnt(0)" ::: "memory")
#define VM_WAIT() asm volatile("s_waitcnt vmcnt(0)" ::: "memory")

constexpr int NWAVES = 8, NTHREADS = 512;
constexpr int RING_OFF = 0, RING_BYTES = 131072;
constexpr int IDTAB_OFF = RING_BYTES, IDTAB_UNITS = 17, IDTAB_BYTES = IDTAB_UNITS * 1024;
constexpr int TILEE_OFF = IDTAB_OFF + IDTAB_BYTES;
constexpr int TSTART_OFF = TILEE_OFF + 2304;
constexpr int CNT_OFF = TSTART_OFF + 256;
constexpr int MISC_OFF = CNT_OFF + 128;
constexpr int LDS_BYTES = 155648;
static_assert(MISC_OFF + 128 <= LDS_BYTES, "LDS map");
constexpr int CW_BAR = 4096;

__device__ __forceinline__ unsigned cvtpk(float lo, float hi) { f32x2 v = {lo, hi}; bf16x2_t b = __builtin_convertvector(v, bf16x2_t); return __builtin_bit_cast(unsigned, b); }

namespace pg8 {
constexpr int BM = 256, BK = 64, HALF = 128, HTB = HALF * BK * 2, NXCD = 8, WGM = 8, KD = 1024, NT = KD / BK;
__host__ __device__ __forceinline__ int lds_byte(int r, int c) { const int st = (r >> 4) * 2 + (c >> 5), rr = r & 15, cc = c & 31, ob = rr * 64 + cc * 2; return st * 1024 + (ob ^ (((ob >> 9) & 1) << 5)); }
__host__ __device__ __forceinline__ void stage_rc(int b, int& R, int& C) { const int st = b / 1024, sb = b % 1024, swz = sb ^ (((sb >> 9) & 1) << 5); R = (st >> 1) * 16 + swz / 64; C = (st & 1) * 32 + (swz % 64) / 2; }
__host__ __device__ __forceinline__ int perm32(int rho) { const int n = rho >> 4, i = rho & 15; return 8 * (i >> 2) + 4 * n + (i & 3); }
struct Unit { int pm, pn, e; };
__device__ __forceinline__ bool order_next(int i, int G, int c, int nM, int nN, Unit& u) {
    const int nwg = nM * nN; const long L = (long)i * G + c; if (L >= nwg) return false;
    int wgid = (int)L; { const int q = nwg / NXCD, r = nwg % NXCD, xcd = wgid % NXCD, off = wgid / NXCD; wgid = (xcd < r ? xcd * (q + 1) : r * (q + 1) + (xcd - r) * q) + off; }
    const int nig = WGM * nN, gid = wgid / nig, fm = gid * WGM, gsz = (nM - fm) < WGM ? (nM - fm) : WGM;
    u.pm = fm + ((wgid % nig) % gsz); u.pn = (wgid % nig) / gsz; u.e = 0; return true;
}
struct ProbDense {
    static constexpr size_t HSTEPB = (size_t)HALF * KD * 2;
    const bf16_t* A; const bf16_t* Bt; int nM, nN, G, c;
    __device__ __forceinline__ bool next(int i, Unit& u) const { return order_next(i, G, c, nM, nN, u); }
    __device__ __forceinline__ const char* a_base(const Unit& u) const { return (const char*)A + (size_t)u.pm * BM * KD * 2; }
    __device__ __forceinline__ const char* b_base(const Unit& u) const { return (const char*)Bt + (size_t)u.pn * BM * KD * 2; }
    __device__ __forceinline__ void a_offs(int, const Unit&, const int (&Rr)[2], const int (&Cb)[2], unsigned (&va)[2][2]) const {
#pragma unroll
        for (int h = 0; h < 2; ++h)
#pragma unroll
            for (int i = 0; i < 2; ++i) va[h][i] = (unsigned)((Rr[i] + HALF * h) * KD * 2 + Cb[i]);
    }
};
struct ProbG1 {
    static constexpr size_t HSTEPB = (size_t)1024 * KD * 2;
    const bf16_t* H2; const bf16_t* W1t; int nM, G, c; const LAS int* tile_e; const LAS unsigned* idtab;
    __device__ __forceinline__ bool next(int i, Unit& u) const { if (!order_next(i, G, c, nM, 8, u)) return false; u.e = tile_e[u.pm]; return true; }
    __device__ __forceinline__ const char* a_base(const Unit&) const { return (const char*)H2; }
    __device__ __forceinline__ const char* b_base(const Unit& u) const { return (const char*)W1t + ((size_t)u.e * 2048 + (size_t)u.pn * 128) * KD * 2; }
    __device__ __forceinline__ void a_offs(int ui, const Unit&, const int (&Rr)[2], const int (&Cb)[2], unsigned (&va)[2][2]) const {
        const int uu = ui < IDTAB_UNITS ? ui : IDTAB_UNITS - 1;
#pragma unroll
        for (int h = 0; h < 2; ++h)
#pragma unroll
            for (int i = 0; i < 2; ++i) va[h][i] = idtab[uu * 256 + h * HALF + Rr[i]] + (unsigned)Cb[i];
    }
};
struct ProbG2 {
    static constexpr size_t HSTEPB = (size_t)HALF * KD * 2;
    const bf16_t* ACT; const bf16_t* W2t; int nM, G, c; const LAS int* tile_e;
    __device__ __forceinline__ bool next(int i, Unit& u) const { if (!order_next(i, G, c, nM, 4, u)) return false; u.e = tile_e[u.pm]; return true; }
    __device__ __forceinline__ const char* a_base(const Unit& u) const { return (const char*)ACT + (size_t)u.pm * BM * KD * 2; }
    __device__ __forceinline__ const char* b_base(const Unit& u) const { return (const char*)W2t + ((size_t)u.e * 1024 + (size_t)u.pn * 256) * KD * 2; }
    __device__ __forceinline__ void a_offs(int, const Unit&, const int (&Rr)[2], const int (&Cb)[2], unsigned (&va)[2][2]) const {
#pragma unroll
        for (int h = 0; h < 2; ++h)
#pragma unroll
            for (int i = 0; i < 2; ++i) va[h][i] = (unsigned)((Rr[i] + HALF * h) * KD * 2 + Cb[i]);
    }
};

struct EpiP {
    static constexpr bool PERM = true; bf16_t* O;
    __device__ __forceinline__ void operator()(const f32x4 (&acc)[2][2][4][2], const Unit& u, int wr, int wc, int fr, int fq) const {
        const int row0 = u.pm * BM + wr * 64 + fr, col0 = u.pn * BM + wc * 32 + 8 * fq; const float sc = u.pn < 2 ? C2 : 1.f;
#pragma unroll
        for (int ai = 0; ai < 2; ++ai)
#pragma unroll
            for (int m = 0; m < 4; ++m) { bf16_t* rowp = O + (size_t)(row0 + ai * HALF + m * 16) * INC + col0;
#pragma unroll
                for (int bj = 0; bj < 2; ++bj) { const f32x4 v0 = acc[ai][bj][m][0] * sc, v1 = acc[ai][bj][m][1] * sc;
                    u32x4 w; w.x = cvtpk(v0[0], v0[1]); w.y = cvtpk(v0[2], v0[3]); w.z = cvtpk(v1[0], v1[1]); w.w = cvtpk(v1[2], v1[3]);
                    *(u32x4*)(rowp + bj * HALF) = w; } }
    }
};
struct EpiX1 {
    static constexpr bool PERM = false; const float* X; float* O;
    __device__ __forceinline__ void operator()(const f32x4 (&acc)[2][2][4][2], const Unit& u, int wr, int wc, int fr, int fq) const {
        const int row0 = u.pm * BM + wr * 64 + fr, col0 = u.pn * BM + wc * 32 + 4 * fq;
#pragma unroll
        for (int ai = 0; ai < 2; ++ai)
#pragma unroll
            for (int m = 0; m < 4; ++m) { const size_t off = (size_t)(row0 + ai * HALF + m * 16) * DM + col0;
#pragma unroll
                for (int bj = 0; bj < 2; ++bj)
#pragma unroll
                    for (int n = 0; n < 2; ++n) { const f32x4 xr = *(const f32x4*)(X + off + bj * HALF + n * 16); *(f32x4*)(O + off + bj * HALF + n * 16) = xr + acc[ai][bj][m][n]; } }
    }
};
struct EpiAct {
    static constexpr bool PERM = true; bf16_t* O; const float* b1;
    __device__ __forceinline__ void operator()(const f32x4 (&acc)[2][2][4][2], const Unit& u, int wr, int wc, int fr, int fq) const {
        const int row0 = u.pm * BM + wr * 64 + fr, col0 = u.pn * 128 + wc * 32 + 8 * fq;
        const float* bp = b1 + (size_t)u.e * 2048 + col0;
        const f32x4 bg0 = *(const f32x4*)(bp), bg1 = *(const f32x4*)(bp + 4), bl0 = *(const f32x4*)(bp + 1024), bl1 = *(const f32x4*)(bp + 1028);
#pragma unroll
        for (int ai = 0; ai < 2; ++ai)
#pragma unroll
            for (int m = 0; m < 4; ++m) {
                const f32x4 g0 = acc[ai][0][m][0] + bg0, g1 = acc[ai][0][m][1] + bg1, l0 = acc[ai][1][m][0] + bl0, l1 = acc[ai][1][m][1] + bl1;
                u32x4 w; w.x = cvtpk(swiglu(g0[0], l0[0]), swiglu(g0[1], l0[1])); w.y = cvtpk(swiglu(g0[2], l0[2]), swiglu(g0[3], l0[3]));
                w.z = cvtpk(swiglu(g1[0], l1[0]), swiglu(g1[1], l1[1])); w.w = cvtpk(swiglu(g1[2], l1[2]), swiglu(g1[3], l1[3]));
                *(u32x4*)(O + (size_t)(row0 + ai * HALF + m * 16) * DM + col0) = w; }
    }
};
struct EpiY {
    static constexpr bool PERM = true; bf16_t* O; const float* b2;
    __device__ __forceinline__ void operator()(const f32x4 (&acc)[2][2][4][2], const Unit& u, int wr, int wc, int fr, int fq) const {
        const int row0 = u.pm * BM + wr * 64 + fr, col0 = u.pn * BM + wc * 32 + 8 * fq;
        const float* bp = b2 + (size_t)u.e * 1024 + col0;
        f32x4 bv[2][2];
#pragma unroll
        for (int bj = 0; bj < 2; ++bj)
#pragma unroll
            for (int n = 0; n < 2; ++n) bv[bj][n] = *(const f32x4*)(bp + bj * HALF + 4 * n);
#pragma unroll
        for (int ai = 0; ai < 2; ++ai)
#pragma unroll
            for (int m = 0; m < 4; ++m) { bf16_t* rowp = O + (size_t)(row0 + ai * HALF + m * 16) * DM + col0;
#pragma unroll
                for (int bj = 0; bj < 2; ++bj) { const f32x4 v0 = acc[ai][bj][m][0] + bv[bj][0], v1 = acc[ai][bj][m][1] + bv[bj][1];
                    u32x4 w; w.x = cvtpk(v0[0], v0[1]); w.y = cvtpk(v0[2], v0[3]); w.z = cvtpk(v1[0], v1[1]); w.w = cvtpk(v1[2], v1[3]);
                    *(u32x4*)(rowp + bj * HALF) = w; } }
    }
};

template <class Prob, class Epi, bool ALIGN_EPI>
__device__ __forceinline__ void gemm_phase(LAS unsigned char* lds, const Prob& S, const Epi& E) {
    const int tid = threadIdx.x, wid = __builtin_amdgcn_readfirstlane(tid >> 6), lane = tid & 63, wr = wid >> 2, wc = wid & 3, fr = lane & 15, fq = lane >> 4;
    constexpr int K = KD, nt = NT;
    unsigned voffB[2]; int Rr[2], Cb[2];
#pragma unroll
    for (int i = 0; i < 2; ++i) { int R, C; stage_rc(tid * 16 + i * 8192, R, C); const int Rb = Epi::PERM ? ((R & ~31) + perm32(R & 31)) : R;
        voffB[i] = (unsigned)(Rb * K + C) * 2u; Rr[i] = R; Cb[i] = C * 2; }
    constexpr size_t kstep = (size_t)(BK * 2);
    constexpr size_t hstepB = Prob::HSTEPB;
    const unsigned ldsw = (unsigned)wid * 1024u;
    const int aoff = lds_byte(wr * 64 + fr, fq * 8), boff = lds_byte(wc * 32 + fr, fq * 8);
#define PG8_SA(b, h) (((b) * 2 + (h)) * HTB)
#define PG8_SB(b, h) ((4 + (b) * 2 + (h)) * HTB)
#define PG8_STAGE(bufoff, gbase, voff) do { _Pragma("unroll") for (int _i = 0; _i < 2; ++_i) \
        __builtin_amdgcn_global_load_lds((const unsigned*)((const char*)(gbase) + (voff)[_i]), (LAS unsigned*)(lds + (bufoff) + ldsw + _i * 8192), 16, 0, 0); } while (0)
#define PG8_LDA(dst, b, h) do { _Pragma("unroll") for (int m = 0; m < 4; ++m) _Pragma("unroll") for (int k = 0; k < 2; ++k) dst[m][k] = *(const LAS bf16x8*)(lds + PG8_SA(b, h) + aoff + m * 2048 + k * 1024); } while (0)
#define PG8_LDB(dst, b, h) do { _Pragma("unroll") for (int n = 0; n < 2; ++n) _Pragma("unroll") for (int k = 0; k < 2; ++k) dst[n][k] = *(const LAS bf16x8*)(lds + PG8_SB(b, h) + boff + n * 2048 + k * 1024); } while (0)
#define PG8_MMA(ai, bj, At, Bt) do { __builtin_amdgcn_s_setprio(1); _Pragma("unroll") for (int m = 0; m < 4; ++m) _Pragma("unroll") for (int n = 0; n < 2; ++n) _Pragma("unroll") for (int k = 0; k < 2; ++k) \
        acc[ai][bj][m][n] = __builtin_amdgcn_mfma_f32_16x16x32_bf16(Bt[n][k], At[m][k], acc[ai][bj][m][n], 0, 0, 0); __builtin_amdgcn_s_setprio(0); } while (0)
#define PG8_WAIT_V(n) asm volatile("s_waitcnt vmcnt(" #n ")" ::: "memory")
#define PG8_WAIT_L(n) asm volatile("s_waitcnt lgkmcnt(" #n ")" ::: "memory")
#define PG8_BAR __builtin_amdgcn_s_barrier()
#define PG8_SCHED __builtin_amdgcn_sched_barrier(0)
    Unit cur, nxt; int ui = 0;
    if (!S.next(0, cur)) return;
    unsigned vaC[2][2], vaN[2][2];
    S.a_offs(0, cur, Rr, Cb, vaC);
    f32x4 acc[2][2][4][2];
#pragma unroll
    for (int a = 0; a < 2; ++a)
#pragma unroll
        for (int b = 0; b < 2; ++b)
#pragma unroll
            for (int m = 0; m < 4; ++m)
#pragma unroll
                for (int n = 0; n < 2; ++n) acc[a][b][m][n] = (f32x4){0.f, 0.f, 0.f, 0.f};
    bf16x8 At[4][2], B0[2][2], B1[2][2];
    const char* cA = S.a_base(cur); const char* cB = S.b_base(cur);
    PG8_STAGE(PG8_SB(0, 0), cB, voffB); PG8_STAGE(PG8_SB(0, 1), cB + hstepB, voffB); PG8_STAGE(PG8_SA(0, 0), cA, vaC[0]); PG8_STAGE(PG8_SA(0, 1), cA, vaC[1]);
    if (wr == 1) PG8_BAR;
    PG8_WAIT_V(2); PG8_BAR;
    PG8_STAGE(PG8_SB(1, 0), cB + kstep, voffB); PG8_STAGE(PG8_SA(1, 0), cA + kstep, vaC[0]); PG8_STAGE(PG8_SB(1, 1), cB + hstepB + kstep, voffB);
    PG8_WAIT_V(6); PG8_BAR;
    for (;;) {
        const bool has_next = S.next(ui + 1, nxt);
        const char* nA = has_next ? S.a_base(nxt) : cA; const char* nB = has_next ? S.b_base(nxt) : cB;
        if (has_next) S.a_offs(ui + 1, nxt, Rr, Cb, vaN);
        else {
#pragma unroll
            for (int h = 0; h < 2; ++h)
#pragma unroll
                for (int i = 0; i < 2; ++i) vaN[h][i] = vaC[h][i]; }
        for (int t = 0; t < nt; t += 2) {
            const bool last = (t == nt - 2);
            const char* a1 = cA + (size_t)(t + 1) * kstep;
            const char* a2 = last ? nA : cA + (size_t)(t + 2) * kstep; const char* b2 = last ? nB : cB + (size_t)(t + 2) * kstep;
            const char* a3 = a2 + kstep; const char* b3 = b2 + kstep;
            unsigned v2[2][2];
#pragma unroll
            for (int h = 0; h < 2; ++h)
#pragma unroll
                for (int i = 0; i < 2; ++i) v2[h][i] = last ? vaN[h][i] : vaC[h][i];
            PG8_LDB(B0, 0, 0); PG8_LDB(B1, 0, 1); PG8_SCHED; PG8_LDA(At, 0, 0); PG8_STAGE(PG8_SA(1, 1), a1, vaC[1]);
            PG8_WAIT_V(8); PG8_WAIT_L(0); PG8_BAR; PG8_MMA(0, 0, At, B0); PG8_MMA(0, 1, At, B1); PG8_BAR; PG8_SCHED;
            PG8_LDA(At, 0, 1); PG8_STAGE(PG8_SB(0, 0), b2, voffB); PG8_STAGE(PG8_SB(0, 1), b2 + hstepB, voffB); PG8_STAGE(PG8_SA(0, 0), a2, v2[0]);
            PG8_WAIT_V(8); PG8_WAIT_L(0); PG8_BAR; PG8_MMA(1, 0, At, B0); PG8_MMA(1, 1, At, B1); PG8_BAR; PG8_SCHED;
            PG8_LDB(B0, 1, 0); PG8_LDB(B1, 1, 1); PG8_SCHED; PG8_LDA(At, 1, 0); PG8_STAGE(PG8_SA(0, 1), a2, v2[1]);
            PG8_WAIT_V(8); PG8_WAIT_L(0); PG8_BAR; PG8_MMA(0, 0, At, B0); PG8_MMA(0, 1, At, B1); PG8_BAR; PG8_SCHED;
            PG8_LDA(At, 1, 1); PG8_STAGE(PG8_SB(1, 0), b3, voffB); PG8_STAGE(PG8_SB(1, 1), b3 + hstepB, voffB); PG8_STAGE(PG8_SA(1, 0), a3, v2[0]);
            PG8_WAIT_V(8); PG8_WAIT_L(0); PG8_BAR; PG8_MMA(1, 0, At, B0); PG8_MMA(1, 1, At, B1); PG8_BAR; PG8_SCHED;
        }
        if constexpr (ALIGN_EPI) { if (wr == 0) PG8_BAR; }
        E(acc, cur, wr, wc, fr, fq);
        if (!has_next) break;
#pragma unroll
        for (int a = 0; a < 2; ++a)
#pragma unroll
            for (int b = 0; b < 2; ++b)
#pragma unroll
                for (int m = 0; m < 4; ++m)
#pragma unroll
                    for (int n = 0; n < 2; ++n) acc[a][b][m][n] = (f32x4){0.f, 0.f, 0.f, 0.f};
        cur = nxt; cA = nA; cB = nB; ++ui;
#pragma unroll
        for (int h = 0; h < 2; ++h)
#pragma unroll
            for (int i = 0; i < 2; ++i) vaC[h][i] = vaN[h][i];
        if constexpr (ALIGN_EPI) { if (wr == 1) PG8_BAR; }
    }
    PG8_WAIT_V(0);
    if constexpr (!ALIGN_EPI) { if (wr == 0) PG8_BAR; }
    PG8_BAR;
#undef PG8_SA
#undef PG8_SB
#undef PG8_STAGE
#undef PG8_LDA
#undef PG8_LDB
#undef PG8_MMA
#undef PG8_WAIT_V
#undef PG8_WAIT_L
#undef PG8_BAR
#undef PG8_SCHED
}
}

#define XB_TMO      128
#define XB_XCNT(j)  (256  + 64 * (j))
#define XB_XSUB(j)  (1280 + 64 * (j))
#define XB_XGEN(j)  (2304 + 64 * (j))
#define XB_TOP      3328
#define XB_TOPGEN   3392
#define XCD_BAR_WORDS 3456
#define XB_SPIN_CAP (1u << 18)
__device__ __forceinline__ unsigned xb_ld(unsigned* p)              { return __hip_atomic_load(p, __ATOMIC_RELAXED, __HIP_MEMORY_SCOPE_AGENT); }
__device__ __forceinline__ unsigned xb_add(unsigned* p, unsigned v) { return __hip_atomic_fetch_add(p, v, __ATOMIC_RELAXED, __HIP_MEMORY_SCOPE_AGENT); }
__device__ __forceinline__ unsigned xb_xcc_id() { return (unsigned)__builtin_amdgcn_s_getreg((3 << 11) | 20) & 0xFu; }
#define XB_SPIN(cond, bar) do { unsigned _sp = 0; while (cond) { __builtin_amdgcn_s_sleep(1); \
    if ((++_sp & 255u) == 0u) { if (xb_ld(&(bar)[XB_TMO])) break; if (_sp > XB_SPIN_CAP) { atomicAdd(&(bar)[XB_TMO], 1u); break; } } } } while (0)
struct XcdBarrier { unsigned* bar; unsigned x; volatile LAS unsigned* st; };
__device__ __forceinline__ XcdBarrier xcd_barrier_post(unsigned* bar, volatile LAS unsigned* st) {
    XcdBarrier b; b.bar = bar; b.x = xb_xcc_id(); b.st = st;
    if (threadIdx.x == 0) (void)xb_add(&bar[XB_XCNT(b.x)], 1u);
    return b;
}
__device__ __forceinline__ void xcd_barrier_complete(unsigned* bar, unsigned x, unsigned& nloc, unsigned& nx) {
    const unsigned G = gridDim.x * gridDim.y * gridDim.z;
    unsigned sum, cnt, mine, sp = 0u;
    for (;;) {
        sum = 0u; cnt = 0u; mine = 0u;
#pragma unroll
        for (unsigned j = 0; j < 16; ++j) { const unsigned c = xb_ld(&bar[XB_XCNT(j)]); sum += c; cnt += (c > 0u) ? 1u : 0u; mine = (j == x) ? c : mine; }
        if (sum == G) break;
        __builtin_amdgcn_s_sleep(1);
        if ((++sp & 255u) == 0u) { if (xb_ld(&bar[XB_TMO])) break; if (sp > XB_SPIN_CAP) { atomicAdd(&bar[XB_TMO], 1u); break; } }
    }
    nloc = mine > 0u ? mine : 1u; nx = cnt > 0u ? cnt : 1u;
}
__device__ __forceinline__ void xcd_barrier(const XcdBarrier& b) {
    asm volatile("s_waitcnt vmcnt(0)" ::: "memory");
    __syncthreads();
    if (threadIdx.x == 0) {
        unsigned* bar = b.bar;
        __builtin_amdgcn_s_waitcnt(0);
        unsigned nloc = b.st[0], nx = b.st[1];
        if (nloc == 0u) { xcd_barrier_complete(bar, b.x, nloc, nx); b.st[0] = nloc; b.st[1] = nx; }
        const unsigned old = xb_add(&bar[XB_XSUB(b.x)], 1u);
        const unsigned gen = old / nloc;
        if (old + 1u == (gen + 1u) * nloc) {
            __builtin_amdgcn_fence(__ATOMIC_RELEASE, "agent");
            asm volatile("s_waitcnt vmcnt(0)" ::: "memory");
            const unsigned og = xb_add(&bar[XB_TOP], 1u);
            const unsigned tg = og / nx;
            if (og + 1u == (tg + 1u) * nx) xb_add(&bar[XB_TOPGEN], 1u);
            else XB_SPIN(xb_ld(&bar[XB_TOPGEN]) == tg, bar);
            __builtin_amdgcn_fence(__ATOMIC_ACQUIRE, "agent");
            xb_add(&bar[XB_XGEN(b.x)], 1u);
            asm volatile("s_waitcnt vmcnt(0)" ::: "memory");
        } else {
            XB_SPIN(xb_ld(&bar[XB_XGEN(b.x)]) == gen, bar);
            __builtin_amdgcn_fence(__ATOMIC_ACQUIRE, "agent");
            asm volatile("s_waitcnt vmcnt(0)" ::: "memory");
        }
    }
    __syncthreads();
}

struct MkArgs {
    const float *x, *g_mix, *w_in, *conv_w, *sinks, *g_ao, *g_co, *w_out, *g_ffn, *w_router, *b_router, *w1, *b1, *w2, *b2, *g_final;
    float* out; unsigned char* ws; int ph_lo, ph_hi;
};
struct Frame {
    LAS unsigned char* lds; int tid, lane, wave, G, bx;
};

__device__ __forceinline__ void p0_transpose_item(const float* W, int K, int N, bf16_t* WT, const float* g0, const float* g1, int split, LAS float* scr, int item, int lane) {
    const int nblk = N / 32, kb = item / nblk, nb = item % nblk, k0 = 64 * kb, n0 = 32 * nb;
#pragma unroll 8
    for (int i = 0; i < 32; ++i) { const int kk = 2 * i + (lane >> 5), k = k0 + kk; const float gg = g0 ? (k < split ? g0[k] : g1[k - split]) : 1.f;
        scr[kk * 33 + (lane & 31)] = W[(size_t)k * N + n0 + (lane & 31)] * gg; }
    LDS_WAIT(); asm volatile("" ::: "memory");
    const int c = lane & 7;
#pragma unroll
    for (int j = 0; j < 4; ++j) { const int n = (lane >> 3) + 8 * j; const LAS float* s = scr + (8 * c) * 33 + n;
        u32x4 o; o.x = cvtpk(s[0 * 33], s[1 * 33]); o.y = cvtpk(s[2 * 33], s[3 * 33]); o.z = cvtpk(s[4 * 33], s[5 * 33]); o.w = cvtpk(s[6 * 33], s[7 * 33]);
        *(u32x4*)(WT + (size_t)(n0 + n) * K + k0 + 8 * c) = o; }
    LDS_WAIT(); asm volatile("" ::: "memory");
}
__device__ __forceinline__ void p0_prologue(const Frame& F, const MkArgs& a) {
    unsigned char* ws = a.ws;
    bf16_t* Win_t = (bf16_t*)(ws + WS_WIN); bf16_t* Wout_t = (bf16_t*)(ws + WS_WOUT); float* WR = (float*)(ws + WS_WR);
    bf16_t* W1_t = (bf16_t*)(ws + WS_W1); bf16_t* W2_t = (bf16_t*)(ws + WS_W2); bf16_t* XN = (bf16_t*)(ws + WS_XN);
    LAS float* scr = (LAS float*)(F.lds + RING_OFF + F.wave * 16384);
    const int gw = F.bx * NWAVES + F.wave, NGW = F.G * NWAVES;
    constexpr int I_IN = (DM / 64) * (INC / 32), I_OUT = (DM / 64) * (DM / 32), I_W1E = (DM / 64) * (2048 / 32), I_W2E = (DFF / 64) * (DM / 32);
    constexpr int NITEMS = I_IN + I_OUT + NE * I_W1E + NE * I_W2E;
    for (int it = gw; it < NITEMS; it += NGW) {
        int r = it;
        if (r < I_IN) { p0_transpose_item(a.w_in, DM, INC, Win_t, a.g_mix, a.g_mix, DM, scr, r, F.lane); continue; } r -= I_IN;
        if (r < I_OUT) { p0_transpose_item(a.w_out, DM, DM, Wout_t, a.g_ao, a.g_co, 512, scr, r, F.lane); continue; } r -= I_OUT;
        if (r < NE * I_W1E) { const int e = r / I_W1E; p0_transpose_item(a.w1 + (size_t)e * DM * 2048, DM, 2048, W1_t + (size_t)e * 2048 * DM, a.g_ffn, a.g_ffn, DM, scr, r % I_W1E, F.lane); continue; } r -= NE * I_W1E;
        { const int e = r / I_W2E; p0_transpose_item(a.w2 + (size_t)e * DFF * DM, DFF, DM, W2_t + (size_t)e * DM * DFF, nullptr, nullptr, 0, scr, r % I_W2E, F.lane); }
    }
    for (int i = (F.bx * NTHREADS + F.tid); i < DM * NE; i += F.G * NTHREADS) WR[i] = a.w_router[i] * a.g_ffn[i >> 5];
    for (int m = gw; m < NTOK; m += NGW) {
        const f32x4* xr = (const f32x4*)(a.x + (size_t)m * DM) + F.lane;
        f32x4 v[4]; float s2 = 0.f;
#pragma unroll
        for (int j = 0; j < 4; ++j) { v[j] = xr[64 * j]; s2 += (v[j].x * v[j].x + v[j].y * v[j].y) + (v[j].z * v[j].z + v[j].w * v[j].w); }
        const float rstd = rsqrtf(wave_sum(s2) * (1.f / DM) + EPS);
        u32x2* o8 = (u32x2*)(XN + (size_t)m * DM) + F.lane;
#pragma unroll
        for (int j = 0; j < 4; ++j) { u32x2 w; w.x = cvtpk(v[j].x * rstd, v[j].y * rstd); w.y = cvtpk(v[j].z * rstd, v[j].w * rstd); o8[64 * j] = w; }
    }
}

constexpr int A_KOFF = 0, A_VOFF = 32768, A_WSF = 65536, A_OST = A_WSF + 2048, A_SSQ = A_OST + 32768, A_RSTD = A_SSQ + 4096;
__device__ __forceinline__ int crow(int r, int hi) { return (r & 3) + 8 * (r >> 2) + 4 * hi; }
typedef short v4i16_t __attribute__((ext_vector_type(4)));
__device__ __forceinline__ s16x4 vtr(const LAS unsigned char* p) { return __builtin_bit_cast(s16x4, __builtin_amdgcn_ds_read_tr16_b64_v4i16((LAS v4i16_t*)p)); }

__device__ __forceinline__ void attn_task(const Frame& F, const bf16_t* P, bf16_t* MIX, int row0, int nb, int hk, int g, int qt, float slope2, float sink2) {
    LAS unsigned char* L = F.lds;
    const int lane = F.lane, r32 = lane & 31, hi = lane >> 5, h = hk * 4 + g;
    const bf16_t* Qp = P + (size_t)(row0 + qt * 32 + r32) * INC + h * 64 + hi * 8;
    bf16x8 qr[4];
#pragma unroll
    for (int d0 = 0; d0 < 4; ++d0) qr[d0] = *(const bf16x8*)(Qp + d0 * 16);
    f32x16 p[5];
    const LAS unsigned char* kb = L + A_KOFF + hi * 4096 + r32 * 16 + qt * 512;
#pragma unroll
    for (int j = 0; j < 5; ++j) {
#pragma unroll
        for (int r = 0; r < 16; ++r) p[j][r] = 0.f;
#pragma unroll
        for (int d0 = 0; d0 < 4; ++d0) { const bf16x8 kf = *(const LAS bf16x8*)(kb + d0 * 8192 + j * 512); p[j] = __builtin_amdgcn_mfma_f32_32x32x16_bf16(kf, qr[d0], p[j], 0, 0, 0); }
        __builtin_amdgcn_sched_barrier(0);
    }
    int dl = r32 - 4 * hi; asm volatile("" : "+v"(dl));
    const float basef = slope2 * (float)dl;
    float mx = sink2;
#pragma unroll
    for (int j = 0; j < 5; ++j) {
        const bool dead = (nb == 0) && (qt + j < 4);
#pragma unroll
        for (int r = 0; r < 16; ++r) {
            const int cc = (r & 3) + 8 * (r >> 2);
            bool ok = (j == 0) ? (dl < cc) : ((j == 4) ? (cc <= dl) : true);
            ok = ok && !dead;
            const float v = ok ? ((p[j][r] - basef) - slope2 * (float)(128 - 32 * j - cc)) : -INFINITY;
            p[j][r] = v; mx = fmaxf(mx, v);
        }
    }
    mx = fmaxf(mx, __shfl_xor(mx, 32));
    float sum = 0.f;
#pragma unroll
    for (int j = 0; j < 5; ++j)
#pragma unroll
        for (int r = 0; r < 16; ++r) { const float e = __builtin_amdgcn_exp2f(p[j][r] - mx); p[j][r] = e; sum += e; }
    sum += __shfl_xor(sum, 32);
    const float l = sum + __builtin_amdgcn_exp2f(sink2 - mx);
    f32x16 o[2];
#pragma unroll
    for (int r = 0; r < 16; ++r) { o[0][r] = 0.f; o[1][r] = 0.f; }
    const LAS unsigned char* vb = L + A_VOFF + ((lane >> 4) & 1) * 32 + (lane & 3) * 8 + (4 * hi + ((lane & 15) >> 2)) * 64 + qt * 2048;
#pragma unroll
    for (int j = 0; j < 5; ++j)
#pragma unroll
        for (int s = 0; s < 2; ++s) {
            u32x4 pw; pw.x = cvtpk(p[j][8 * s + 0], p[j][8 * s + 1]); pw.y = cvtpk(p[j][8 * s + 2], p[j][8 * s + 3]); pw.z = cvtpk(p[j][8 * s + 4], p[j][8 * s + 5]); pw.w = cvtpk(p[j][8 * s + 6], p[j][8 * s + 7]);
            const bf16x8 pa = __builtin_bit_cast(bf16x8, pw);
#pragma unroll
            for (int d0 = 0; d0 < 2; ++d0) {
                const LAS unsigned char* ap = vb + d0 * 16384 + (2 * j + s) * 1024;
                const s16x4 lo = vtr(ap), hh = vtr(ap + 512);
                const bf16x8 vf = (bf16x8){lo[0], lo[1], lo[2], lo[3], hh[0], hh[1], hh[2], hh[3]};
                o[d0] = __builtin_amdgcn_mfma_f32_32x32x16_bf16(pa, vf, o[d0], 0, 0, 0);
            }
        }
    LAS float* wsf = (LAS float*)(L + A_WSF) + F.wave * 64;
    if (hi == 0) wsf[r32] = l;
    LDS_WAIT();
    LAS bf16_t* stg = (LAS bf16_t*)(L + A_OST) + F.wave * 2048;
#pragma unroll
    for (int r = 0; r < 16; ++r) { const int c = crow(r, hi); const float rl = __builtin_amdgcn_rcpf(wsf[c]);
        stg[c * 64 + r32] = f2bf(o[0][r] * rl); stg[c * 64 + 32 + r32] = f2bf(o[1][r] * rl); }
    LDS_WAIT();
    LAS float* ssq = (LAS float*)(L + A_SSQ);
#pragma unroll
    for (int i = 0; i < 4; ++i) {
        const int row = i * 8 + (lane >> 3), ch = lane & 7;
        const u32x4 v = *(const LAS u32x4*)(stg + row * 64 + ch * 8);
        *(u32x4*)(MIX + (size_t)(row0 + qt * 32 + row) * DM + h * 64 + ch * 8) = v;
        float s2 = 0.f;
#pragma unroll
        for (int q = 0; q < 4; ++q) { const float a = __uint_as_float(v[q] << 16), b = __uint_as_float(v[q] & 0xffff0000u); s2 += a * a + b * b; }
        s2 += __shfl_xor(s2, 1); s2 += __shfl_xor(s2, 2); s2 += __shfl_xor(s2, 4);
        if (ch == 0) ssq[(qt * 32 + row) * 8 + h] = s2;
    }
    LDS_WAIT();
}

__device__ __forceinline__ void p2_attn_conv(const Frame& F, const MkArgs& a) {
    const bf16_t* P = (const bf16_t*)(a.ws + WS_P); bf16_t* MIX = (bf16_t*)(a.ws + WS_MIX);
    LAS unsigned char* L = F.lds;
    const int tid = F.tid, lane = F.lane, wave = F.wave;
    for (int unit = F.bx; unit < NTOK / 128; unit += F.G) {
        const int b = unit >> 7, nb = unit & 127, row0 = b * SEQ + nb * 128;
        for (int hk = 0; hk < 2; ++hk) {
            __syncthreads();
#pragma unroll
            for (int i = 0; i < 4; ++i) {
                const int idx = tid + 512 * i, key = idx >> 3, ch = idx & 7;
                u32x4 kv = (u32x4){0u, 0u, 0u, 0u}, vv = (u32x4){0u, 0u, 0u, 0u};
                if (nb > 0 || key >= 128) { const bf16_t* src = P + (size_t)(row0 - 128 + key) * INC + 512 + hk * 64 + ch * 8; kv = *(const u32x4*)src; vv = *(const u32x4*)(src + 128); }
                *(LAS u32x4*)(L + A_KOFF + ch * 4096 + key * 16) = kv;
                *(LAS u32x4*)(L + A_VOFF + (ch >> 2) * 16384 + (key >> 4) * 1024 + (key & 15) * 64 + (ch & 3) * 16) = vv;
            }
            __syncthreads();
#pragma unroll 1
            for (int tt = 0; tt < 2; ++tt) {
                const int g = (wave >> 2) + 2 * tt, qt = wave & 3, h = hk * 4 + g;
                const float slope2 = __builtin_amdgcn_exp2f(-(float)(h + 1)) * LOG2E, sink2 = a.sinks[h] * LOG2E;
                attn_task(F, P, MIX, row0, nb, hk, g, qt, slope2, sink2);
            }
        }
        VM_WAIT();
        __syncthreads();
        LAS float* ssq = (LAS float*)(L + A_SSQ); LAS float* rs = (LAS float*)(L + A_RSTD);
        if (tid < 128) { float s = 0.f;
#pragma unroll
            for (int hh = 0; hh < 8; ++hh) s += ssq[tid * 8 + hh];
            rs[tid] = rsqrtf(s * (1.f / ATTW) + EPS); }
        __syncthreads();
#pragma unroll 4
        for (int i = 0; i < 16; ++i) {
            const int idx = tid + 512 * i, row = idx >> 6, ch = idx & 63;
            u32x4* pp = (u32x4*)(MIX + (size_t)(row0 + row) * DM + ch * 8);
            u32x4 v = *pp; const float rr = rs[row];
#pragma unroll
            for (int q = 0; q < 4; ++q) v[q] = cvtpk(__uint_as_float(v[q] << 16) * rr, __uint_as_float(v[q] & 0xffff0000u) * rr);
            *pp = v;
        }
        {
            const int c0 = lane * 8; float cw[3][8];
#pragma unroll
            for (int d = 0; d < 3; ++d) { const f32x4 w0 = *(const f32x4*)(a.conv_w + d * CONVW + c0), w1 = *(const f32x4*)(a.conv_w + d * CONVW + c0 + 4);
                cw[d][0] = w0.x; cw[d][1] = w0.y; cw[d][2] = w0.z; cw[d][3] = w0.w; cw[d][4] = w1.x; cw[d][5] = w1.y; cw[d][6] = w1.z; cw[d][7] = w1.w; }
            const int tl0 = wave * 16, ts0 = nb * 128 + tl0;
            float u2[8], u1[8];
#pragma unroll
            for (int q = 0; q < 8; ++q) { u2[q] = 0.f; u1[q] = 0.f; }
            if (ts0 >= 2) {
                const bf16_t* pr = P + (size_t)(row0 + tl0 - 2) * INC;
                const u32x4 c2 = *(const u32x4*)(pr + 1280 + c0), x2 = *(const u32x4*)(pr + 1792 + c0), c1 = *(const u32x4*)(pr + INC + 1280 + c0), x1 = *(const u32x4*)(pr + INC + 1792 + c0);
#pragma unroll
                for (int q = 0; q < 4; ++q) { u2[2 * q] = __uint_as_float(c2[q] << 16) * __uint_as_float(x2[q] << 16); u2[2 * q + 1] = __uint_as_float(c2[q] & 0xffff0000u) * __uint_as_float(x2[q] & 0xffff0000u);
                    u1[2 * q] = __uint_as_float(c1[q] << 16) * __uint_as_float(x1[q] << 16); u1[2 * q + 1] = __uint_as_float(c1[q] & 0xffff0000u) * __uint_as_float(x1[q] & 0xffff0000u); }
            }
#pragma unroll 4
            for (int r = 0; r < 16; ++r) {
                const bf16_t* pr = P + (size_t)(row0 + tl0 + r) * INC;
                const u32x4 bb = *(const u32x4*)(pr + 768 + c0), cc = *(const u32x4*)(pr + 1280 + c0), xx = *(const u32x4*)(pr + 1792 + c0);
                float y[8], u0[8], s2 = 0.f;
#pragma unroll
                for (int q = 0; q < 4; ++q) {
                    u0[2 * q] = __uint_as_float(cc[q] << 16) * __uint_as_float(xx[q] << 16); u0[2 * q + 1] = __uint_as_float(cc[q] & 0xffff0000u) * __uint_as_float(xx[q] & 0xffff0000u);
                    y[2 * q] = __uint_as_float(bb[q] << 16) * (cw[0][2 * q] * u2[2 * q] + cw[1][2 * q] * u1[2 * q] + cw[2][2 * q] * u0[2 * q]);
                    y[2 * q + 1] = __uint_as_float(bb[q] & 0xffff0000u) * (cw[0][2 * q + 1] * u2[2 * q + 1] + cw[1][2 * q + 1] * u1[2 * q + 1] + cw[2][2 * q + 1] * u0[2 * q + 1]);
                    s2 += y[2 * q] * y[2 * q] + y[2 * q + 1] * y[2 * q + 1];
                }
                const float rc = rsqrtf(wave_sum(s2) * (1.f / CONVW) + EPS);
                u32x4 w; w.x = cvtpk(y[0] * rc, y[1] * rc); w.y = cvtpk(y[2] * rc, y[3] * rc); w.z = cvtpk(y[4] * rc, y[5] * rc); w.w = cvtpk(y[6] * rc, y[7] * rc);
                *(u32x4*)(MIX + (size_t)(row0 + tl0 + r) * DM + 512 + c0) = w;
#pragma unroll
                for (int q = 0; q < 8; ++q) { u2[q] = u1[q]; u1[q] = u0[q]; }
            }
        }
    }
    __syncthreads();
}

constexpr int R_PART = 0, R_RSTD = 2 * 128 * 33 * 4, R_HIST = R_RSTD + 512, R_BASE = R_HIST + 128;
__device__ __forceinline__ void p4_router(const Frame& F, const MkArgs& a) {
    const float* X1 = a.out; const float* WR = (const float*)(a.ws + WS_WR); bf16_t* H2 = (bf16_t*)(a.ws + WS_XN);
    unsigned* gcnt = (unsigned*)(a.ws + WS_CTL) + CW_CNT; int* list = (int*)(a.ws + WS_LIST);
    int* TE = (int*)(a.ws + WS_TE); int* TP = (int*)(a.ws + WS_TP); float* TG = (float*)(a.ws + WS_TG);
    LAS unsigned char* L = F.lds;
    LAS float* part = (LAS float*)(L + R_PART); LAS float* rsl = (LAS float*)(L + R_RSTD); LAS unsigned* hist = (LAS unsigned*)(L + R_HIST); LAS unsigned* gb = (LAS unsigned*)(L + R_BASE);
    const int tid = F.tid, lane = F.lane, wave = F.wave;
    for (int chunk = F.bx; chunk < NTOK / 128; chunk += F.G) {
        const int rowbase = chunk * 128;
        __syncthreads();
        if (tid < 32) hist[tid] = 0u;
        for (int rr = 0; rr < 16; ++rr) {
            const int rl = wave * 16 + rr; const size_t row = (size_t)(rowbase + rl);
            const f32x4* xr = (const f32x4*)(X1 + row * DM) + lane;
            f32x4 v[4]; float s2 = 0.f;
#pragma unroll
            for (int j = 0; j < 4; ++j) { v[j] = xr[64 * j]; s2 += (v[j].x * v[j].x + v[j].y * v[j].y) + (v[j].z * v[j].z + v[j].w * v[j].w); }
            const float rstd = rsqrtf(wave_sum(s2) * (1.f / DM) + EPS);
            u32x2* o8 = (u32x2*)(H2 + row * DM) + lane;
#pragma unroll
            for (int j = 0; j < 4; ++j) { u32x2 w; w.x = cvtpk(v[j].x * rstd, v[j].y * rstd); w.y = cvtpk(v[j].z * rstd, v[j].w * rstd); o8[64 * j] = w; }
            if (lane == 0) rsl[rl] = rstd;
        }
        {
            const int tile = wave & 3, kh = wave >> 2, i = lane & 31, h = lane >> 5;
            const float* xrow = X1 + (size_t)(rowbase + tile * 32 + i) * DM + kh * 512 + 4 * h;
            const float* wrp = WR + (size_t)(kh * 512 + 4 * h) * NE + (lane & 31);
            f32x16 acc;
#pragma unroll
            for (int r = 0; r < 16; ++r) acc[r] = 0.f;
#pragma unroll 2
            for (int kb = 0; kb < 512; kb += 8) {
                const f32x4 xa = *(const f32x4*)(xrow + kb);
                const float b0 = wrp[(kb + 0) * NE], b1 = wrp[(kb + 1) * NE], b2 = wrp[(kb + 2) * NE], b3 = wrp[(kb + 3) * NE];
                acc = __builtin_amdgcn_mfma_f32_32x32x2f32(xa.x, b0, acc, 0, 0, 0);
                acc = __builtin_amdgcn_mfma_f32_32x32x2f32(xa.y, b1, acc, 0, 0, 0);
                acc = __builtin_amdgcn_mfma_f32_32x32x2f32(xa.z, b2, acc, 0, 0, 0);
                acc = __builtin_amdgcn_mfma_f32_32x32x2f32(xa.w, b3, acc, 0, 0, 0);
            }
#pragma unroll
            for (int r = 0; r < 16; ++r) part[(kh * 128 + tile * 32 + crow(r, h)) * 33 + (lane & 31)] = acc[r];
        }
        __syncthreads();
        int ek[4] = {0, 0, 0, 0}; unsigned lp[4] = {0u, 0u, 0u, 0u}; float gk[4] = {0.f, 0.f, 0.f, 0.f};
        if (tid < 128) {
            float lg[32]; const float rstd = rsl[tid];
#pragma unroll
            for (int e = 0; e < 32; ++e) lg[e] = (part[tid * 33 + e] + part[(128 + tid) * 33 + e]) * rstd + a.b_router[e];
            unsigned used = 0u; float val[4];
#pragma unroll
            for (int k = 0; k < 4; ++k) { float best = -INFINITY; int bi = 0;
#pragma unroll
                for (int j = 0; j < 32; ++j) { const bool take = !((used >> j) & 1u) && lg[j] > best; best = take ? lg[j] : best; bi = take ? j : bi; }
                used |= 1u << bi; ek[k] = bi; val[k] = best; }
            float es[4], sum = 0.f;
#pragma unroll
            for (int k = 0; k < 4; ++k) { es[k] = __expf(val[k] - val[0]); sum += es[k]; }
            const float inv = 1.f / sum;
#pragma unroll
            for (int k = 0; k < 4; ++k) { gk[k] = es[k] * inv; lp[k] = atomicAdd((unsigned*)&hist[ek[k]], 1u); }
        }
        __syncthreads();
        if (tid < 32) { const unsigned n = hist[tid]; gb[tid] = n ? atomicAdd(&gcnt[tid], n) : 0u; }
        __syncthreads();
        if (tid < 128) {
            const int tok = rowbase + tid;
#pragma unroll
            for (int k = 0; k < 4; ++k) { const unsigned pos = gb[ek[k]] + lp[k]; list[(size_t)ek[k] * NTOK + pos] = tok; TE[tok * 4 + k] = ek[k]; TP[tok * 4 + k] = (int)pos; TG[tok * 4 + k] = gk[k]; }
        }
    }
    __syncthreads();
}

__device__ __forceinline__ int moe_tables(const Frame& F, const MkArgs& a) {
    LAS int* cnt = (LAS int*)(F.lds + CNT_OFF); LAS int* ts = (LAS int*)(F.lds + TSTART_OFF); LAS int* te = (LAS int*)(F.lds + TILEE_OFF);
    const unsigned* gcnt = (const unsigned*)(a.ws + WS_CTL) + CW_CNT;
    __syncthreads();
    if (F.tid < 32) cnt[F.tid] = (int)__hip_atomic_load(gcnt + F.tid, RLX_AGENT);
    __syncthreads();
    if (F.tid == 0) { int s = 0; for (int e = 0; e < NE; ++e) { ts[e] = s; s += (cnt[e] + 255) >> 8; } ts[32] = s; }
    __syncthreads();
    const int total = ts[32];
    for (int t = F.tid; t < total && t < MAXTILES; t += NTHREADS) { int e = 0;
#pragma unroll 1
        for (int q = 1; q < NE; ++q) e += (ts[q] <= t) ? 1 : 0;
        te[t] = e; }
    __syncthreads();
    return total < MAXTILES ? total : MAXTILES;
}

__device__ __forceinline__ void p7_combine(const Frame& F, const MkArgs& a) {
    const bf16_t* Y = (const bf16_t*)(a.ws + WS_Y); const int* TE = (const int*)(a.ws + WS_TE); const int* TP = (const int*)(a.ws + WS_TP); const float* TG = (const float*)(a.ws + WS_TG);
    LAS int* ts = (LAS int*)(F.lds + TSTART_OFF);
    const int gw = F.bx * NWAVES + F.wave, NGW = F.G * NWAVES, lane = F.lane;
    f32x4 gf[2][2];
#pragma unroll
    for (int j = 0; j < 2; ++j) { gf[j][0] = *(const f32x4*)(a.g_final + 512 * j + 8 * lane); gf[j][1] = *(const f32x4*)(a.g_final + 512 * j + 8 * lane + 4); }
    for (int tok = gw; tok < NTOK; tok += NGW) {
        float* xr = a.out + (size_t)tok * DM + 8 * lane;
        f32x4 v[2][2];
#pragma unroll
        for (int j = 0; j < 2; ++j) { v[j][0] = *(const f32x4*)(xr + 512 * j); v[j][1] = *(const f32x4*)(xr + 512 * j + 4); }
#pragma unroll
        for (int k = 0; k < 4; ++k) {
            const int e = __builtin_amdgcn_readfirstlane(TE[tok * 4 + k]), pos = __builtin_amdgcn_readfirstlane(TP[tok * 4 + k]);
            const float g = __uint_as_float(__builtin_amdgcn_readfirstlane(__float_as_uint(TG[tok * 4 + k])));
            const bf16_t* yr = Y + ((size_t)256 * ts[e] + pos) * DM + 8 * lane;
#pragma unroll
            for (int j = 0; j < 2; ++j) { const u32x4 y = *(const u32x4*)(yr + 512 * j);
                v[j][0].x += g * __uint_as_float(y.x << 16); v[j][0].y += g * __uint_as_float(y.x & 0xffff0000u); v[j][0].z += g * __uint_as_float(y.y << 16); v[j][0].w += g * __uint_as_float(y.y & 0xffff0000u);
                v[j][1].x += g * __uint_as_float(y.z << 16); v[j][1].y += g * __uint_as_float(y.z & 0xffff0000u); v[j][1].z += g * __uint_as_float(y.w << 16); v[j][1].w += g * __uint_as_float(y.w & 0xffff0000u); }
        }
        float s2 = 0.f;
#pragma unroll
        for (int j = 0; j < 2; ++j)
#pragma unroll
            for (int q = 0; q < 2; ++q) s2 += (v[j][q].x * v[j][q].x + v[j][q].y * v[j][q].y) + (v[j][q].z * v[j][q].z + v[j][q].w * v[j][q].w);
        const float rstd = rsqrtf(wave_sum(s2) * (1.f / DM) + EPS);
#pragma unroll
        for (int j = 0; j < 2; ++j)
#pragma unroll
            for (int q = 0; q < 2; ++q) *(f32x4*)(xr + 512 * j + 4 * q) = v[j][q] * rstd * gf[j][q];
    }
}

__global__ void __launch_bounds__(NTHREADS, 2) mk_fwd(MkArgs args) {
    extern __shared__ __attribute__((aligned(16))) unsigned char lds_raw[];
    Frame F;
    F.lds = (LAS unsigned char*)lds_raw;
    F.tid = threadIdx.x; F.lane = F.tid & 63; F.wave = __builtin_amdgcn_readfirstlane(F.tid >> 6); F.G = gridDim.x; F.bx = blockIdx.x;
    volatile LAS unsigned* MISC = (volatile LAS unsigned*)(F.lds + MISC_OFF);
    if (F.tid < 32) MISC[F.tid] = 0u;
    __syncthreads();
    const int lo = args.ph_lo, hi = args.ph_hi;
    unsigned* ctl = (unsigned*)(args.ws + WS_CTL);
    XcdBarrier bar; bar.bar = ctl + CW_BAR; bar.x = 0; bar.st = nullptr;
    if (hi - lo > 1) bar = xcd_barrier_post(ctl + CW_BAR, MISC + 8);
#ifndef PHASE_SEL
#define PHASE_SEL 0xFF
#endif
#define IN(k) (((PHASE_SEL >> (k)) & 1) && lo <= (k) && (k) < hi)
#define SEAM(k) do { if (IN(k) && IN((k) + 1)) xcd_barrier(bar); } while (0)
    unsigned char* ws = args.ws;
    if (IN(0)) { p0_prologue(F, args); }
    SEAM(0);
    if (IN(1)) {
        pg8::ProbDense S{(const bf16_t*)(ws + WS_XN), (const bf16_t*)(ws + WS_WIN), NTOK / 256, INC / 256, F.G, F.bx};
        pg8::EpiP E{(bf16_t*)(ws + WS_P)};
        pg8::gemm_phase<pg8::ProbDense, pg8::EpiP, true>(F.lds + RING_OFF, S, E);
    }
    SEAM(1);
    if (IN(2)) { p2_attn_conv(F, args); }
    SEAM(2);
    if (IN(3)) {
        pg8::ProbDense S{(const bf16_t*)(ws + WS_MIX), (const bf16_t*)(ws + WS_WOUT), NTOK / 256, DM / 256, F.G, F.bx};
        pg8::EpiX1 E{args.x, args.out};
        pg8::gemm_phase<pg8::ProbDense, pg8::EpiX1, true>(F.lds + RING_OFF, S, E);
    }
    SEAM(3);
    if (IN(4)) { p4_router(F, args); }
    SEAM(4);
    if (IN(5)) {
        const int nM = moe_tables(F, args);
        LAS int* te = (LAS int*)(F.lds + TILEE_OFF); LAS int* ts = (LAS int*)(F.lds + TSTART_OFF); LAS int* cnt = (LAS int*)(F.lds + CNT_OFF); LAS unsigned* idtab = (LAS unsigned*)(F.lds + IDTAB_OFF);
        pg8::ProbG1 S{(const bf16_t*)(ws + WS_XN), (const bf16_t*)(ws + WS_W1), nM, F.G, F.bx, te, idtab};
        const int* list = (const int*)(ws + WS_LIST);
        pg8::Unit u;
        for (int i = 0; i < IDTAB_UNITS && S.next(i, u); ++i) {
            if (F.tid < 256) { const int rie = (u.pm - ts[u.e]) * 256 + F.tid; const int tok = rie < cnt[u.e] ? list[(size_t)u.e * NTOK + rie] : 0; idtab[i * 256 + F.tid] = (unsigned)tok * (unsigned)(DM * 2); }
        }
        __syncthreads();
        pg8::EpiAct E{(bf16_t*)(ws + WS_ACT), args.b1};
        pg8::gemm_phase<pg8::ProbG1, pg8::EpiAct, true>(F.lds + RING_OFF, S, E);
    }
    SEAM(5);
    if (IN(6)) {
        const int nM = moe_tables(F, args);
        LAS int* te = (LAS int*)(F.lds + TILEE_OFF);
        pg8::ProbG2 S{(const bf16_t*)(ws + WS_ACT), (const bf16_t*)(ws + WS_W2), nM, F.G, F.bx, te};
        pg8::EpiY E{(bf16_t*)(ws + WS_Y), args.b2};
        pg8::gemm_phase<pg8::ProbG2, pg8::EpiY, true>(F.lds + RING_OFF, S, E);
    }
    SEAM(6);
    if (IN(7)) { (void)moe_tables(F, args); p7_combine(F, args); }
#undef IN
#undef SEAM
}

#ifndef MK_MASK
#define MK_MASK 0xFF
#endif
#ifndef MK_ONE
#define MK_ONE 1
#endif

extern "C" void kernel_launch(void* const* d_in, const int* in_sizes, int n_in, void* d_out, int out_size, void* d_ws, size_t ws_size, hipStream_t stream) {
    if (n_in != 16 || out_size != NTOK * DM || ws_size < WS_END) { fprintf(stderr, "kernel_launch: unexpected shapes (n_in %d out %d ws %zu)\n", n_in, out_size, ws_size); return; }
    const float* x = (const float*)d_in[0]; const float* g_mix = (const float*)d_in[1]; const float* w_in = (const float*)d_in[2]; const float* conv_w = (const float*)d_in[3];
    const float* sinks = (const float*)d_in[4]; const float* g_ao = (const float*)d_in[5]; const float* g_co = (const float*)d_in[6]; const float* w_out = (const float*)d_in[7];
    const float* g_ffn = (const float*)d_in[8]; const float* w_router = (const float*)d_in[9]; const float* b_router = (const float*)d_in[10]; const float* w1 = (const float*)d_in[11];
    const float* b1 = (const float*)d_in[12]; const float* w2 = (const float*)d_in[13]; const float* b2 = (const float*)d_in[14]; const float* g_final = (const float*)d_in[15];
    unsigned char* ws = (unsigned char*)d_ws; float* out = (float*)d_out;
    static int grid = 0;
    if (grid == 0) {
        int dev = 0, cus = 0, per_cu = 0;
        if (hipGetDevice(&dev) != hipSuccess || hipDeviceGetAttribute(&cus, hipDeviceAttributeMultiprocessorCount, dev) != hipSuccess) { fprintf(stderr, "kernel_launch: device query failed\n"); grid = -1; return; }
        if (hipFuncSetAttribute((const void*)mk_fwd, hipFuncAttributeMaxDynamicSharedMemorySize, LDS_BYTES) != hipSuccess) { fprintf(stderr, "kernel_launch: hipFuncSetAttribute failed\n"); grid = -1; return; }
        if (hipOccupancyMaxActiveBlocksPerMultiprocessor(&per_cu, (const void*)mk_fwd, NTHREADS, LDS_BYTES) != hipSuccess || per_cu < 1) { fprintf(stderr, "kernel_launch: occupancy query says %d blocks per CU\n", per_cu); per_cu = 1; }
        (void)hipGetLastError();
        grid = cus;
    }
    if (grid < 0) return;
    (void)hipMemsetAsync(ws + WS_CTL, 0, CTL_BYTES, stream);
    MkArgs a{};
    a.x = x; a.g_mix = g_mix; a.w_in = w_in; a.conv_w = conv_w; a.sinks = sinks; a.g_ao = g_ao; a.g_co = g_co; a.w_out = w_out; a.g_ffn = g_ffn; a.w_router = w_router; a.b_router = b_router;
    a.w1 = w1; a.b1 = b1; a.w2 = w2; a.b2 = b2; a.g_final = g_final; a.out = out; a.ws = ws;
#if MK_ONE
    a.ph_lo = 0; a.ph_hi = 8;
    hipLaunchKernelGGL(mk_fwd, dim3(grid), dim3(NTHREADS), LDS_BYTES, stream, a);
#else
    unsigned* ctl = (unsigned*)(ws + WS_CTL);
    bf16_t* Win_t = (bf16_t*)(ws + WS_WIN); bf16_t* Wout_t = (bf16_t*)(ws + WS_WOUT); float* WR = (float*)(ws + WS_WR); int* list = (int*)(ws + WS_LIST);
    int* TE = (int*)(ws + WS_TE); int* TP = (int*)(ws + WS_TP); float* TG = (float*)(ws + WS_TG); int* tab = (int*)(ws + WS_TAB); float* gcat = (float*)(ws + WS_TAB + 16384);
    bf16_t* W1_t = (bf16_t*)(ws + WS_W1); bf16_t* W2_t = (bf16_t*)(ws + WS_W2); bf16_t* XN = (bf16_t*)(ws + WS_XN); bf16_t* P = (bf16_t*)(ws + WS_P);
    bf16_t* MIX = (bf16_t*)(ws + WS_MIX); bf16_t* ACT = (bf16_t*)(ws + WS_ACT); bf16_t* Y = (bf16_t*)(ws + WS_Y); float* ATT = (float*)(ws + WS_ATT);
    for (int p = 0; p < 8; ++p) {
        if ((MK_MASK >> p) & 1) { a.ph_lo = p; a.ph_hi = p + 1; hipLaunchKernelGGL(mk_fwd, dim3(grid), dim3(NTHREADS), LDS_BYTES, stream, a); continue; }
        switch (p) {
        case 0:
            n_gcat<<<4, 256, 0, stream>>>(g_ao, g_co, gcat);
            n_transpose<<<dim3(DM / 32, INC / 32, 1), dim3(32, 8), 0, stream>>>(w_in, Win_t, DM, INC, g_mix);
            n_transpose<<<dim3(DM / 32, DM / 32, 1), dim3(32, 8), 0, stream>>>(w_out, Wout_t, DM, DM, gcat);
            n_transpose<<<dim3(DM / 32, 2048 / 32, NE), dim3(32, 8), 0, stream>>>(w1, W1_t, DM, 2048, g_ffn);
            n_transpose<<<dim3(DFF / 32, DM / 32, NE), dim3(32, 8), 0, stream>>>(w2, W2_t, DFF, DM, nullptr);
            n_wr<<<DM * NE / 256, 256, 0, stream>>>(w_router, g_ffn, WR);
            n_xn<<<NTOK, 256, 0, stream>>>(x, XN); break;
        case 1: { NG g{}; g.A = XN; g.Bt = Win_t; g.Ob = P; n_gemm<0><<<dim3(NTOK / 128, INC / 128), 256, 0, stream>>>(g); } break;
        case 2: n_attn<<<NTOK * NQH / 4, 256, 0, stream>>>(P, sinks, ATT); n_mix<<<NTOK, 256, 0, stream>>>(P, ATT, conv_w, MIX); break;
        case 3: { NG g{}; g.A = MIX; g.Bt = Wout_t; g.Of = out; g.X = x; n_gemm<1><<<dim3(NTOK / 128, DM / 128), 256, 0, stream>>>(g); } break;
        case 4: n_router<<<NTOK, 256, 0, stream>>>(out, WR, b_router, XN, ctl + CW_CNT, list, TE, TP, TG); break;
        case 5: n_tables<<<1, 64, 0, stream>>>(ctl + CW_CNT, tab);
            { NG g{}; g.A = XN; g.Bt = W1_t; g.Ob = ACT; g.bias = b1; g.list = list; g.cnt = ctl + CW_CNT; g.tab = tab; n_gemm<2><<<dim3(PADROWS / 128, DFF / 128), 256, 0, stream>>>(g); } break;
        case 6: n_tables<<<1, 64, 0, stream>>>(ctl + CW_CNT, tab);
            { NG g{}; g.A = ACT; g.Bt = W2_t; g.Ob = Y; g.bias = b2; g.list = list; g.cnt = ctl + CW_CNT; g.tab = tab; n_gemm<3><<<dim3(PADROWS / 128, DM / 128), 256, 0, stream>>>(g); } break;
        case 7: n_tables<<<1, 64, 0, stream>>>(ctl + CW_CNT, tab); n_combine<<<NTOK, 256, 0, stream>>>(out, Y, TE, TP, TG, tab, g_final, out); break;
        }
    }
#endif
}
```

```cpp
#include <hip/hip_runtime.h>
#include <cstdint>
#include <cstdio>

typedef unsigned short bf16_t;
typedef short bf16x8 __attribute__((ext_vector_type(8)));
typedef float f32x4 __attribute__((ext_vector_type(4)));

constexpr int BATCH = 2, SEQ = 16384, DM = 1024, NTOK = BATCH * SEQ;
constexpr int NQH = 8, HD = 64, ATTW = 512, CONVW = 512, INC = 2304;
constexpr int NE = 32, DFF = 1024;
constexpr int MAXTILES = 544, PADROWS = MAXTILES * 256;
constexpr float EPS = 1e-5f;
constexpr float LOG2E = 1.4426950408889634f;
constexpr float C2 = 0.125f * LOG2E;
constexpr int W8_SHIFT = 5;
constexpr int W8_SCALE_E8M0 = 127 - W8_SHIFT;
#ifndef MOE_FP8
#define MOE_FP8 1
#endif

constexpr size_t MiB = 1u << 20;
constexpr size_t WS_CTL = 0, CTL_BYTES = 64 * 1024;
constexpr size_t WS_WIN = 1 * MiB, WS_WOUT = 6 * MiB, WS_WR = 8 * MiB, WS_LIST = 9 * MiB;
constexpr size_t WS_TE = 13 * MiB, WS_TP = 13 * MiB + 512 * 1024, WS_TG = 14 * MiB, WS_TAB = 14 * MiB + 512 * 1024;
constexpr size_t WS_W1 = 16 * MiB, WS_W2 = 144 * MiB, WS_XN = 208 * MiB, WS_P = 272 * MiB, WS_MIX = 416 * MiB;
constexpr size_t WS_ACT = 272 * MiB, WS_Y = 544 * MiB, WS_ATT = 816 * MiB, WS_DUMMY = 880 * MiB, WS_END = 1016 * MiB;
constexpr int CW_CNT = 0;

__device__ __forceinline__ float bf2f(bf16_t v) { return __uint_as_float((unsigned)v << 16); }
__device__ __forceinline__ bf16_t f2bf(float f) { unsigned u = __float_as_uint(f); return (bf16_t)((u + 0x7fffu + ((u >> 16) & 1u)) >> 16); }

__device__ __forceinline__ float wave_sum(float v) {
#pragma unroll
    for (int o = 1; o < 64; o <<= 1) v += __shfl_xor(v, o);
    return v;
}
__device__ __forceinline__ float wave_max(float v) {
#pragma unroll
    for (int o = 1; o < 64; o <<= 1) v = fmaxf(v, __shfl_xor(v, o));
    return v;
}
__device__ __forceinline__ float block_sum256(float v, float* red) {
    v = wave_sum(v);
    __syncthreads();
    if ((threadIdx.x & 63) == 0) red[threadIdx.x >> 6] = v;
    __syncthreads();
    return red[0] + red[1] + red[2] + red[3];
}

__global__ void n_transpose(const float* W, bf16_t* WT, int K, int N, const float* g) {
    __shared__ float tile[32][33];
    const size_t zoff = (size_t)blockIdx.z * K * N;
    const int k0 = blockIdx.x * 32, n0 = blockIdx.y * 32, tx = threadIdx.x, ty = threadIdx.y;
#pragma unroll
    for (int i = 0; i < 4; ++i) { const int kk = ty + 8 * i; tile[kk][tx] = W[zoff + (size_t)(k0 + kk) * N + n0 + tx] * (g ? g[k0 + kk] : 1.f); }
    __syncthreads();
#pragma unroll
    for (int i = 0; i < 4; ++i) { const int nn = ty + 8 * i; WT[zoff + (size_t)(n0 + nn) * K + k0 + tx] = f2bf(tile[tx][nn]); }
}
__global__ void n_wr(const float* wr, const float* g, float* out) {
    const int i = blockIdx.x * 256 + threadIdx.x; if (i < DM * NE) out[i] = wr[i] * g[i >> 5];
}
__global__ void n_gcat(const float* ga, const float* gc, float* out) { const int i = blockIdx.x * 256 + threadIdx.x; if (i < DM) out[i] = i < 512 ? ga[i] : gc[i - 512]; }
__global__ __launch_bounds__(256) void n_xn(const float* x, bf16_t* XN) {
    __shared__ float red[4];
    const int row = blockIdx.x, t = threadIdx.x;
    const f32x4 v = *(const f32x4*)(x + (size_t)row * DM + 4 * t);
    const float ss = block_sum256(v.x * v.x + v.y * v.y + v.z * v.z + v.w * v.w, red);
    const float rstd = rsqrtf(ss * (1.f / DM) + EPS);
    bf16_t* o = XN + (size_t)row * DM + 4 * t;
    o[0] = f2bf(v.x * rstd); o[1] = f2bf(v.y * rstd); o[2] = f2bf(v.z * rstd); o[3] = f2bf(v.w * rstd);
}

struct NG {
    const bf16_t* A; const bf16_t* Bt; bf16_t* Ob; float* Of; const float* X; const float* bias;
    const int* list; const unsigned* cnt; const int* tab;
};
__device__ __forceinline__ float swiglu(float g, float l) {
    g = fminf(g, 7.f); l = fminf(fmaxf(l, -7.f), 7.f);
    const float s = __builtin_amdgcn_rcpf(1.f + __builtin_amdgcn_exp2f(-1.702f * LOG2E * g));
    return g * s * (l + 1.f);
}
template <int MODE> __global__ __launch_bounds__(256) void n_gemm(NG a) {
    const int lane = threadIdx.x & 63, w = threadIdx.x >> 6, row = lane & 15, quad = lane >> 4;
    const int m0 = blockIdx.x * 128 + (w >> 1) * 64, n0 = blockIdx.y * 128 + (w & 1) * 64;
    int e = 0, rbase = 0, cnt = 0;
    if (MODE >= 2) {
        const int pm = (blockIdx.x * 128) >> 8;
        if (pm >= a.tab[32]) return;
        e = a.tab[64 + pm]; rbase = m0 - 256 * a.tab[e]; cnt = (int)a.cnt[e];
    }
    const bf16_t* ar[4]; const bf16_t* br[4]; const bf16_t* br2[4];
#pragma unroll
    for (int i = 0; i < 4; ++i) {
        const int m = m0 + 16 * i + row;
        if (MODE == 2) { const int rr = rbase + 16 * i + row; const int tok = rr < cnt ? a.list[e * NTOK + rr] : 0; ar[i] = a.A + (size_t)tok * DM; }
        else ar[i] = a.A + (size_t)m * DM;
        const int n = n0 + 16 * i + row;
        if (MODE == 2) { br[i] = a.Bt + ((size_t)e * 2048 + n) * DM; br2[i] = br[i] + (size_t)1024 * DM; }
        else if (MODE == 3) { br[i] = a.Bt + ((size_t)e * 1024 + n) * DM; br2[i] = br[i]; }
        else { br[i] = a.Bt + (size_t)n * DM; br2[i] = br[i]; }
    }
    f32x4 acc[4][4], acc2[4][4];
#pragma unroll
    for (int i = 0; i < 4; ++i)
#pragma unroll
        for (int j = 0; j < 4; ++j) { acc[i][j] = (f32x4){0.f, 0.f, 0.f, 0.f}; acc2[i][j] = (f32x4){0.f, 0.f, 0.f, 0.f}; }
    for (int k0 = 0; k0 < DM; k0 += 32) {
        bf16x8 fa[4], fb[4], fb2[4];
#pragma unroll
        for (int i = 0; i < 4; ++i) { fa[i] = *(const bf16x8*)(ar[i] + k0 + quad * 8); fb[i] = *(const bf16x8*)(br[i] + k0 + quad * 8); if (MODE == 2) fb2[i] = *(const bf16x8*)(br2[i] + k0 + quad * 8); }
#pragma unroll
        for (int i = 0; i < 4; ++i)
#pragma unroll
            for (int j = 0; j < 4; ++j) {
                acc[i][j] = __builtin_amdgcn_mfma_f32_16x16x32_bf16(fa[i], fb[j], acc[i][j], 0, 0, 0);
                if (MODE == 2) acc2[i][j] = __builtin_amdgcn_mfma_f32_16x16x32_bf16(fa[i], fb2[j], acc2[i][j], 0, 0, 0);
            }
    }
#pragma unroll
    for (int i = 0; i < 4; ++i)
#pragma unroll
        for (int j = 0; j < 4; ++j)
#pragma unroll
            for (int r = 0; r < 4; ++r) {
                const int m = m0 + 16 * i + quad * 4 + r, n = n0 + 16 * j + row;
                const float v = acc[i][j][r];
                if (MODE == 0) a.Ob[(size_t)m * INC + n] = f2bf(n < 512 ? v * C2 : v);
                else if (MODE == 1) a.Of[(size_t)m * DM + n] = a.X[(size_t)m * DM + n] + v;
                else if (MODE == 2) a.Ob[(size_t)m * DM + n] = f2bf(swiglu(v + a.bias[e * 2048 + n], acc2[i][j][r] + a.bias[e * 2048 + 1024 + n]));
                else a.Ob[(size_t)m * DM + n] = f2bf(v + a.bias[e * 1024 + n]);
            }
}

__global__ __launch_bounds__(256) void n_attn(const bf16_t* P, const float* sinks, float* ATT) {
    const int gw = blockIdx.x * 4 + (threadIdx.x >> 6), lane = threadIdx.x & 63;
    const int tok = gw >> 3, h = gw & 7, hk = h >> 2, t = tok % SEQ;
    const float slope2 = exp2f(-(float)(h + 1)) * LOG2E, sink2 = sinks[h] * LOG2E;
    float q[64];
    const bf16_t* qp = P + (size_t)tok * INC + h * 64;
#pragma unroll
    for (int d = 0; d < 64; ++d) q[d] = bf2f(qp[d]);
    float s[2];
#pragma unroll
    for (int jj = 0; jj < 2; ++jj) {
        const int j = lane + 64 * jj, kp = t - 127 + j;
        float acc = -INFINITY;
        if (kp >= 0) {
            const bf16_t* kr = P + (size_t)(tok - 127 + j) * INC + 512 + hk * 64;
            acc = 0.f;
#pragma unroll
            for (int d = 0; d < 64; ++d) acc += q[d] * bf2f(kr[d]);
            acc -= slope2 * (float)(127 - j);
        }
        s[jj] = acc;
    }
    const float m = fmaxf(wave_max(fmaxf(s[0], s[1])), sink2);
    const float e0 = exp2f(s[0] - m), e1 = exp2f(s[1] - m);
    const float l = wave_sum(e0 + e1) + exp2f(sink2 - m);
    const float p0 = e0 / l, p1 = e1 / l;
    float o = 0.f;
    for (int j = 0; j < 128; ++j) {
        const float pj = __shfl(j < 64 ? p0 : p1, j & 63);
        if (t - 127 + j >= 0) o += pj * bf2f(P[(size_t)(tok - 127 + j) * INC + 640 + hk * 64 + lane]);
    }
    ATT[(size_t)tok * ATTW + h * 64 + lane] = o;
}
__global__ __launch_bounds__(256) void n_mix(const bf16_t* P, const float* ATT, const float* convw, bf16_t* MIX) {
    __shared__ float red[4];
    const int tok = blockIdx.x, tid = threadIdx.x, t = tok % SEQ;
    const float a0 = ATT[(size_t)tok * ATTW + tid], a1 = ATT[(size_t)tok * ATTW + 256 + tid];
    const float ssa = block_sum256(a0 * a0 + a1 * a1, red);
    const float ra = rsqrtf(ssa * (1.f / ATTW) + EPS);
    MIX[(size_t)tok * DM + tid] = f2bf(a0 * ra); MIX[(size_t)tok * DM + 256 + tid] = f2bf(a1 * ra);
    float y[2];
#pragma unroll
    for (int i = 0; i < 2; ++i) {
        const int c = tid + 256 * i;
        float acc = 0.f;
#pragma unroll
        for (int dt = 0; dt < 3; ++dt) {
            const int tt = t - 2 + dt;
            if (tt >= 0) { const bf16_t* pr = P + (size_t)(tok - 2 + dt) * INC; acc += convw[dt * CONVW + c] * (bf2f(pr[1280 + c]) * bf2f(pr[1792 + c])); }
        }
        y[i] = bf2f(P[(size_t)tok * INC + 768 + c]) * acc;
    }
    const float ssc = block_sum256(y[0] * y[0] + y[1] * y[1], red);
    const float rc = rsqrtf(ssc * (1.f / CONVW) + EPS);
    MIX[(size_t)tok * DM + 512 + tid] = f2bf(y[0] * rc); MIX[(size_t)tok * DM + 768 + tid] = f2bf(y[1] * rc);
}
__global__ __launch_bounds__(256) void n_router(const float* X1, const float* WR, const float* br, bf16_t* H2, unsigned* cnt, int* list, int* TE, int* TP, float* TG) {
    __shared__ float red[4]; __shared__ float xs[DM]; __shared__ float part[8][32]; __shared__ float lg[32];
    const int tok = blockIdx.x, tid = threadIdx.x;
    const f32x4 v = *(const f32x4*)(X1 + (size_t)tok * DM + 4 * tid);
    const float ss = block_sum256(v.x * v.x + v.y * v.y + v.z * v.z + v.w * v.w, red);
    const float rstd = rsqrtf(ss * (1.f / DM) + EPS);
    bf16_t* o = H2 + (size_t)tok * DM + 4 * tid;
    o[0] = f2bf(v.x * rstd); o[1] = f2bf(v.y * rstd); o[2] = f2bf(v.z * rstd); o[3] = f2bf(v.w * rstd);
    xs[4 * tid] = v.x; xs[4 * tid + 1] = v.y; xs[4 * tid + 2] = v.z; xs[4 * tid + 3] = v.w;
    __syncthreads();
    const int e = tid & 31, pt = tid >> 5;
    float acc = 0.f;
    for (int k = pt * 128; k < pt * 128 + 128; ++k) acc += xs[k] * WR[k * NE + e];
    part[pt][e] = acc;
    __syncthreads();
    if (tid < 32) { float sum = 0.f; for (int p = 0; p < 8; ++p) sum += part[p][tid]; lg[tid] = sum * rstd + br[tid]; }
    __syncthreads();
    if (tid == 0) {
        int idx[4]; float val[4]; unsigned used = 0u;
        for (int k = 0; k < 4; ++k) { float best = -INFINITY; int bi = 0; for (int j = 0; j < 32; ++j) if (!((used >> j) & 1u) && lg[j] > best) { best = lg[j]; bi = j; } used |= 1u << bi; idx[k] = bi; val[k] = best; }
        float es[4], sum = 0.f; for (int k = 0; k < 4; ++k) { es[k] = expf(val[k] - val[0]); sum += es[k]; }
        for (int k = 0; k < 4; ++k) {
            const unsigned pos = atomicAdd(&cnt[idx[k]], 1u);
            list[idx[k] * NTOK + pos] = tok; TE[tok * 4 + k] = idx[k]; TP[tok * 4 + k] = (int)pos; TG[tok * 4 + k] = es[k] / sum;
        }
    }
}
__global__ void n_tables(const unsigned* cnt, int* tab) {
    if (threadIdx.x == 0) { int s = 0; for (int e = 0; e < NE; ++e) { tab[e] = s; const int nt = ((int)cnt[e] + 255) >> 8; for (int i = 0; i < nt; ++i) tab[64 + s + i] = e; s += nt; } tab[32] = s; }
}
__global__ __launch_bounds__(256) void n_combine(const float* X1, const bf16_t* Y, const int* TE, const int* TP, const float* TG, const int* tab, const float* gf, float* out) {
    __shared__ float red[4];
    const int tok = blockIdx.x, tid = threadIdx.x;
    f32x4 v = *(const f32x4*)(X1 + (size_t)tok * DM + 4 * tid);
#pragma unroll
    for (int k = 0; k < 4; ++k) {
        const int e = TE[tok * 4 + k]; const size_t slot = (size_t)256 * tab[e] + TP[tok * 4 + k]; const float g = TG[tok * 4 + k];
        const bf16_t* yr = Y + slot * DM + 4 * tid;
        v.x += g * bf2f(yr[0]); v.y += g * bf2f(yr[1]); v.z += g * bf2f(yr[2]); v.w += g * bf2f(yr[3]);
    }
    const float ss = block_sum256(v.x * v.x + v.y * v.y + v.z * v.z + v.w * v.w, red);
    const float rstd = rsqrtf(ss * (1.f / DM) + EPS);
    const f32x4 g4 = *(const f32x4*)(gf + 4 * tid);
    *(f32x4*)(out + (size_t)tok * DM + 4 * tid) = (f32x4){v.x * rstd * g4.x, v.y * rstd * g4.y, v.z * rstd * g4.z, v.w * rstd * g4.w};
}


#define LAS __attribute__((address_space(3)))
#define GAS __attribute__((address_space(1)))
typedef unsigned u32x4 __attribute__((ext_vector_type(4)));
typedef unsigned u32x2 __attribute__((ext_vector_type(2)));
typedef float f32x16 __attribute__((ext_vector_type(16)));
typedef float f32x2 __attribute__((ext_vector_type(2)));
typedef short s16x4 __attribute__((ext_vector_type(4)));
typedef __bf16 bf16x2_t __attribute__((ext_vector_type(2)));
typedef GAS unsigned gu32;
#define RLX_AGENT __ATOMIC_RELAXED, __HIP_MEMORY_SCOPE_AGENT
#define LDS_WAIT() asm volatile("s_waitcnt lgkmcnt(0)" ::: "memory")
#define VM_WAIT() asm volatile("s_waitcnt vmcnt(0)" ::: "memory")

constexpr int NWAVES = 8, NTHREADS = 512;
constexpr int RING_OFF = 0, RING_BYTES = 131072;
constexpr int IDTAB_OFF = RING_BYTES, IDTAB_UNITS = 17, IDTAB_BYTES = IDTAB_UNITS * 1024;
constexpr int TILEE_OFF = IDTAB_OFF + IDTAB_BYTES;
constexpr int TSTART_OFF = TILEE_OFF + 2304;
constexpr int CNT_OFF = TSTART_OFF + 256;
constexpr int MISC_OFF = CNT_OFF + 128;
constexpr int LDS_BYTES = 155648;
static_assert(MISC_OFF + 128 <= LDS_BYTES, "LDS map");
constexpr int CW_BAR = 4096;

__device__ __forceinline__ unsigned cvtpk(float lo, float hi) { f32x2 v = {lo, hi}; bf16x2_t b = __builtin_convertvector(v, bf16x2_t); return __builtin_bit_cast(unsigned, b); }

namespace pg8 {
constexpr int BM = 256, BK = 64, HALF = 128, HTB = HALF * BK * 2, NXCD = 8, WGM = 8, KD = 1024;
typedef int i32x8 __attribute__((ext_vector_type(8)));
typedef int i32x4 __attribute__((ext_vector_type(4)));
__host__ __device__ __forceinline__ int lds_byte(int r, int c) { const int st = (r >> 4) * 2 + (c >> 5), rr = r & 15, cc = c & 31, ob = rr * 64 + cc * 2; return st * 1024 + (ob ^ (((ob >> 9) & 1) << 5)); }
__host__ __device__ __forceinline__ void stage_rc(int b, int& R, int& C) { const int st = b / 1024, sb = b % 1024, swz = sb ^ (((sb >> 9) & 1) << 5); R = (st >> 1) * 16 + swz / 64; C = (st & 1) * 32 + (swz % 64) / 2; }
__host__ __device__ __forceinline__ int perm32(int rho) { const int n = rho >> 4, i = rho & 15; return 8 * (i >> 2) + 4 * n + (i & 3); }
struct Unit { int pm, pn, e; };
__device__ __forceinline__ bool order_next(int i, int G, int c, int nM, int nN, Unit& u) {
    const int nwg = nM * nN; const long L = (long)i * G + c; if (L >= nwg) return false;
    int wgid = (int)L; { const int q = nwg / NXCD, r = nwg % NXCD, xcd = wgid % NXCD, off = wgid / NXCD; wgid = (xcd < r ? xcd * (q + 1) : r * (q + 1) + (xcd - r) * q) + off; }
    const int nig = WGM * nN, gid = wgid / nig, fm = gid * WGM, gsz = (nM - fm) < WGM ? (nM - fm) : WGM;
    u.pm = fm + ((wgid % nig) % gsz); u.pn = (wgid % nig) / gsz; u.e = 0; return true;
}
struct ProbDense {
    static constexpr int KB = KD * 2; static constexpr bool F8 = false;
    static constexpr size_t HSTEPB = (size_t)HALF * KD * 2;
    const bf16_t* A; const bf16_t* Bt; int nM, nN, G, c;
    __device__ __forceinline__ bool next(int i, Unit& u) const { return order_next(i, G, c, nM, nN, u); }
    __device__ __forceinline__ const char* a_base(const Unit& u) const { return (const char*)A + (size_t)u.pm * BM * KD * 2; }
    __device__ __forceinline__ const char* b_base(const Unit& u) const { return (const char*)Bt + (size_t)u.pn * BM * KD * 2; }
    __device__ __forceinline__ void a_offs(int, const Unit&, const int (&Rr)[2], const int (&Cb)[2], unsigned (&va)[2][2]) const {
#pragma unroll
        for (int h = 0; h < 2; ++h)
#pragma unroll
            for (int i = 0; i < 2; ++i) va[h][i] = (unsigned)((Rr[i] + HALF * h) * KD * 2 + Cb[i]);
    }
};
template <bool F8_> struct ProbG1 {
    static constexpr int KB = F8_ ? KD : KD * 2; static constexpr bool F8 = F8_;
    static constexpr size_t HSTEPB = (size_t)1024 * KB;
    const unsigned char* H2; const unsigned char* W1t; int nM, G, c; const LAS int* tile_e; const LAS unsigned* idtab;
    __device__ __forceinline__ bool next(int i, Unit& u) const { if (!order_next(i, G, c, nM, 8, u)) return false; u.e = __builtin_amdgcn_readfirstlane(tile_e[u.pm]); return true; }
    __device__ __forceinline__ const char* a_base(const Unit&) const { return (const char*)H2; }
    __device__ __forceinline__ const char* b_base(const Unit& u) const { return (const char*)W1t + ((size_t)u.e * 2048 + (size_t)u.pn * 128) * KB; }
    __device__ __forceinline__ void a_offs(int ui, const Unit&, const int (&Rr)[2], const int (&Cb)[2], unsigned (&va)[2][2]) const {
        const int uu = ui < IDTAB_UNITS ? ui : IDTAB_UNITS - 1;
#pragma unroll
        for (int h = 0; h < 2; ++h)
#pragma unroll
            for (int i = 0; i < 2; ++i) va[h][i] = idtab[uu * 256 + h * HALF + Rr[i]] + (unsigned)Cb[i];
    }
};
template <bool F8_> struct ProbG2 {
    static constexpr int KB = F8_ ? KD : KD * 2; static constexpr bool F8 = F8_;
    static constexpr size_t HSTEPB = (size_t)HALF * KB;
    const unsigned char* ACT; const unsigned char* W2t; int nM, G, c; const LAS int* tile_e;
    __device__ __forceinline__ bool next(int i, Unit& u) const { if (!order_next(i, G, c, nM, 4, u)) return false; u.e = __builtin_amdgcn_readfirstlane(tile_e[u.pm]); return true; }
    __device__ __forceinline__ const char* a_base(const Unit& u) const { return (const char*)ACT + (size_t)u.pm * BM * KB; }
    __device__ __forceinline__ const char* b_base(const Unit& u) const { return (const char*)W2t + ((size_t)u.e * 1024 + (size_t)u.pn * 256) * KB; }
    __device__ __forceinline__ void a_offs(int, const Unit&, const int (&Rr)[2], const int (&Cb)[2], unsigned (&va)[2][2]) const {
#pragma unroll
        for (int h = 0; h < 2; ++h)
#pragma unroll
            for (int i = 0; i < 2; ++i) va[h][i] = (unsigned)((Rr[i] + HALF * h) * KB + Cb[i]);
    }
};

struct EpiP {
    static constexpr bool PERM = true; bf16_t* O;
    __device__ __forceinline__ void operator()(const f32x4 (&acc)[2][2][4][2], const Unit& u, int wr, int wc, int fr, int fq) const {
        const int row0 = u.pm * BM + wr * 64 + fr, col0 = u.pn * BM + wc * 32 + 8 * fq; const float sc = u.pn < 2 ? C2 : 1.f;
#pragma unroll
        for (int ai = 0; ai < 2; ++ai)
#pragma unroll
            for (int m = 0; m < 4; ++m) { bf16_t* rowp = O + (size_t)(row0 + ai * HALF + m * 16) * INC + col0;
#pragma unroll
                for (int bj = 0; bj < 2; ++bj) { const f32x4 v0 = acc[ai][bj][m][0] * sc, v1 = acc[ai][bj][m][1] * sc;
                    u32x4 w; w.x = cvtpk(v0[0], v0[1]); w.y = cvtpk(v0[2], v0[3]); w.z = cvtpk(v1[0], v1[1]); w.w = cvtpk(v1[2], v1[3]);
                    *(u32x4*)(rowp + bj * HALF) = w; } }
    }
};
struct EpiX1 {
    static constexpr bool PERM = false; const float* X; float* O;
    __device__ __forceinline__ void operator()(const f32x4 (&acc)[2][2][4][2], const Unit& u, int wr, int wc, int fr, int fq) const {
        const int row0 = u.pm * BM + wr * 64 + fr, col0 = u.pn * BM + wc * 32 + 4 * fq;
#pragma unroll
        for (int ai = 0; ai < 2; ++ai)
#pragma unroll
            for (int m = 0; m < 4; ++m) { const size_t off = (size_t)(row0 + ai * HALF + m * 16) * DM + col0;
#pragma unroll
                for (int bj = 0; bj < 2; ++bj)
#pragma unroll
                    for (int n = 0; n < 2; ++n) { const f32x4 xr = *(const f32x4*)(X + off + bj * HALF + n * 16); *(f32x4*)(O + off + bj * HALF + n * 16) = xr + acc[ai][bj][m][n]; } }
    }
};
struct EpiAct {
    static constexpr bool PERM = true; bf16_t* O; const float* b1;
    __device__ __forceinline__ void operator()(const f32x4 (&acc)[2][2][4][2], const Unit& u, int wr, int wc, int fr, int fq) const {
        const int row0 = u.pm * BM + wr * 64 + fr, col0 = u.pn * 128 + wc * 32 + 8 * fq;
        const float* bp = b1 + (size_t)u.e * 2048 + col0;
        const f32x4 bg0 = *(const f32x4*)(bp), bg1 = *(const f32x4*)(bp + 4), bl0 = *(const f32x4*)(bp + 1024), bl1 = *(const f32x4*)(bp + 1028);
#pragma unroll
        for (int ai = 0; ai < 2; ++ai)
#pragma unroll
            for (int m = 0; m < 4; ++m) {
                const f32x4 g0 = acc[ai][0][m][0] + bg0, g1 = acc[ai][0][m][1] + bg1, l0 = acc[ai][1][m][0] + bl0, l1 = acc[ai][1][m][1] + bl1;
                u32x4 w; w.x = cvtpk(swiglu(g0[0], l0[0]), swiglu(g0[1], l0[1])); w.y = cvtpk(swiglu(g0[2], l0[2]), swiglu(g0[3], l0[3]));
                w.z = cvtpk(swiglu(g1[0], l1[0]), swiglu(g1[1], l1[1])); w.w = cvtpk(swiglu(g1[2], l1[2]), swiglu(g1[3], l1[3]));
                *(u32x4*)(O + (size_t)(row0 + ai * HALF + m * 16) * DM + col0) = w; }
    }
};
__device__ __forceinline__ unsigned pack4_fp8(float a, float b, float c, float d) {
    a = fminf(fmaxf(a, -448.f), 448.f); b = fminf(fmaxf(b, -448.f), 448.f); c = fminf(fmaxf(c, -448.f), 448.f); d = fminf(fmaxf(d, -448.f), 448.f);
    int p = __builtin_amdgcn_cvt_pk_fp8_f32(a, b, 0, false); p = __builtin_amdgcn_cvt_pk_fp8_f32(c, d, p, true); return (unsigned)p;
}
struct EpiAct8 {
    static constexpr bool PERM = true; unsigned char* O; const float* b1;
    __device__ __forceinline__ void operator()(const f32x4 (&acc)[2][2][4][2], const Unit& u, int wr, int wc, int fr, int fq) const {
        const int row0 = u.pm * BM + wr * 64 + fr, col0 = u.pn * 128 + wc * 32 + 8 * fq;
        const float* bp = b1 + (size_t)u.e * 2048 + col0;
        const f32x4 bg0 = *(const f32x4*)(bp), bg1 = *(const f32x4*)(bp + 4), bl0 = *(const f32x4*)(bp + 1024), bl1 = *(const f32x4*)(bp + 1028);
#pragma unroll
        for (int ai = 0; ai < 2; ++ai)
#pragma unroll
            for (int m = 0; m < 4; ++m) {
                const f32x4 g0 = acc[ai][0][m][0] + bg0, g1 = acc[ai][0][m][1] + bg1, l0 = acc[ai][1][m][0] + bl0, l1 = acc[ai][1][m][1] + bl1;
                u32x2 w; w.x = pack4_fp8(swiglu(g0[0], l0[0]), swiglu(g0[1], l0[1]), swiglu(g0[2], l0[2]), swiglu(g0[3], l0[3]));
                w.y = pack4_fp8(swiglu(g1[0], l1[0]), swiglu(g1[1], l1[1]), swiglu(g1[2], l1[2]), swiglu(g1[3], l1[3]));
                *(u32x2*)(O + (size_t)(row0 + ai * HALF + m * 16) * DM + col0) = w; }
    }
};
struct EpiY {
    static constexpr bool PERM = true; bf16_t* O; const float* b2;
    __device__ __forceinline__ void operator()(const f32x4 (&acc)[2][2][4][2], const Unit& u, int wr, int wc, int fr, int fq) const {
        const int row0 = u.pm * BM + wr * 64 + fr, col0 = u.pn * BM + wc * 32 + 8 * fq;
        const float* bp = b2 + (size_t)u.e * 1024 + col0;
        f32x4 bv[2][2];
#pragma unroll
        for (int bj = 0; bj < 2; ++bj)
#pragma unroll
            for (int n = 0; n < 2; ++n) bv[bj][n] = *(const f32x4*)(bp + bj * HALF + 4 * n);
#pragma unroll
        for (int ai = 0; ai < 2; ++ai)
#pragma unroll
            for (int m = 0; m < 4; ++m) { bf16_t* rowp = O + (size_t)(row0 + ai * HALF + m * 16) * DM + col0;
#pragma unroll
                for (int bj = 0; bj < 2; ++bj) { const f32x4 v0 = acc[ai][bj][m][0] + bv[bj][0], v1 = acc[ai][bj][m][1] + bv[bj][1];
                    u32x4 w; w.x = cvtpk(v0[0], v0[1]); w.y = cvtpk(v0[2], v0[3]); w.z = cvtpk(v1[0], v1[1]); w.w = cvtpk(v1[2], v1[3]);
                    *(u32x4*)(rowp + bj * HALF) = w; } }
    }
};

template <class Prob, class Epi, bool ALIGN_EPI>
__device__ __forceinline__ void gemm_phase(LAS unsigned char* lds, const Prob& S, const Epi& E) {
    const int tid = threadIdx.x, wid = __builtin_amdgcn_readfirstlane(tid >> 6), lane = tid & 63, wr = wid >> 2, wc = wid & 3, fr = lane & 15, fq = lane >> 4;
    constexpr int KB = Prob::KB, nt = KB / 128; constexpr bool F8 = Prob::F8;
    unsigned voffB[2]; int Rr[2], Cb[2];
#pragma unroll
    for (int i = 0; i < 2; ++i) { int R, C; stage_rc(tid * 16 + i * 8192, R, C); const int Rb = Epi::PERM ? ((R & ~31) + perm32(R & 31)) : R;
        voffB[i] = (unsigned)(Rb * KB + C * 2); Rr[i] = R; Cb[i] = C * 2; }
    constexpr size_t kstep = (size_t)(BK * 2);
    constexpr size_t hstepB = Prob::HSTEPB;
    const unsigned ldsw = (unsigned)wid * 1024u;
    const int aoff = lds_byte(wr * 64 + fr, fq * 8), boff = lds_byte(wc * 32 + fr, fq * 8);
#define PG8_SA(b, h) (((b) * 2 + (h)) * HTB)
#define PG8_SB(b, h) ((4 + (b) * 2 + (h)) * HTB)
#define PG8_STAGE(bufoff, gbase, voff) do { _Pragma("unroll") for (int _i = 0; _i < 2; ++_i) \
        __builtin_amdgcn_global_load_lds((const unsigned*)((const char*)(gbase) + (voff)[_i]), (LAS unsigned*)(lds + (bufoff) + ldsw + _i * 8192), 16, 0, 0); } while (0)
#define PG8_LDA(dst, b, h) do { _Pragma("unroll") for (int m = 0; m < 4; ++m) { const i32x4 x0_ = *(const LAS i32x4*)(lds + PG8_SA(b, h) + aoff + m * 2048), x1_ = *(const LAS i32x4*)(lds + PG8_SA(b, h) + aoff + m * 2048 + 1024); dst[m] = __builtin_shufflevector(x0_, x1_, 0, 1, 2, 3, 4, 5, 6, 7); } } while (0)
#define PG8_LDB(dst, b, h) do { _Pragma("unroll") for (int n = 0; n < 2; ++n) { const i32x4 x0_ = *(const LAS i32x4*)(lds + PG8_SB(b, h) + boff + n * 2048), x1_ = *(const LAS i32x4*)(lds + PG8_SB(b, h) + boff + n * 2048 + 1024); dst[n] = __builtin_shufflevector(x0_, x1_, 0, 1, 2, 3, 4, 5, 6, 7); } } while (0)
#define PG8_MMA(ai, bj, At, Bt) do { __builtin_amdgcn_s_setprio(1); _Pragma("unroll") for (int m = 0; m < 4; ++m) _Pragma("unroll") for (int n = 0; n < 2; ++n) { \
        if constexpr (F8) asm volatile("s_nop 1\n\tv_mfma_scale_f32_16x16x128_f8f6f4 %0, %1, %2, %0, %3, %4 op_sel_hi:[0,0,0]" : "+v"(acc[ai][bj][m][n]) : "v"(Bt[n]), "v"(At[m]), "v"(scw), "v"(sca)); \
        else { acc[ai][bj][m][n] = __builtin_amdgcn_mfma_f32_16x16x32_bf16(__builtin_bit_cast(bf16x8, (i32x4)__builtin_shufflevector(Bt[n], Bt[n], 0, 1, 2, 3)), __builtin_bit_cast(bf16x8, (i32x4)__builtin_shufflevector(At[m], At[m], 0, 1, 2, 3)), acc[ai][bj][m][n], 0, 0, 0); \
               acc[ai][bj][m][n] = __builtin_amdgcn_mfma_f32_16x16x32_bf16(__builtin_bit_cast(bf16x8, (i32x4)__builtin_shufflevector(Bt[n], Bt[n], 4, 5, 6, 7)), __builtin_bit_cast(bf16x8, (i32x4)__builtin_shufflevector(At[m], At[m], 4, 5, 6, 7)), acc[ai][bj][m][n], 0, 0, 0); } } \
        __builtin_amdgcn_s_setprio(0); } while (0)
#define PG8_WAIT_V(n) asm volatile("s_waitcnt vmcnt(" #n ")" ::: "memory")
#define PG8_WAIT_L(n) asm volatile("s_waitcnt lgkmcnt(" #n ")" ::: "memory")
#define PG8_BAR __builtin_amdgcn_s_barrier()
#define PG8_SCHED __builtin_amdgcn_sched_barrier(0)
    Unit cur, nxt; int ui = 0;
    if (!S.next(0, cur)) return;
    unsigned vaC[2][2], vaN[2][2];
    S.a_offs(0, cur, Rr, Cb, vaC);
    f32x4 acc[2][2][4][2];
#pragma unroll
    for (int a = 0; a < 2; ++a)
#pragma unroll
        for (int b = 0; b < 2; ++b)
#pragma unroll
            for (int m = 0; m < 4; ++m)
#pragma unroll
                for (int n = 0; n < 2; ++n) acc[a][b][m][n] = (f32x4){0.f, 0.f, 0.f, 0.f};
    i32x8 At[4], B0[2], B1[2];
    int scw = W8_SCALE_E8M0, sca = 127; asm volatile("" : "+v"(scw), "+v"(sca));
    const char* cA = S.a_base(cur); const char* cB = S.b_base(cur);
    PG8_STAGE(PG8_SB(0, 0), cB, voffB); PG8_STAGE(PG8_SB(0, 1), cB + hstepB, voffB); PG8_STAGE(PG8_SA(0, 0), cA, vaC[0]); PG8_STAGE(PG8_SA(0, 1), cA, vaC[1]);
    if (wr == 1) PG8_BAR;
    PG8_WAIT_V(2); PG8_BAR;
    PG8_STAGE(PG8_SB(1, 0), cB + kstep, voffB); PG8_STAGE(PG8_SA(1, 0), cA + kstep, vaC[0]); PG8_STAGE(PG8_SB(1, 1), cB + hstepB + kstep, voffB);
    PG8_WAIT_V(6); PG8_BAR;
    for (;;) {
        const bool has_next = S.next(ui + 1, nxt);
        const char* nA = has_next ? S.a_base(nxt) : cA; const char* nB = has_next ? S.b_base(nxt) : cB;
        if (has_next) S.a_offs(ui + 1, nxt, Rr, Cb, vaN);
        else {
#pragma unroll
            for (int h = 0; h < 2; ++h)
#pragma unroll
                for (int i = 0; i < 2; ++i) vaN[h][i] = vaC[h][i]; }
#pragma unroll 1
        for (int t = 0; t < nt; t += 2) {
            const bool last = (t == nt - 2);
            const char* a1 = cA + (size_t)(t + 1) * kstep;
            const char* a2 = last ? nA : cA + (size_t)(t + 2) * kstep; const char* b2 = last ? nB : cB + (size_t)(t + 2) * kstep;
            const char* a3 = a2 + kstep; const char* b3 = b2 + kstep;
            unsigned v2[2][2];
#pragma unroll
            for (int h = 0; h < 2; ++h)
#pragma unroll
                for (int i = 0; i < 2; ++i) v2[h][i] = last ? vaN[h][i] : vaC[h][i];
            PG8_LDB(B0, 0, 0); PG8_LDB(B1, 0, 1); PG8_SCHED; PG8_LDA(At, 0, 0); PG8_STAGE(PG8_SA(1, 1), a1, vaC[1]);
            PG8_WAIT_V(8); PG8_WAIT_L(0); PG8_BAR; PG8_MMA(0, 0, At, B0); PG8_MMA(0, 1, At, B1); PG8_BAR; PG8_SCHED;
            PG8_LDA(At, 0, 1); PG8_STAGE(PG8_SB(0, 0), b2, voffB); PG8_STAGE(PG8_SB(0, 1), b2 + hstepB, voffB); PG8_STAGE(PG8_SA(0, 0), a2, v2[0]);
            PG8_WAIT_V(8); PG8_WAIT_L(0); PG8_BAR; PG8_MMA(1, 0, At, B0); PG8_MMA(1, 1, At, B1); PG8_BAR; PG8_SCHED;
            PG8_LDB(B0, 1, 0); PG8_LDB(B1, 1, 1); PG8_SCHED; PG8_LDA(At, 1, 0); PG8_STAGE(PG8_SA(0, 1), a2, v2[1]);
            PG8_WAIT_V(8); PG8_WAIT_L(0); PG8_BAR; PG8_MMA(0, 0, At, B0); PG8_MMA(0, 1, At, B1); PG8_BAR; PG8_SCHED;
            PG8_LDA(At, 1, 1); PG8_STAGE(PG8_SB(1, 0), b3, voffB); PG8_STAGE(PG8_SB(1, 1), b3 + hstepB, voffB); PG8_STAGE(PG8_SA(1, 0), a3, v2[0]);
            PG8_WAIT_V(8); PG8_WAIT_L(0); PG8_BAR; PG8_MMA(1, 0, At, B0); PG8_MMA(1, 1, At, B1); PG8_BAR; PG8_SCHED;
        }
        if constexpr (ALIGN_EPI) { if (wr == 0) PG8_BAR; }
        if constexpr (F8) asm volatile("s_nop 15\n\ts_nop 15" ::: "memory");
        E(acc, cur, wr, wc, fr, fq);
        if (!has_next) break;
#pragma unroll
        for (int a = 0; a < 2; ++a)
#pragma unroll
            for (int b = 0; b < 2; ++b)
#pragma unroll
                for (int m = 0; m < 4; ++m)
#pragma unroll
                    for (int n = 0; n < 2; ++n) acc[a][b][m][n] = (f32x4){0.f, 0.f, 0.f, 0.f};
        cur = nxt; cA = nA; cB = nB; ++ui;
#pragma unroll
        for (int h = 0; h < 2; ++h)
#pragma unroll
            for (int i = 0; i < 2; ++i) vaC[h][i] = vaN[h][i];
        if constexpr (ALIGN_EPI) { if (wr == 1) PG8_BAR; }
    }
    PG8_WAIT_V(0);
    if constexpr (!ALIGN_EPI) { if (wr == 0) PG8_BAR; }
    PG8_BAR;
#undef PG8_SA
#undef PG8_SB
#undef PG8_STAGE
#undef PG8_LDA
#undef PG8_LDB
#undef PG8_MMA
#undef PG8_WAIT_V
#undef PG8_WAIT_L
#undef PG8_BAR
#undef PG8_SCHED
}
}

#define XB_TMO      128
#define XB_XCNT(j)  (256  + 64 * (j))
#define XB_XSUB(j)  (1280 + 64 * (j))
#define XB_XGEN(j)  (2304 + 64 * (j))
#define XB_TOP      3328
#define XB_TOPGEN   3392
#define XCD_BAR_WORDS 3456
#define XB_SPIN_CAP (1u << 18)
__device__ __forceinline__ unsigned xb_ld(unsigned* p)              { return __hip_atomic_load(p, __ATOMIC_RELAXED, __HIP_MEMORY_SCOPE_AGENT); }
__device__ __forceinline__ unsigned xb_add(unsigned* p, unsigned v) { return __hip_atomic_fetch_add(p, v, __ATOMIC_RELAXED, __HIP_MEMORY_SCOPE_AGENT); }
__device__ __forceinline__ unsigned xb_xcc_id() { return (unsigned)__builtin_amdgcn_s_getreg((3 << 11) | 20) & 0xFu; }
#define XB_SPIN(cond, bar) do { unsigned _sp = 0; while (cond) { __builtin_amdgcn_s_sleep(1); \
    if ((++_sp & 255u) == 0u) { if (xb_ld(&(bar)[XB_TMO])) break; if (_sp > XB_SPIN_CAP) { atomicAdd(&(bar)[XB_TMO], 1u); break; } } } } while (0)
struct XcdBarrier { unsigned* bar; unsigned x; volatile LAS unsigned* st; };
__device__ __forceinline__ XcdBarrier xcd_barrier_post(unsigned* bar, volatile LAS unsigned* st) {
    XcdBarrier b; b.bar = bar; b.x = xb_xcc_id(); b.st = st;
    if (threadIdx.x == 0) (void)xb_add(&bar[XB_XCNT(b.x)], 1u);
    return b;
}
__device__ __forceinline__ void xcd_barrier_complete(unsigned* bar, unsigned x, unsigned& nloc, unsigned& nx) {
    const unsigned G = gridDim.x * gridDim.y * gridDim.z;
    unsigned sum, cnt, mine, sp = 0u;
    for (;;) {
        sum = 0u; cnt = 0u; mine = 0u;
#pragma unroll
        for (unsigned j = 0; j < 16; ++j) { const unsigned c = xb_ld(&bar[XB_XCNT(j)]); sum += c; cnt += (c > 0u) ? 1u : 0u; mine = (j == x) ? c : mine; }
        if (sum == G) break;
        __builtin_amdgcn_s_sleep(1);
        if ((++sp & 255u) == 0u) { if (xb_ld(&bar[XB_TMO])) break; if (sp > XB_SPIN_CAP) { atomicAdd(&bar[XB_TMO], 1u); break; } }
    }
    nloc = mine > 0u ? mine : 1u; nx = cnt > 0u ? cnt : 1u;
}
__device__ __forceinline__ void xcd_barrier(const XcdBarrier& b) {
    asm volatile("s_waitcnt vmcnt(0)" ::: "memory");
    __syncthreads();
    if (threadIdx.x == 0) {
        unsigned* bar = b.bar;
        __builtin_amdgcn_s_waitcnt(0);
        unsigned nloc = b.st[0], nx = b.st[1];
        if (nloc == 0u) { xcd_barrier_complete(bar, b.x, nloc, nx); b.st[0] = nloc; b.st[1] = nx; }
        const unsigned old = xb_add(&bar[XB_XSUB(b.x)], 1u);
        const unsigned gen = old / nloc;
        if (old + 1u == (gen + 1u) * nloc) {
            __builtin_amdgcn_fence(__ATOMIC_RELEASE, "agent");
            asm volatile("s_waitcnt vmcnt(0)" ::: "memory");
            const unsigned og = xb_add(&bar[XB_TOP], 1u);
            const unsigned tg = og / nx;
            if (og + 1u == (tg + 1u) * nx) xb_add(&bar[XB_TOPGEN], 1u);
            else XB_SPIN(xb_ld(&bar[XB_TOPGEN]) == tg, bar);
            __builtin_amdgcn_fence(__ATOMIC_ACQUIRE, "agent");
            xb_add(&bar[XB_XGEN(b.x)], 1u);
            asm volatile("s_waitcnt vmcnt(0)" ::: "memory");
        } else {
            XB_SPIN(xb_ld(&bar[XB_XGEN(b.x)]) == gen, bar);
            __builtin_amdgcn_fence(__ATOMIC_ACQUIRE, "agent");
            asm volatile("s_waitcnt vmcnt(0)" ::: "memory");
        }
    }
    __syncthreads();
}

struct MkArgs {
    const float *x, *g_mix, *w_in, *conv_w, *sinks, *g_ao, *g_co, *w_out, *g_ffn, *w_router, *b_router, *w1, *b1, *w2, *b2, *g_final;
    float* out; unsigned char* ws; int ph_lo, ph_hi;
};
struct Frame {
    LAS unsigned char* lds; int tid, lane, wave, G, bx;
};

__device__ __forceinline__ void p0_transpose_item(const float* W, int K, int N, bf16_t* WT, const float* g0, const float* g1, int split, LAS unsigned char* scr, int item, int lane) {
    const int nblk = N / 64, kb = item / nblk, nb = item % nblk, k0 = 64 * kb, n = 64 * nb + lane;
    const float* src = W + (size_t)k0 * N + n;
    float v[64];
#pragma unroll
    for (int i = 0; i < 64; ++i) v[i] = src[(size_t)i * N];
#pragma unroll
    for (int q = 0; q < 8; ++q) {
        float w[8];
#pragma unroll
        for (int i = 0; i < 8; ++i) { const int k = k0 + 8 * q + i; const float gg = g0 ? (k < split ? g0[k] : g1[k - split]) : 1.f; w[i] = v[8 * q + i] * gg; }
        u32x4 o; o.x = cvtpk(w[0], w[1]); o.y = cvtpk(w[2], w[3]); o.z = cvtpk(w[4], w[5]); o.w = cvtpk(w[6], w[7]);
        *(LAS u32x4*)(scr + lane * 128 + ((q ^ (lane & 7)) * 16)) = o;
    }
    LDS_WAIT(); asm volatile("" ::: "memory");
#pragma unroll
    for (int j = 0; j < 8; ++j) {
        const int nl = 8 * j + (lane >> 3), ch = lane & 7;
        const u32x4 o = *(const LAS u32x4*)(scr + nl * 128 + ((ch ^ (nl & 7)) * 16));
        *(u32x4*)(WT + (size_t)(64 * nb + nl) * K + k0 + 8 * ch) = o;
    }
    LDS_WAIT(); asm volatile("" ::: "memory");
}
__device__ __forceinline__ void p0_transpose_item8(const float* W, int K, int N, unsigned char* WT, const float* g0, LAS unsigned char* scr, int item, int lane) {
    const int nblk = N / 64, kb = item / nblk, nb = item % nblk, k0 = 64 * kb, n = 64 * nb + lane;
    const float* src = W + (size_t)k0 * N + n;
    float v[64];
#pragma unroll
    for (int i = 0; i < 64; ++i) v[i] = src[(size_t)i * N];
    constexpr float SC = (float)(1 << W8_SHIFT);
#pragma unroll
    for (int q = 0; q < 4; ++q) {
        float w[16];
#pragma unroll
        for (int i = 0; i < 16; ++i) { const int k = k0 + 16 * q + i; const float gg = g0 ? g0[k] * SC : SC; w[i] = v[16 * q + i] * gg; }
        u32x4 o; o.x = pg8::pack4_fp8(w[0], w[1], w[2], w[3]); o.y = pg8::pack4_fp8(w[4], w[5], w[6], w[7]); o.z = pg8::pack4_fp8(w[8], w[9], w[10], w[11]); o.w = pg8::pack4_fp8(w[12], w[13], w[14], w[15]);
        *(LAS u32x4*)(scr + lane * 64 + ((q ^ ((lane >> 1) & 3)) * 16)) = o;
    }
    LDS_WAIT(); asm volatile("" ::: "memory");
#pragma unroll
    for (int j = 0; j < 4; ++j) {
        const int nl = 16 * j + (lane >> 2), ch = lane & 3;
        const u32x4 o = *(const LAS u32x4*)(scr + nl * 64 + ((ch ^ ((nl >> 1) & 3)) * 16));
        *(u32x4*)(WT + (size_t)(64 * nb + nl) * K + k0 + 16 * ch) = o;
    }
    LDS_WAIT(); asm volatile("" ::: "memory");
}
__device__ __forceinline__ void p0_prologue(const Frame& F, const MkArgs& a) {
    unsigned char* ws = a.ws;
    bf16_t* Win_t = (bf16_t*)(ws + WS_WIN); bf16_t* Wout_t = (bf16_t*)(ws + WS_WOUT); float* WR = (float*)(ws + WS_WR);
    bf16_t* W1_t = (bf16_t*)(ws + WS_W1); bf16_t* W2_t = (bf16_t*)(ws + WS_W2); bf16_t* XN = (bf16_t*)(ws + WS_XN);
    const int gw = F.bx * NWAVES + F.wave, NGW = F.G * NWAVES;
    LAS unsigned char* scr = F.lds + RING_OFF + F.wave * 8192;
    constexpr int I_IN = (DM / 64) * (INC / 64), I_OUT = (DM / 64) * (DM / 64), I_W1E = (DM / 64) * (2048 / 64), I_W2E = (DFF / 64) * (DM / 64);
    constexpr int NITEMS = I_IN + I_OUT + NE * I_W1E + NE * I_W2E;
    for (int it = gw; it < NITEMS; it += NGW) {
        int r = it;
        if (r < I_IN) { p0_transpose_item(a.w_in, DM, INC, Win_t, a.g_mix, a.g_mix, DM, scr, r, F.lane); continue; } r -= I_IN;
        if (r < I_OUT) { p0_transpose_item(a.w_out, DM, DM, Wout_t, a.g_ao, a.g_co, 512, scr, r, F.lane); continue; } r -= I_OUT;
#if MOE_FP8
        if (r < NE * I_W1E) { const int e = r / I_W1E; p0_transpose_item8(a.w1 + (size_t)e * DM * 2048, DM, 2048, (unsigned char*)W1_t + (size_t)e * 2048 * DM, a.g_ffn, scr, r % I_W1E, F.lane); continue; } r -= NE * I_W1E;
        { const int e = r / I_W2E; p0_transpose_item8(a.w2 + (size_t)e * DFF * DM, DFF, DM, (unsigned char*)W2_t + (size_t)e * DM * DFF, nullptr, scr, r % I_W2E, F.lane); }
#else
        if (r < NE * I_W1E) { const int e = r / I_W1E; p0_transpose_item(a.w1 + (size_t)e * DM * 2048, DM, 2048, W1_t + (size_t)e * 2048 * DM, a.g_ffn, a.g_ffn, DM, scr, r % I_W1E, F.lane); continue; } r -= NE * I_W1E;
        { const int e = r / I_W2E; p0_transpose_item(a.w2 + (size_t)e * DFF * DM, DFF, DM, W2_t + (size_t)e * DM * DFF, nullptr, nullptr, 0, scr, r % I_W2E, F.lane); }
#endif
    }
    for (int i = (F.bx * NTHREADS + F.tid); i < DM * NE; i += F.G * NTHREADS) WR[i] = a.w_router[i] * a.g_ffn[i >> 5];
    for (int m0 = 4 * gw; m0 < NTOK; m0 += 4 * NGW) {
        f32x4 v[4][4];
#pragma unroll
        for (int r = 0; r < 4; ++r) { const f32x4* xr = (const f32x4*)(a.x + (size_t)(m0 + r) * DM) + F.lane;
#pragma unroll
            for (int j = 0; j < 4; ++j) v[r][j] = xr[64 * j]; }
#pragma unroll
        for (int r = 0; r < 4; ++r) {
            float s2 = 0.f;
#pragma unroll
            for (int j = 0; j < 4; ++j) s2 += (v[r][j].x * v[r][j].x + v[r][j].y * v[r][j].y) + (v[r][j].z * v[r][j].z + v[r][j].w * v[r][j].w);
            const float rstd = rsqrtf(wave_sum(s2) * (1.f / DM) + EPS);
            u32x2* o8 = (u32x2*)(XN + (size_t)(m0 + r) * DM) + F.lane;
#pragma unroll
            for (int j = 0; j < 4; ++j) { u32x2 w; w.x = cvtpk(v[r][j].x * rstd, v[r][j].y * rstd); w.y = cvtpk(v[r][j].z * rstd, v[r][j].w * rstd); o8[64 * j] = w; }
        }
    }
}

constexpr int A_KOFF = 0, A_VOFF = 32768, A_WSF = 65536, A_OST = A_WSF + 2048, A_SSQ = A_OST + 32768, A_RSTD = A_SSQ + 4096;
__device__ __forceinline__ int crow(int r, int hi) { return (r & 3) + 8 * (r >> 2) + 4 * hi; }
typedef short v4i16_t __attribute__((ext_vector_type(4)));
__device__ __forceinline__ s16x4 vtr(const LAS unsigned char* p) { return __builtin_bit_cast(s16x4, __builtin_amdgcn_ds_read_tr16_b64_v4i16((LAS v4i16_t*)p)); }

__device__ __forceinline__ void attn_task(const Frame& F, const bf16_t* P, bf16_t* MIX, int row0, int nb, int hk, int g, int qt, float slope2, float sink2) {
    LAS unsigned char* L = F.lds;
    const int lane = F.lane, r32 = lane & 31, hi = lane >> 5, h = hk * 4 + g;
    const bf16_t* Qp = P + (size_t)(row0 + qt * 32 + r32) * INC + h * 64 + hi * 8;
    bf16x8 qr[4];
#pragma unroll
    for (int d0 = 0; d0 < 4; ++d0) qr[d0] = *(const bf16x8*)(Qp + d0 * 16);
    f32x16 p[5];
    const LAS unsigned char* kb = L + A_KOFF + hi * 4096 + r32 * 16 + qt * 512;
#pragma unroll
    for (int j = 0; j < 5; ++j) {
#pragma unroll
        for (int r = 0; r < 16; ++r) p[j][r] = 0.f;
#pragma unroll
        for (int d0 = 0; d0 < 4; ++d0) { const bf16x8 kf = *(const LAS bf16x8*)(kb + d0 * 8192 + j * 512); p[j] = __builtin_amdgcn_mfma_f32_32x32x16_bf16(kf, qr[d0], p[j], 0, 0, 0); }
        __builtin_amdgcn_sched_barrier(0);
    }
    int dl = r32 - 4 * hi; asm volatile("" : "+v"(dl));
    const float basef = slope2 * (float)dl;
    float mx = sink2;
#pragma unroll
    for (int j = 0; j < 5; ++j) {
        const bool dead = (nb == 0) && (qt + j < 4);
#pragma unroll
        for (int r = 0; r < 16; ++r) {
            const int cc = (r & 3) + 8 * (r >> 2);
            bool ok = (j == 0) ? (dl < cc) : ((j == 4) ? (cc <= dl) : true);
            ok = ok && !dead;
            const float v = ok ? ((p[j][r] - basef) - slope2 * (float)(128 - 32 * j - cc)) : -INFINITY;
            p[j][r] = v; mx = fmaxf(mx, v);
        }
    }
    mx = fmaxf(mx, __shfl_xor(mx, 32));
    float sum = 0.f;
#pragma unroll
    for (int j = 0; j < 5; ++j)
#pragma unroll
        for (int r = 0; r < 16; ++r) { const float e = __builtin_amdgcn_exp2f(p[j][r] - mx); p[j][r] = e; sum += e; }
    sum += __shfl_xor(sum, 32);
    const float l = sum + __builtin_amdgcn_exp2f(sink2 - mx);
    f32x16 o[2];
#pragma unroll
    for (int r = 0; r < 16; ++r) { o[0][r] = 0.f; o[1][r] = 0.f; }
    const LAS unsigned char* vb = L + A_VOFF + ((lane >> 4) & 1) * 32 + (lane & 3) * 8 + (4 * hi + ((lane & 15) >> 2)) * 64 + qt * 2048;
#pragma unroll
    for (int j = 0; j < 5; ++j)
#pragma unroll
        for (int s = 0; s < 2; ++s) {
            u32x4 pw; pw.x = cvtpk(p[j][8 * s + 0], p[j][8 * s + 1]); pw.y = cvtpk(p[j][8 * s + 2], p[j][8 * s + 3]); pw.z = cvtpk(p[j][8 * s + 4], p[j][8 * s + 5]); pw.w = cvtpk(p[j][8 * s + 6], p[j][8 * s + 7]);
            const bf16x8 pa = __builtin_bit_cast(bf16x8, pw);
#pragma unroll
            for (int d0 = 0; d0 < 2; ++d0) {
                const LAS unsigned char* ap = vb + d0 * 16384 + (2 * j + s) * 1024;
                const s16x4 lo = vtr(ap), hh = vtr(ap + 512);
                const bf16x8 vf = (bf16x8){lo[0], lo[1], lo[2], lo[3], hh[0], hh[1], hh[2], hh[3]};
                o[d0] = __builtin_amdgcn_mfma_f32_32x32x16_bf16(pa, vf, o[d0], 0, 0, 0);
            }
        }
    LAS float* wsf = (LAS float*)(L + A_WSF) + F.wave * 64;
    if (hi == 0) wsf[r32] = l;
    LDS_WAIT();
    LAS bf16_t* stg = (LAS bf16_t*)(L + A_OST) + F.wave * 2048;
#pragma unroll
    for (int r = 0; r < 16; ++r) { const int c = crow(r, hi); const float rl = __builtin_amdgcn_rcpf(wsf[c]);
        stg[c * 64 + r32] = f2bf(o[0][r] * rl); stg[c * 64 + 32 + r32] = f2bf(o[1][r] * rl); }
    LDS_WAIT();
    LAS float* ssq = (LAS float*)(L + A_SSQ);
#pragma unroll
    for (int i = 0; i < 4; ++i) {
        const int row = i * 8 + (lane >> 3), ch = lane & 7;
        const u32x4 v = *(const LAS u32x4*)(stg + row * 64 + ch * 8);
        *(u32x4*)(MIX + (size_t)(row0 + qt * 32 + row) * DM + h * 64 + ch * 8) = v;
        float s2 = 0.f;
#pragma unroll
        for (int q = 0; q < 4; ++q) { const float a = __uint_as_float(v[q] << 16), b = __uint_as_float(v[q] & 0xffff0000u); s2 += a * a + b * b; }
        s2 += __shfl_xor(s2, 1); s2 += __shfl_xor(s2, 2); s2 += __shfl_xor(s2, 4);
        if (ch == 0) ssq[(qt * 32 + row) * 8 + h] = s2;
    }
    LDS_WAIT();
}

__device__ __forceinline__ void p2_attn_conv(const Frame& F, const MkArgs& a) {
    const bf16_t* P = (const bf16_t*)(a.ws + WS_P); bf16_t* MIX = (bf16_t*)(a.ws + WS_MIX);
    LAS unsigned char* L = F.lds;
    const int tid = F.tid, lane = F.lane, wave = F.wave;
    for (int unit = F.bx; unit < NTOK / 128; unit += F.G) {
        const int b = unit >> 7, nb = unit & 127, row0 = b * SEQ + nb * 128;
        for (int hk = 0; hk < 2; ++hk) {
            __syncthreads();
#pragma unroll
            for (int i = 0; i < 4; ++i) {
                const int idx = tid + 512 * i, key = idx >> 3, ch = idx & 7;
                u32x4 kv = (u32x4){0u, 0u, 0u, 0u}, vv = (u32x4){0u, 0u, 0u, 0u};
                if (nb > 0 || key >= 128) { const bf16_t* src = P + (size_t)(row0 - 128 + key) * INC + 512 + hk * 64 + ch * 8; kv = *(const u32x4*)src; vv = *(const u32x4*)(src + 128); }
                *(LAS u32x4*)(L + A_KOFF + ch * 4096 + key * 16) = kv;
                *(LAS u32x4*)(L + A_VOFF + (ch >> 2) * 16384 + (key >> 4) * 1024 + (key & 15) * 64 + (ch & 3) * 16) = vv;
            }
            __syncthreads();
#pragma unroll 1
            for (int tt = 0; tt < 2; ++tt) {
                const int g = (wave >> 2) + 2 * tt, qt = wave & 3, h = hk * 4 + g;
                const float slope2 = __builtin_amdgcn_exp2f(-(float)(h + 1)) * LOG2E, sink2 = a.sinks[h] * LOG2E;
                attn_task(F, P, MIX, row0, nb, hk, g, qt, slope2, sink2);
            }
        }
        VM_WAIT();
        __syncthreads();
        LAS float* ssq = (LAS float*)(L + A_SSQ); LAS float* rs = (LAS float*)(L + A_RSTD);
        if (tid < 128) { float s = 0.f;
#pragma unroll
            for (int hh = 0; hh < 8; ++hh) s += ssq[tid * 8 + hh];
            rs[tid] = rsqrtf(s * (1.f / ATTW) + EPS); }
        __syncthreads();
#pragma unroll 4
        for (int i = 0; i < 16; ++i) {
            const int idx = tid + 512 * i, row = idx >> 6, ch = idx & 63;
            u32x4* pp = (u32x4*)(MIX + (size_t)(row0 + row) * DM + ch * 8);
            u32x4 v = *pp; const float rr = rs[row];
#pragma unroll
            for (int q = 0; q < 4; ++q) v[q] = cvtpk(__uint_as_float(v[q] << 16) * rr, __uint_as_float(v[q] & 0xffff0000u) * rr);
            *pp = v;
        }
        {
            const int c0 = lane * 8; float cw[3][8];
#pragma unroll
            for (int d = 0; d < 3; ++d) { const f32x4 w0 = *(const f32x4*)(a.conv_w + d * CONVW + c0), w1 = *(const f32x4*)(a.conv_w + d * CONVW + c0 + 4);
                cw[d][0] = w0.x; cw[d][1] = w0.y; cw[d][2] = w0.z; cw[d][3] = w0.w; cw[d][4] = w1.x; cw[d][5] = w1.y; cw[d][6] = w1.z; cw[d][7] = w1.w; }
            const int tl0 = wave * 16, ts0 = nb * 128 + tl0;
            float u2[8], u1[8];
#pragma unroll
            for (int q = 0; q < 8; ++q) { u2[q] = 0.f; u1[q] = 0.f; }
            if (ts0 >= 2) {
                const bf16_t* pr = P + (size_t)(row0 + tl0 - 2) * INC;
                const u32x4 c2 = *(const u32x4*)(pr + 1280 + c0), x2 = *(const u32x4*)(pr + 1792 + c0), c1 = *(const u32x4*)(pr + INC + 1280 + c0), x1 = *(const u32x4*)(pr + INC + 1792 + c0);
#pragma unroll
                for (int q = 0; q < 4; ++q) { u2[2 * q] = __uint_as_float(c2[q] << 16) * __uint_as_float(x2[q] << 16); u2[2 * q + 1] = __uint_as_float(c2[q] & 0xffff0000u) * __uint_as_float(x2[q] & 0xffff0000u);
                    u1[2 * q] = __uint_as_float(c1[q] << 16) * __uint_as_float(x1[q] << 16); u1[2 * q + 1] = __uint_as_float(c1[q] & 0xffff0000u) * __uint_as_float(x1[q] & 0xffff0000u); }
            }
#pragma unroll 4
            for (int r = 0; r < 16; ++r) {
                const bf16_t* pr = P + (size_t)(row0 + tl0 + r) * INC;
                const u32x4 bb = *(const u32x4*)(pr + 768 + c0), cc = *(const u32x4*)(pr + 1280 + c0), xx = *(const u32x4*)(pr + 1792 + c0);
                float y[8], u0[8], s2 = 0.f;
#pragma unroll
                for (int q = 0; q < 4; ++q) {
                    u0[2 * q] = __uint_as_float(cc[q] << 16) * __uint_as_float(xx[q] << 16); u0[2 * q + 1] = __uint_as_float(cc[q] & 0xffff0000u) * __uint_as_float(xx[q] & 0xffff0000u);
                    y[2 * q] = __uint_as_float(bb[q] << 16) * (cw[0][2 * q] * u2[2 * q] + cw[1][2 * q] * u1[2 * q] + cw[2][2 * q] * u0[2 * q]);
                    y[2 * q + 1] = __uint_as_float(bb[q] & 0xffff0000u) * (cw[0][2 * q + 1] * u2[2 * q + 1] + cw[1][2 * q + 1] * u1[2 * q + 1] + cw[2][2 * q + 1] * u0[2 * q + 1]);
                    s2 += y[2 * q] * y[2 * q] + y[2 * q + 1] * y[2 * q + 1];
                }
                const float rc = rsqrtf(wave_sum(s2) * (1.f / CONVW) + EPS);
                u32x4 w; w.x = cvtpk(y[0] * rc, y[1] * rc); w.y = cvtpk(y[2] * rc, y[3] * rc); w.z = cvtpk(y[4] * rc, y[5] * rc); w.w = cvtpk(y[6] * rc, y[7] * rc);
                *(u32x4*)(MIX + (size_t)(row0 + tl0 + r) * DM + 512 + c0) = w;
#pragma unroll
                for (int q = 0; q < 8; ++q) { u2[q] = u1[q]; u1[q] = u0[q]; }
            }
        }
    }
    __syncthreads();
}

constexpr int R_PART = 0, R_RSTD = 2 * 128 * 33 * 4, R_HIST = R_RSTD + 512, R_BASE = R_HIST + 128;
__device__ __forceinline__ void p4_router(const Frame& F, const MkArgs& a, bool dummy) {
    const float* X1 = a.out; const float* WR = (const float*)(a.ws + WS_WR); bf16_t* H2 = (bf16_t*)(a.ws + WS_XN);
    unsigned* gcnt = (unsigned*)(a.ws + WS_CTL) + CW_CNT + (dummy ? 64 : 0); int* list = (int*)(a.ws + (dummy ? WS_DUMMY : WS_LIST));
    int* TE = (int*)(a.ws + (dummy ? WS_DUMMY + 8 * MiB : WS_TE)); int* TP = (int*)(a.ws + (dummy ? WS_DUMMY + 9 * MiB : WS_TP)); float* TG = (float*)(a.ws + (dummy ? WS_DUMMY + 10 * MiB : WS_TG));
    LAS unsigned char* L = F.lds;
    LAS float* part = (LAS float*)(L + R_PART); LAS float* rsl = (LAS float*)(L + R_RSTD); LAS unsigned* hist = (LAS unsigned*)(L + R_HIST); LAS unsigned* gb = (LAS unsigned*)(L + R_BASE);
    const int tid = F.tid, lane = F.lane, wave = F.wave;
    for (int chunk = F.bx; chunk < NTOK / 128; chunk += F.G) {
        const int rowbase = chunk * 128;
        __syncthreads();
        if (tid < 32) hist[tid] = 0u;
        for (int r4 = 0; r4 < 16; r4 += 4) {
            f32x4 v[4][4];
#pragma unroll
            for (int r = 0; r < 4; ++r) { const f32x4* xr = (const f32x4*)(X1 + (size_t)(rowbase + wave * 16 + r4 + r) * DM) + lane;
#pragma unroll
                for (int j = 0; j < 4; ++j) v[r][j] = xr[64 * j]; }
#pragma unroll
            for (int r = 0; r < 4; ++r) {
                const int rl = wave * 16 + r4 + r; float s2 = 0.f;
#pragma unroll
                for (int j = 0; j < 4; ++j) s2 += (v[r][j].x * v[r][j].x + v[r][j].y * v[r][j].y) + (v[r][j].z * v[r][j].z + v[r][j].w * v[r][j].w);
                const float rstd = rsqrtf(wave_sum(s2) * (1.f / DM) + EPS);
#if MOE_FP8
                unsigned* o4 = (unsigned*)((unsigned char*)H2 + (size_t)(rowbase + rl) * DM) + lane;
#pragma unroll
                for (int j = 0; j < 4; ++j) o4[64 * j] = pg8::pack4_fp8(v[r][j].x * rstd, v[r][j].y * rstd, v[r][j].z * rstd, v[r][j].w * rstd);
#else
                u32x2* o8 = (u32x2*)(H2 + (size_t)(rowbase + rl) * DM) + lane;
#pragma unroll
                for (int j = 0; j < 4; ++j) { u32x2 w; w.x = cvtpk(v[r][j].x * rstd, v[r][j].y * rstd); w.y = cvtpk(v[r][j].z * rstd, v[r][j].w * rstd); o8[64 * j] = w; }
#endif
                if (lane == 0) rsl[rl] = rstd;
            }
        }
        {
            const int tile = wave & 3, kh = wave >> 2, i = lane & 31, h = lane >> 5;
            const float* xrow = X1 + (size_t)(rowbase + tile * 32 + i) * DM + kh * 512 + 4 * h;
            const float* wrp = WR + (size_t)(kh * 512 + 4 * h) * NE + (lane & 31);
            f32x16 acc;
#pragma unroll
            for (int r = 0; r < 16; ++r) acc[r] = 0.f;
#pragma unroll 8
            for (int kb = 0; kb < 512; kb += 8) {
                const f32x4 xa = *(const f32x4*)(xrow + kb);
                const float b0 = wrp[(kb + 0) * NE], b1 = wrp[(kb + 1) * NE], b2 = wrp[(kb + 2) * NE], b3 = wrp[(kb + 3) * NE];
                acc = __builtin_amdgcn_mfma_f32_32x32x2f32(xa.x, b0, acc, 0, 0, 0);
                acc = __builtin_amdgcn_mfma_f32_32x32x2f32(xa.y, b1, acc, 0, 0, 0);
                acc = __builtin_amdgcn_mfma_f32_32x32x2f32(xa.z, b2, acc, 0, 0, 0);
                acc = __builtin_amdgcn_mfma_f32_32x32x2f32(xa.w, b3, acc, 0, 0, 0);
            }
#pragma unroll
            for (int r = 0; r < 16; ++r) part[(kh * 128 + tile * 32 + crow(r, h)) * 33 + (lane & 31)] = acc[r];
        }
        __syncthreads();
        int ek[4] = {0, 0, 0, 0}; unsigned lp[4] = {0u, 0u, 0u, 0u}; float gk[4] = {0.f, 0.f, 0.f, 0.f};
        if (tid < 128) {
            float lg[32]; const float rstd = rsl[tid];
#pragma unroll
            for (int e = 0; e < 32; ++e) lg[e] = (part[tid * 33 + e] + part[(128 + tid) * 33 + e]) * rstd + a.b_router[e];
            unsigned used = 0u; float val[4];
#pragma unroll
            for (int k = 0; k < 4; ++k) { float best = -INFINITY; int bi = 0;
#pragma unroll
                for (int j = 0; j < 32; ++j) { const bool take = !((used >> j) & 1u) && lg[j] > best; best = take ? lg[j] : best; bi = take ? j : bi; }
                used |= 1u << bi; ek[k] = bi; val[k] = best; }
            float es[4], sum = 0.f;
#pragma unroll
            for (int k = 0; k < 4; ++k) { es[k] = __expf(val[k] - val[0]); sum += es[k]; }
            const float inv = 1.f / sum;
#pragma unroll
            for (int k = 0; k < 4; ++k) { gk[k] = es[k] * inv; lp[k] = atomicAdd((unsigned*)&hist[ek[k]], 1u); }
        }
        __syncthreads();
        if (tid < 32) { const unsigned n = hist[tid]; gb[tid] = n ? atomicAdd(&gcnt[tid], n) : 0u; }
        __syncthreads();
        if (tid < 128) {
            const int tok = rowbase + tid;
#pragma unroll
            for (int k = 0; k < 4; ++k) { const unsigned pos = gb[ek[k]] + lp[k]; list[(size_t)ek[k] * NTOK + pos] = tok; TE[tok * 4 + k] = ek[k]; TP[tok * 4 + k] = (int)pos; TG[tok * 4 + k] = gk[k]; }
        }
    }
    __syncthreads();
}

__device__ __forceinline__ int moe_tables(const Frame& F, const MkArgs& a) {
    LAS int* cnt = (LAS int*)(F.lds + CNT_OFF); LAS int* ts = (LAS int*)(F.lds + TSTART_OFF); LAS int* te = (LAS int*)(F.lds + TILEE_OFF);
    const unsigned* gcnt = (const unsigned*)(a.ws + WS_CTL) + CW_CNT;
    __syncthreads();
    if (F.tid < 32) cnt[F.tid] = (int)__hip_atomic_load(gcnt + F.tid, RLX_AGENT);
    __syncthreads();
    if (F.tid == 0) { int s = 0; for (int e = 0; e < NE; ++e) { ts[e] = s; s += (cnt[e] + 255) >> 8; } ts[32] = s; }
    __syncthreads();
    const int total = ts[32];
    for (int t = F.tid; t < total && t < MAXTILES; t += NTHREADS) { int e = 0;
#pragma unroll 1
        for (int q = 1; q < NE; ++q) e += (ts[q] <= t) ? 1 : 0;
        te[t] = e; }
    __syncthreads();
    return total < MAXTILES ? total : MAXTILES;
}

__device__ __forceinline__ void p7_combine(const Frame& F, const MkArgs& a, bool dummy) {
    float* const dst = dummy ? (float*)(a.ws + WS_DUMMY) : a.out;
    const bf16_t* Y = (const bf16_t*)(a.ws + WS_Y); const int* TE = (const int*)(a.ws + WS_TE); const int* TP = (const int*)(a.ws + WS_TP); const float* TG = (const float*)(a.ws + WS_TG);
    LAS int* ts = (LAS int*)(F.lds + TSTART_OFF);
    const int gw = F.bx * NWAVES + F.wave, NGW = F.G * NWAVES, lane = F.lane, l7 = lane & 7;
    f32x4 gf[2][2];
#pragma unroll
    for (int j = 0; j < 2; ++j) { gf[j][0] = *(const f32x4*)(a.g_final + 512 * j + 8 * lane); gf[j][1] = *(const f32x4*)(a.g_final + 512 * j + 8 * lane + 4); }
    int t0 = 2 * gw;
    int e_c = 0, p_c = 0; float g_c = 0.f;
    if (t0 < NTOK) { e_c = TE[t0 * 4 + l7]; p_c = TP[t0 * 4 + l7]; g_c = TG[t0 * 4 + l7]; }
    for (; t0 < NTOK; t0 += 2 * NGW) {
        const int slot_l = 256 * ts[e_c & 31] + p_c; const float g_l = g_c;
        const int tn = t0 + 2 * NGW;
        if (tn < NTOK) { e_c = TE[tn * 4 + l7]; p_c = TP[tn * 4 + l7]; g_c = TG[tn * 4 + l7]; }
        f32x4 v[2][2][2]; u32x4 y[2][4][2]; float gk[2][4];
#pragma unroll
        for (int tt = 0; tt < 2; ++tt) {
            const float* xr = a.out + (size_t)(t0 + tt) * DM + 8 * lane;
#pragma unroll
            for (int j = 0; j < 2; ++j) { v[tt][j][0] = *(const f32x4*)(xr + 512 * j); v[tt][j][1] = *(const f32x4*)(xr + 512 * j + 4); }
#pragma unroll
            for (int k = 0; k < 4; ++k) {
                const int slot = __builtin_amdgcn_readlane(slot_l, tt * 4 + k);
                gk[tt][k] = __uint_as_float(__builtin_amdgcn_readlane(__float_as_uint(g_l), tt * 4 + k));
                const bf16_t* yr = Y + (size_t)slot * DM + 8 * lane;
                y[tt][k][0] = *(const u32x4*)(yr); y[tt][k][1] = *(const u32x4*)(yr + 512);
            }
        }
#pragma unroll
        for (int tt = 0; tt < 2; ++tt) {
#pragma unroll
            for (int k = 0; k < 4; ++k) { const float g = gk[tt][k];
#pragma unroll
                for (int j = 0; j < 2; ++j) { const u32x4 yy = y[tt][k][j];
                    v[tt][j][0].x += g * __uint_as_float(yy.x << 16); v[tt][j][0].y += g * __uint_as_float(yy.x & 0xffff0000u); v[tt][j][0].z += g * __uint_as_float(yy.y << 16); v[tt][j][0].w += g * __uint_as_float(yy.y & 0xffff0000u);
                    v[tt][j][1].x += g * __uint_as_float(yy.z << 16); v[tt][j][1].y += g * __uint_as_float(yy.z & 0xffff0000u); v[tt][j][1].z += g * __uint_as_float(yy.w << 16); v[tt][j][1].w += g * __uint_as_float(yy.w & 0xffff0000u); } }
            float s2 = 0.f;
#pragma unroll
            for (int j = 0; j < 2; ++j)
#pragma unroll
                for (int q = 0; q < 2; ++q) s2 += (v[tt][j][q].x * v[tt][j][q].x + v[tt][j][q].y * v[tt][j][q].y) + (v[tt][j][q].z * v[tt][j][q].z + v[tt][j][q].w * v[tt][j][q].w);
            const float rstd = rsqrtf(wave_sum(s2) * (1.f / DM) + EPS);
            float* xr = dst + (size_t)(t0 + tt) * DM + 8 * lane;
#pragma unroll
            for (int j = 0; j < 2; ++j)
#pragma unroll
                for (int q = 0; q < 2; ++q) *(f32x4*)(xr + 512 * j + 4 * q) = v[tt][j][q] * rstd * gf[j][q];
        }
    }
}

__global__ void __launch_bounds__(NTHREADS, 2) mk_fwd(MkArgs args) {
    extern __shared__ __attribute__((aligned(16))) unsigned char lds_raw[];
    Frame F;
    F.lds = (LAS unsigned char*)lds_raw;
    F.tid = threadIdx.x; F.lane = F.tid & 63; F.wave = __builtin_amdgcn_readfirstlane(F.tid >> 6); F.G = gridDim.x; F.bx = blockIdx.x;
    volatile LAS unsigned* MISC = (volatile LAS unsigned*)(F.lds + MISC_OFF);
    if (F.tid < 32) MISC[F.tid] = 0u;
    __syncthreads();
    const int lo = args.ph_lo, hi = args.ph_hi;
    unsigned* ctl = (unsigned*)(args.ws + WS_CTL);
    XcdBarrier bar; bar.bar = ctl + CW_BAR; bar.x = 0; bar.st = nullptr;
    if (hi - lo > 1) bar = xcd_barrier_post(ctl + CW_BAR, MISC + 8);
#ifndef PHASE_SEL
#define PHASE_SEL 0xFF
#endif
#define IN(k) (((PHASE_SEL >> (k)) & 1) && lo <= (k) && (k) < hi)
#define SEAM(k) do { if (IN(k) && IN((k) + 1)) xcd_barrier(bar); } while (0)
#ifndef REP_MASK
#define REP_MASK 0
#endif
#define REPS(k) for (int rep_ = 0; rep_ < (((REP_MASK >> (k)) & 1) ? 2 : 1); ++rep_)
    unsigned char* ws = args.ws;
    if (IN(0)) REPS(0) { p0_prologue(F, args); }
    SEAM(0);
    if (IN(1)) REPS(1) {
        pg8::ProbDense S{(const bf16_t*)(ws + WS_XN), (const bf16_t*)(ws + WS_WIN), NTOK / 256, INC / 256, F.G, F.bx};
        pg8::EpiP E{(bf16_t*)(ws + WS_P)};
        pg8::gemm_phase<pg8::ProbDense, pg8::EpiP, true>(F.lds + RING_OFF, S, E);
    }
    SEAM(1);
    if (IN(2)) REPS(2) { p2_attn_conv(F, args); }
    SEAM(2);
    if (IN(3)) REPS(3) {
        pg8::ProbDense S{(const bf16_t*)(ws + WS_MIX), (const bf16_t*)(ws + WS_WOUT), NTOK / 256, DM / 256, F.G, F.bx};
        pg8::EpiX1 E{args.x, args.out};
        pg8::gemm_phase<pg8::ProbDense, pg8::EpiX1, true>(F.lds + RING_OFF, S, E);
    }
    SEAM(3);
    if (IN(4)) REPS(4) { p4_router(F, args, ((REP_MASK >> 4) & 1) && rep_ == 0); }
    SEAM(4);
    if (IN(5)) REPS(5) {
        const int nM = moe_tables(F, args);
        LAS int* te = (LAS int*)(F.lds + TILEE_OFF); LAS int* ts = (LAS int*)(F.lds + TSTART_OFF); LAS int* cnt = (LAS int*)(F.lds + CNT_OFF); LAS unsigned* idtab = (LAS unsigned*)(F.lds + IDTAB_OFF);
        pg8::ProbG1<MOE_FP8 != 0> S{(const unsigned char*)(ws + WS_XN), (const unsigned char*)(ws + WS_W1), nM, F.G, F.bx, te, idtab};
        const int* list = (const int*)(ws + WS_LIST);
        pg8::Unit u;
        for (int i = 0; i < IDTAB_UNITS && S.next(i, u); ++i) {
            if (F.tid < 256) { const int rie = (u.pm - ts[u.e]) * 256 + F.tid; const int tok = rie < cnt[u.e] ? list[(size_t)u.e * NTOK + rie] : 0; idtab[i * 256 + F.tid] = (unsigned)tok * (unsigned)(pg8::ProbG1<MOE_FP8 != 0>::KB); }
        }
        __syncthreads();
#if MOE_FP8
        pg8::EpiAct8 E{(unsigned char*)(ws + WS_ACT), args.b1};
        pg8::gemm_phase<pg8::ProbG1<true>, pg8::EpiAct8, true>(F.lds + RING_OFF, S, E);
#else
        pg8::EpiAct E{(bf16_t*)(ws + WS_ACT), args.b1};
        pg8::gemm_phase<pg8::ProbG1<false>, pg8::EpiAct, true>(F.lds + RING_OFF, S, E);
#endif
    }
    SEAM(5);
    if (IN(6)) REPS(6) {
        const int nM = moe_tables(F, args);
        LAS int* te = (LAS int*)(F.lds + TILEE_OFF);
        pg8::ProbG2<MOE_FP8 != 0> S{(const unsigned char*)(ws + WS_ACT), (const unsigned char*)(ws + WS_W2), nM, F.G, F.bx, te};
        pg8::EpiY E{(bf16_t*)(ws + WS_Y), args.b2};
        pg8::gemm_phase<pg8::ProbG2<MOE_FP8 != 0>, pg8::EpiY, true>(F.lds + RING_OFF, S, E);
    }
    SEAM(6);
    if (IN(7)) REPS(7) { (void)moe_tables(F, args); p7_combine(F, args, ((REP_MASK >> 7) & 1) && rep_ == 0); }
#undef IN
#undef SEAM
}

#ifndef MK_MASK
#define MK_MASK 0xFF
#endif
#ifndef MK_ONE
#define MK_ONE 1
#endif

extern "C" void kernel_launch(void* const* d_in, const int* in_sizes, int n_in, void* d_out, int out_size, void* d_ws, size_t ws_size, hipStream_t stream) {
    if (n_in != 16 || out_size != NTOK * DM || ws_size < WS_END) { fprintf(stderr, "kernel_launch: unexpected shapes (n_in %d out %d ws %zu)\n", n_in, out_size, ws_size); return; }
    const float* x = (const float*)d_in[0]; const float* g_mix = (const float*)d_in[1]; const float* w_in = (const float*)d_in[2]; const float* conv_w = (const float*)d_in[3];
    const float* sinks = (const float*)d_in[4]; const float* g_ao = (const float*)d_in[5]; const float* g_co = (const float*)d_in[6]; const float* w_out = (const float*)d_in[7];
    const float* g_ffn = (const float*)d_in[8]; const float* w_router = (const float*)d_in[9]; const float* b_router = (const float*)d_in[10]; const float* w1 = (const float*)d_in[11];
    const float* b1 = (const float*)d_in[12]; const float* w2 = (const float*)d_in[13]; const float* b2 = (const float*)d_in[14]; const float* g_final = (const float*)d_in[15];
    unsigned char* ws = (unsigned char*)d_ws; float* out = (float*)d_out;
    static int grid = 0;
    if (grid == 0) {
        int dev = 0, cus = 0, per_cu = 0;
        if (hipGetDevice(&dev) != hipSuccess || hipDeviceGetAttribute(&cus, hipDeviceAttributeMultiprocessorCount, dev) != hipSuccess) { fprintf(stderr, "kernel_launch: device query failed\n"); grid = -1; return; }
        if (hipFuncSetAttribute((const void*)mk_fwd, hipFuncAttributeMaxDynamicSharedMemorySize, LDS_BYTES) != hipSuccess) { fprintf(stderr, "kernel_launch: hipFuncSetAttribute failed\n"); grid = -1; return; }
        if (hipOccupancyMaxActiveBlocksPerMultiprocessor(&per_cu, (const void*)mk_fwd, NTHREADS, LDS_BYTES) != hipSuccess || per_cu < 1) { fprintf(stderr, "kernel_launch: occupancy query says %d blocks per CU\n", per_cu); per_cu = 1; }
        (void)hipGetLastError();
        grid = cus;
    }
    if (grid < 0) return;
    (void)hipMemsetAsync(ws + WS_CTL, 0, CTL_BYTES, stream);
    MkArgs a{};
    a.x = x; a.g_mix = g_mix; a.w_in = w_in; a.conv_w = conv_w; a.sinks = sinks; a.g_ao = g_ao; a.g_co = g_co; a.w_out = w_out; a.g_ffn = g_ffn; a.w_router = w_router; a.b_router = b_router;
    a.w1 = w1; a.b1 = b1; a.w2 = w2; a.b2 = b2; a.g_final = g_final; a.out = out; a.ws = ws;
#if MK_ONE
    a.ph_lo = 0; a.ph_hi = 8;
    hipLaunchKernelGGL(mk_fwd, dim3(grid), dim3(NTHREADS), LDS_BYTES, stream, a);
#else
    unsigned* ctl = (unsigned*)(ws + WS_CTL);
    bf16_t* Win_t = (bf16_t*)(ws + WS_WIN); bf16_t* Wout_t = (bf16_t*)(ws + WS_WOUT); float* WR = (float*)(ws + WS_WR); int* list = (int*)(ws + WS_LIST);
    int* TE = (int*)(ws + WS_TE); int* TP = (int*)(ws + WS_TP); float* TG = (float*)(ws + WS_TG); int* tab = (int*)(ws + WS_TAB); float* gcat = (float*)(ws + WS_TAB + 16384);
    bf16_t* W1_t = (bf16_t*)(ws + WS_W1); bf16_t* W2_t = (bf16_t*)(ws + WS_W2); bf16_t* XN = (bf16_t*)(ws + WS_XN); bf16_t* P = (bf16_t*)(ws + WS_P);
    bf16_t* MIX = (bf16_t*)(ws + WS_MIX); bf16_t* ACT = (bf16_t*)(ws + WS_ACT); bf16_t* Y = (bf16_t*)(ws + WS_Y); float* ATT = (float*)(ws + WS_ATT);
    for (int p = 0; p < 8; ++p) {
        if ((MK_MASK >> p) & 1) { a.ph_lo = p; a.ph_hi = p + 1; hipLaunchKernelGGL(mk_fwd, dim3(grid), dim3(NTHREADS), LDS_BYTES, stream, a); continue; }
        switch (p) {
        case 0:
            n_gcat<<<4, 256, 0, stream>>>(g_ao, g_co, gcat);
            n_transpose<<<dim3(DM / 32, INC / 32, 1), dim3(32, 8), 0, stream>>>(w_in, Win_t, DM, INC, g_mix);
            n_transpose<<<dim3(DM / 32, DM / 32, 1), dim3(32, 8), 0, stream>>>(w_out, Wout_t, DM, DM, gcat);
            n_transpose<<<dim3(DM / 32, 2048 / 32, NE), dim3(32, 8), 0, stream>>>(w1, W1_t, DM, 2048, g_ffn);
            n_transpose<<<dim3(DFF / 32, DM / 32, NE), dim3(32, 8), 0, stream>>>(w2, W2_t, DFF, DM, nullptr);
            n_wr<<<DM * NE / 256, 256, 0, stream>>>(w_router, g_ffn, WR);
            n_xn<<<NTOK, 256, 0, stream>>>(x, XN); break;
        case 1: { NG g{}; g.A = XN; g.Bt = Win_t; g.Ob = P; n_gemm<0><<<dim3(NTOK / 128, INC / 128), 256, 0, stream>>>(g); } break;
        case 2: n_attn<<<NTOK * NQH / 4, 256, 0, stream>>>(P, sinks, ATT); n_mix<<<NTOK, 256, 0, stream>>>(P, ATT, conv_w, MIX); break;
        case 3: { NG g{}; g.A = MIX; g.Bt = Wout_t; g.Of = out; g.X = x; n_gemm<1><<<dim3(NTOK / 128, DM / 128), 256, 0, stream>>>(g); } break;
        case 4: n_router<<<NTOK, 256, 0, stream>>>(out, WR, b_router, XN, ctl + CW_CNT, list, TE, TP, TG); break;
        case 5: n_tables<<<1, 64, 0, stream>>>(ctl + CW_CNT, tab);
            { NG g{}; g.A = XN; g.Bt = W1_t; g.Ob = ACT; g.bias = b1; g.list = list; g.cnt = ctl + CW_CNT; g.tab = tab; n_gemm<2><<<dim3(PADROWS / 128, DFF / 128), 256, 0, stream>>>(g); } break;
        case 6: n_tables<<<1, 64, 0, stream>>>(ctl + CW_CNT, tab);
            { NG g{}; g.A = ACT; g.Bt = W2_t; g.Ob = Y; g.bias = b2; g.list = list; g.cnt = ctl + CW_CNT; g.tab = tab; n_gemm<3><<<dim3(PADROWS / 128, DM / 128), 256, 0, stream>>>(g); } break;
        case 7: n_tables<<<1, 64, 0, stream>>>(ctl + CW_CNT, tab); n_combine<<<NTOK, 256, 0, stream>>>(out, Y, TE, TP, TG, tab, g_final, out); break;
        }
    }
#endif
}
```

```cpp
#include <hip/hip_runtime.h>
#include <cstdint>
#include <cstdio>
#ifndef SCHED44
#define SCHED44 0
#endif
#ifndef SPLIT_CONV
#define SPLIT_CONV 0
#define CONV_IN_P0 0
#endif
#ifndef STG1
#define STG1 0
#define STG3 0
#define STG5 0
#define STG6 0
#endif

typedef unsigned short bf16_t;
typedef short bf16x8 __attribute__((ext_vector_type(8)));
typedef float f32x4 __attribute__((ext_vector_type(4)));

constexpr int BATCH = 2, SEQ = 16384, DM = 1024, NTOK = BATCH * SEQ;
constexpr int NQH = 8, HD = 64, ATTW = 512, CONVW = 512, INC = 2304;
constexpr int INCP = 1792;
constexpr int NE = 32, DFF = 1024;
constexpr int MAXTILES = 544, PADROWS = MAXTILES * 256;
constexpr float EPS = 1e-5f;
constexpr float LOG2E = 1.4426950408889634f;
constexpr float C2 = 0.125f * LOG2E;
constexpr int W8_SHIFT = 5;
constexpr int W8_SCALE_E8M0 = 127 - W8_SHIFT;
#ifndef MOE_FP8
#define MOE_FP8 1
#endif

constexpr size_t MiB = 1u << 20;
constexpr size_t WS_CTL = 0, CTL_BYTES = 64 * 1024;
constexpr size_t WS_WIN = 1 * MiB, WS_WOUT = 6 * MiB, WS_WR = 8 * MiB, WS_LIST = 9 * MiB;
constexpr size_t WS_TE = 13 * MiB, WS_TP = 13 * MiB + 512 * 1024, WS_TG = 14 * MiB, WS_TAB = 14 * MiB + 512 * 1024;
constexpr size_t WS_RSA = 15 * MiB;
constexpr size_t WS_W1 = 16 * MiB, WS_W2 = 144 * MiB, WS_XN = 208 * MiB, WS_P = 272 * MiB, WS_MIX = 416 * MiB;
constexpr size_t WS_MO = 272 * MiB  , WS_X1B = 816 * MiB  ;
constexpr size_t WS_ACT = 272 * MiB, WS_Y = 544 * MiB, WS_ATT = 816 * MiB, WS_DUMMY = 880 * MiB, WS_END = 1016 * MiB;
constexpr int CW_CNT = 0;

__device__ __forceinline__ float bf2f(bf16_t v) { return __uint_as_float((unsigned)v << 16); }
__device__ __forceinline__ bf16_t f2bf(float f) { unsigned u = __float_as_uint(f); return (bf16_t)((u + 0x7fffu + ((u >> 16) & 1u)) >> 16); }

__device__ __forceinline__ float wave_sum(float v) {
#pragma unroll
    for (int o = 1; o < 64; o <<= 1) v += __shfl_xor(v, o);
    return v;
}
__device__ __forceinline__ float wave_max(float v) {
#pragma unroll
    for (int o = 1; o < 64; o <<= 1) v = fmaxf(v, __shfl_xor(v, o));
    return v;
}
__device__ __forceinline__ float block_sum256(float v, float* red) {
    v = wave_sum(v);
    __syncthreads();
    if ((threadIdx.x & 63) == 0) red[threadIdx.x >> 6] = v;
    __syncthreads();
    return red[0] + red[1] + red[2] + red[3];
}

__global__ void n_transpose(const float* W, bf16_t* WT, int K, int N, const float* g) {
    __shared__ float tile[32][33];
    const size_t zoff = (size_t)blockIdx.z * K * N;
    const int k0 = blockIdx.x * 32, n0 = blockIdx.y * 32, tx = threadIdx.x, ty = threadIdx.y;
#pragma unroll
    for (int i = 0; i < 4; ++i) { const int kk = ty + 8 * i; tile[kk][tx] = W[zoff + (size_t)(k0 + kk) * N + n0 + tx] * (g ? g[k0 + kk] : 1.f); }
    __syncthreads();
#pragma unroll
    for (int i = 0; i < 4; ++i) { const int nn = ty + 8 * i; WT[zoff + (size_t)(n0 + nn) * K + k0 + tx] = f2bf(tile[tx][nn]); }
}
__global__ void n_wr(const float* wr, const float* g, float* out) {
    const int i = blockIdx.x * 256 + threadIdx.x; if (i < DM * NE) out[i] = wr[i] * g[i >> 5];
}
__global__ void n_gcat(const float* ga, const float* gc, float* out) { const int i = blockIdx.x * 256 + threadIdx.x; if (i < DM) out[i] = i < 512 ? ga[i] : gc[i - 512]; }
__global__ __launch_bounds__(256) void n_xn(const float* x, bf16_t* XN) {
    __shared__ float red[4];
    const int row = blockIdx.x, t = threadIdx.x;
    const f32x4 v = *(const f32x4*)(x + (size_t)row * DM + 4 * t);
    const float ss = block_sum256(v.x * v.x + v.y * v.y + v.z * v.z + v.w * v.w, red);
    const float rstd = rsqrtf(ss * (1.f / DM) + EPS);
    bf16_t* o = XN + (size_t)row * DM + 4 * t;
    o[0] = f2bf(v.x * rstd); o[1] = f2bf(v.y * rstd); o[2] = f2bf(v.z * rstd); o[3] = f2bf(v.w * rstd);
}

struct NG {
    const bf16_t* A; const bf16_t* Bt; bf16_t* Ob; float* Of; const float* X; const float* bias;
    const int* list; const unsigned* cnt; const int* tab;
};
__device__ __forceinline__ float swiglu(float g, float l) {
    g = fminf(g, 7.f); l = fminf(fmaxf(l, -7.f), 7.f);
    const float s = __builtin_amdgcn_rcpf(1.f + __builtin_amdgcn_exp2f(-1.702f * LOG2E * g));
    const float a = g * s;
    return __builtin_fmaf(a, l, a);
}
typedef float f32x2v __attribute__((ext_vector_type(2)));
__device__ __forceinline__ f32x2v swiglu_pk(f32x2v g, f32x2v l) {
    g.x = __builtin_amdgcn_fmed3f(g.x, -24.f, 7.f); g.y = __builtin_amdgcn_fmed3f(g.y, -24.f, 7.f);
    l.x = __builtin_amdgcn_fmed3f(l.x, -7.f, 7.f); l.y = __builtin_amdgcn_fmed3f(l.y, -7.f, 7.f);
    const f32x2v t = g * (-1.702f * LOG2E);
    f32x2v e; e.x = __builtin_amdgcn_exp2f(t.x); e.y = __builtin_amdgcn_exp2f(t.y);
    const f32x2v d = e + 1.0f;
    const float rr = __builtin_amdgcn_rcpf(d.x * d.y);
    const f32x2v ds = {d.y, d.x};
    const f32x2v a = g * (ds * rr);
    return a * l + a;
}
template <int MODE> __global__ __launch_bounds__(256) void n_gemm(NG a) {
    const int lane = threadIdx.x & 63, w = threadIdx.x >> 6, row = lane & 15, quad = lane >> 4;
    const int m0 = blockIdx.x * 128 + (w >> 1) * 64, n0 = blockIdx.y * 128 + (w & 1) * 64;
    int e = 0, rbase = 0, cnt = 0;
    if (MODE >= 2) {
        const int pm = (blockIdx.x * 128) >> 8;
        if (pm >= a.tab[32]) return;
        e = a.tab[64 + pm]; rbase = m0 - 256 * a.tab[e]; cnt = (int)a.cnt[e];
    }
    const bf16_t* ar[4]; const bf16_t* br[4]; const bf16_t* br2[4];
#pragma unroll
    for (int i = 0; i < 4; ++i) {
        const int m = m0 + 16 * i + row;
        if (MODE == 2) { const int rr = rbase + 16 * i + row; const int tok = rr < cnt ? a.list[e * NTOK + rr] : 0; ar[i] = a.A + (size_t)tok * DM; }
        else ar[i] = a.A + (size_t)m * DM;
        const int n = n0 + 16 * i + row;
        if (MODE == 2) { br[i] = a.Bt + ((size_t)e * 2048 + n) * DM; br2[i] = br[i] + (size_t)1024 * DM; }
        else if (MODE == 3) { br[i] = a.Bt + ((size_t)e * 1024 + n) * DM; br2[i] = br[i]; }
        else { br[i] = a.Bt + (size_t)n * DM; br2[i] = br[i]; }
    }
    f32x4 acc[4][4], acc2[4][4];
#pragma unroll
    for (int i = 0; i < 4; ++i)
#pragma unroll
        for (int j = 0; j < 4; ++j) { acc[i][j] = (f32x4){0.f, 0.f, 0.f, 0.f}; acc2[i][j] = (f32x4){0.f, 0.f, 0.f, 0.f}; }
    for (int k0 = 0; k0 < DM; k0 += 32) {
        bf16x8 fa[4], fb[4], fb2[4];
#pragma unroll
        for (int i = 0; i < 4; ++i) { fa[i] = *(const bf16x8*)(ar[i] + k0 + quad * 8); fb[i] = *(const bf16x8*)(br[i] + k0 + quad * 8); if (MODE == 2) fb2[i] = *(const bf16x8*)(br2[i] + k0 + quad * 8); }
#pragma unroll
        for (int i = 0; i < 4; ++i)
#pragma unroll
            for (int j = 0; j < 4; ++j) {
                acc[i][j] = __builtin_amdgcn_mfma_f32_16x16x32_bf16(fa[i], fb[j], acc[i][j], 0, 0, 0);
                if (MODE == 2) acc2[i][j] = __builtin_amdgcn_mfma_f32_16x16x32_bf16(fa[i], fb2[j], acc2[i][j], 0, 0, 0);
            }
    }
#pragma unroll
    for (int i = 0; i < 4; ++i)
#pragma unroll
        for (int j = 0; j < 4; ++j)
#pragma unroll
            for (int r = 0; r < 4; ++r) {
                const int m = m0 + 16 * i + quad * 4 + r, n = n0 + 16 * j + row;
                const float v = acc[i][j][r];
                if (MODE == 0) a.Ob[(size_t)m * INC + n] = f2bf(n < 512 ? v * C2 : v);
                else if (MODE == 1) a.Of[(size_t)m * DM + n] = a.X[(size_t)m * DM + n] + v;
                else if (MODE == 2) a.Ob[(size_t)m * DM + n] = f2bf(swiglu(v + a.bias[e * 2048 + n], acc2[i][j][r] + a.bias[e * 2048 + 1024 + n]));
                else a.Ob[(size_t)m * DM + n] = f2bf(v + a.bias[e * 1024 + n]);
            }
}

__global__ __launch_bounds__(256) void n_attn(const bf16_t* P, const float* sinks, float* ATT) {
    const int gw = blockIdx.x * 4 + (threadIdx.x >> 6), lane = threadIdx.x & 63;
    const int tok = gw >> 3, h = gw & 7, hk = h >> 2, t = tok % SEQ;
    const float slope2 = exp2f(-(float)(h + 1)) * LOG2E, sink2 = sinks[h] * LOG2E;
    float q[64];
    const bf16_t* qp = P + (size_t)tok * INC + h * 64;
#pragma unroll
    for (int d = 0; d < 64; ++d) q[d] = bf2f(qp[d]);
    float s[2];
#pragma unroll
    for (int jj = 0; jj < 2; ++jj) {
        const int j = lane + 64 * jj, kp = t - 127 + j;
        float acc = -INFINITY;
        if (kp >= 0) {
            const bf16_t* kr = P + (size_t)(tok - 127 + j) * INC + 512 + hk * 64;
            acc = 0.f;
#pragma unroll
            for (int d = 0; d < 64; ++d) acc += q[d] * bf2f(kr[d]);
            acc -= slope2 * (float)(127 - j);
        }
        s[jj] = acc;
    }
    const float m = fmaxf(wave_max(fmaxf(s[0], s[1])), sink2);
    const float e0 = exp2f(s[0] - m), e1 = exp2f(s[1] - m);
    const float l = wave_sum(e0 + e1) + exp2f(sink2 - m);
    const float p0 = e0 / l, p1 = e1 / l;
    float o = 0.f;
    for (int j = 0; j < 128; ++j) {
        const float pj = __shfl(j < 64 ? p0 : p1, j & 63);
        if (t - 127 + j >= 0) o += pj * bf2f(P[(size_t)(tok - 127 + j) * INC + 640 + hk * 64 + lane]);
    }
    ATT[(size_t)tok * ATTW + h * 64 + lane] = o;
}
__global__ __launch_bounds__(256) void n_mix(const bf16_t* P, const float* ATT, const float* convw, bf16_t* MIX) {
    __shared__ float red[4];
    const int tok = blockIdx.x, tid = threadIdx.x, t = tok % SEQ;
    const float a0 = ATT[(size_t)tok * ATTW + tid], a1 = ATT[(size_t)tok * ATTW + 256 + tid];
    const float ssa = block_sum256(a0 * a0 + a1 * a1, red);
    const float ra = rsqrtf(ssa * (1.f / ATTW) + EPS);
    MIX[(size_t)tok * DM + tid] = f2bf(a0 * ra); MIX[(size_t)tok * DM + 256 + tid] = f2bf(a1 * ra);
    float y[2];
#pragma unroll
    for (int i = 0; i < 2; ++i) {
        const int c = tid + 256 * i;
        float acc = 0.f;
#pragma unroll
        for (int dt = 0; dt < 3; ++dt) {
            const int tt = t - 2 + dt;
            if (tt >= 0) { const bf16_t* pr = P + (size_t)(tok - 2 + dt) * INC; acc += convw[dt * CONVW + c] * (bf2f(pr[1280 + c]) * bf2f(pr[1792 + c])); }
        }
        y[i] = bf2f(P[(size_t)tok * INC + 768 + c]) * acc;
    }
    const float ssc = block_sum256(y[0] * y[0] + y[1] * y[1], red);
    const float rc = rsqrtf(ssc * (1.f / CONVW) + EPS);
    MIX[(size_t)tok * DM + 512 + tid] = f2bf(y[0] * rc); MIX[(size_t)tok * DM + 768 + tid] = f2bf(y[1] * rc);
}
__global__ __launch_bounds__(256) void n_router(const float* X1, const float* WR, const float* br, bf16_t* H2, unsigned* cnt, int* list, int* TE, int* TP, float* TG) {
    __shared__ float red[4]; __shared__ float xs[DM]; __shared__ float part[8][32]; __shared__ float lg[32];
    const int tok = blockIdx.x, tid = threadIdx.x;
    const f32x4 v = *(const f32x4*)(X1 + (size_t)tok * DM + 4 * tid);
    const float ss = block_sum256(v.x * v.x + v.y * v.y + v.z * v.z + v.w * v.w, red);
    const float rstd = rsqrtf(ss * (1.f / DM) + EPS);
    bf16_t* o = H2 + (size_t)tok * DM + 4 * tid;
    o[0] = f2bf(v.x * rstd); o[1] = f2bf(v.y * rstd); o[2] = f2bf(v.z * rstd); o[3] = f2bf(v.w * rstd);
    xs[4 * tid] = v.x; xs[4 * tid + 1] = v.y; xs[4 * tid + 2] = v.z; xs[4 * tid + 3] = v.w;
    __syncthreads();
    const int e = tid & 31, pt = tid >> 5;
    float acc = 0.f;
    for (int k = pt * 128; k < pt * 128 + 128; ++k) acc += xs[k] * WR[k * NE + e];
    part[pt][e] = acc;
    __syncthreads();
    if (tid < 32) { float sum = 0.f; for (int p = 0; p < 8; ++p) sum += part[p][tid]; lg[tid] = sum * rstd + br[tid]; }
    __syncthreads();
    if (tid == 0) {
        int idx[4]; float val[4]; unsigned used = 0u;
        for (int k = 0; k < 4; ++k) { float best = -INFINITY; int bi = 0; for (int j = 0; j < 32; ++j) if (!((used >> j) & 1u) && lg[j] > best) { best = lg[j]; bi = j; } used |= 1u << bi; idx[k] = bi; val[k] = best; }
        float es[4], sum = 0.f; for (int k = 0; k < 4; ++k) { es[k] = expf(val[k] - val[0]); sum += es[k]; }
        for (int k = 0; k < 4; ++k) {
            const unsigned pos = atomicAdd(&cnt[idx[k]], 1u);
            list[idx[k] * NTOK + pos] = tok; TE[tok * 4 + k] = idx[k]; TP[tok * 4 + k] = (int)pos; TG[tok * 4 + k] = es[k] / sum;
        }
    }
}
__global__ void n_tables(const unsigned* cnt, int* tab) {
    if (threadIdx.x == 0) { int s = 0; for (int e = 0; e < NE; ++e) { tab[e] = s; const int nt = ((int)cnt[e] + 255) >> 8; for (int i = 0; i < nt; ++i) tab[64 + s + i] = e; s += nt; } tab[32] = s; }
}
__global__ __launch_bounds__(256) void n_combine(const float* X1, const bf16_t* Y, const int* TE, const int* TP, const float* TG, const int* tab, const float* gf, float* out) {
    __shared__ float red[4];
    const int tok = blockIdx.x, tid = threadIdx.x;
    f32x4 v = *(const f32x4*)(X1 + (size_t)tok * DM + 4 * tid);
#pragma unroll
    for (int k = 0; k < 4; ++k) {
        const int e = TE[tok * 4 + k]; const size_t slot = (size_t)256 * tab[e] + TP[tok * 4 + k]; const float g = TG[tok * 4 + k];
        const bf16_t* yr = Y + slot * DM + 4 * tid;
        v.x += g * bf2f(yr[0]); v.y += g * bf2f(yr[1]); v.z += g * bf2f(yr[2]); v.w += g * bf2f(yr[3]);
    }
    const float ss = block_sum256(v.x * v.x + v.y * v.y + v.z * v.z + v.w * v.w, red);
    const float rstd = rsqrtf(ss * (1.f / DM) + EPS);
    const f32x4 g4 = *(const f32x4*)(gf + 4 * tid);
    *(f32x4*)(out + (size_t)tok * DM + 4 * tid) = (f32x4){v.x * rstd * g4.x, v.y * rstd * g4.y, v.z * rstd * g4.z, v.w * rstd * g4.w};
}


#define LAS __attribute__((address_space(3)))
#define GAS __attribute__((address_space(1)))
typedef unsigned u32x4 __attribute__((ext_vector_type(4)));
typedef unsigned u32x2 __attribute__((ext_vector_type(2)));
typedef float f32x16 __attribute__((ext_vector_type(16)));
typedef float f32x2 __attribute__((ext_vector_type(2)));
typedef short s16x4 __attribute__((ext_vector_type(4)));
typedef __bf16 bf16x2_t __attribute__((ext_vector_type(2)));
typedef GAS unsigned gu32;
#define RLX_AGENT __ATOMIC_RELAXED, __HIP_MEMORY_SCOPE_AGENT
#define LDS_WAIT() asm volatile("s_waitcnt lgkmcnt(0)" ::: "memory")
#define VM_WAIT() asm volatile("s_waitcnt vmcnt(0)" ::: "memory")

constexpr int NWAVES = 8, NTHREADS = 512;
constexpr int RING_OFF = 0, RING_BYTES = 131072;
constexpr int IDTAB_OFF = RING_BYTES, IDTAB_UNITS = 17, IDTAB_BYTES = IDTAB_UNITS * 1024;
constexpr int TILEE_OFF = IDTAB_OFF + IDTAB_BYTES;
constexpr int TSTART_OFF = TILEE_OFF + 2304;
constexpr int CNT_OFF = TSTART_OFF + 256;
constexpr int MISC_OFF = CNT_OFF + 128;
constexpr int BIAS_OFF = MISC_OFF + 128;
constexpr int LDS_BYTES = 155648;
static_assert(BIAS_OFF % 16 == 0 && BIAS_OFF + 1024 <= LDS_BYTES, "LDS map");
constexpr int CW_BAR = 4096;

__device__ __forceinline__ unsigned cvtpk(float lo, float hi) { f32x2 v = {lo, hi}; bf16x2_t b = __builtin_convertvector(v, bf16x2_t); return __builtin_bit_cast(unsigned, b); }

__device__ __forceinline__ int tid_of(int wave) { unsigned z = 0u; asm volatile("" : "+v"(z)); const int l = (int)__builtin_amdgcn_mbcnt_hi(~0u, __builtin_amdgcn_mbcnt_lo(~0u, z)); return wave * 64 + l; }

namespace pg8 {
constexpr int BM = 256, BK = 64, HALF = 128, HTB = HALF * BK * 2, NXCD = 8, WGM = 8, KD = 1024;
typedef int i32x8 __attribute__((ext_vector_type(8)));
typedef int i32x4 __attribute__((ext_vector_type(4)));
__host__ __device__ __forceinline__ int lds_byte(int r, int c) { return r * 128 + ((((c >> 3) ^ (r >> 1)) & 7) << 4) + (c & 7) * 2; }
__host__ __device__ __forceinline__ void stage_rc(int b, int& R, int& C) { R = b >> 7; C = ((((b >> 4) & 7) ^ ((R >> 1) & 7)) << 3); }
__host__ __device__ __forceinline__ int perm32(int rho) { const int n = rho >> 4, i = rho & 15; return 8 * (i >> 2) + 4 * n + (i & 3); }
struct Unit { int pm, pn, e; };
__device__ __forceinline__ bool order_next(int i, int G, int c, int nM, int nN, Unit& u) {
    const int nwg = nM * nN; const long L = (long)i * G + c; if (L >= nwg) return false;
    int wgid = (int)L; { const int q = nwg / NXCD, r = nwg % NXCD, xcd = wgid % NXCD, off = wgid / NXCD; wgid = (xcd < r ? xcd * (q + 1) : r * (q + 1) + (xcd - r) * q) + off; }
    const int nig = WGM * nN, gid = wgid / nig, fm = gid * WGM, gsz = (nM - fm) < WGM ? (nM - fm) : WGM;
    u.pm = fm + ((wgid % nig) % gsz); u.pn = (wgid % nig) / gsz; u.e = 0; return true;
}
struct ProbDense {
    static constexpr int KB = KD * 2; static constexpr bool F8 = false;
    static constexpr size_t HSTEPB = (size_t)HALF * KD * 2;
    const bf16_t* A; const bf16_t* Bt; int nM, nN, G, c; unsigned char* dummy;
    __device__ __forceinline__ bool next(int i, Unit& u) const { return order_next(i, G, c, nM, nN, u); }
    __device__ __forceinline__ const char* a_base(const Unit& u) const { return (const char*)A + (size_t)u.pm * BM * KD * 2; }
    __device__ __forceinline__ const char* b_base(const Unit& u) const { return (const char*)Bt + (size_t)u.pn * BM * KD * 2; }
    __device__ __forceinline__ void a_offs(int, const Unit&, const int (&Rr)[2], const int (&Cb)[2], unsigned (&va)[2][2]) const {
#pragma unroll
        for (int h = 0; h < 2; ++h)
#pragma unroll
            for (int i = 0; i < 2; ++i) va[h][i] = (unsigned)((Rr[i] + HALF * h) * KD * 2 + Cb[i]);
    }
};
template <bool F8_> struct ProbG1 {
    static constexpr int KB = F8_ ? KD : KD * 2; static constexpr bool F8 = F8_;
    static constexpr size_t HSTEPB = (size_t)1024 * KB;
    const unsigned char* H2; const unsigned char* W1t; int nM, G, c; const LAS int* tile_e; const LAS unsigned* idtab; unsigned char* dummy;
    __device__ __forceinline__ bool next(int i, Unit& u) const { if (!order_next(i, G, c, nM, 8, u)) return false; u.e = __builtin_amdgcn_readfirstlane(tile_e[u.pm]); return true; }
    __device__ __forceinline__ const char* a_base(const Unit&) const { return (const char*)H2; }
    __device__ __forceinline__ const char* b_base(const Unit& u) const { return (const char*)W1t + ((size_t)u.e * 2048 + (size_t)u.pn * 128) * KB; }
    __device__ __forceinline__ void a_offs(int ui, const Unit&, const int (&Rr)[2], const int (&Cb)[2], unsigned (&va)[2][2]) const {
        const int uu = ui < IDTAB_UNITS ? ui : IDTAB_UNITS - 1;
#pragma unroll
        for (int h = 0; h < 2; ++h)
#pragma unroll
            for (int i = 0; i < 2; ++i) va[h][i] = idtab[uu * 256 + h * HALF + Rr[i]] + (unsigned)Cb[i];
    }
};
template <bool F8_> struct ProbG2 {
    static constexpr int KB = F8_ ? KD : KD * 2; static constexpr bool F8 = F8_;
    static constexpr size_t HSTEPB = (size_t)HALF * KB;
    const unsigned char* ACT; const unsigned char* W2t; int nM, G, c; const LAS int* tile_e; unsigned char* dummy;
    __device__ __forceinline__ bool next(int i, Unit& u) const { if (!order_next(i, G, c, nM, 4, u)) return false; u.e = __builtin_amdgcn_readfirstlane(tile_e[u.pm]); return true; }
    __device__ __forceinline__ const char* a_base(const Unit& u) const { return (const char*)ACT + (size_t)u.pm * BM * KB; }
    __device__ __forceinline__ const char* b_base(const Unit& u) const { return (const char*)W2t + ((size_t)u.e * 1024 + (size_t)u.pn * 256) * KB; }
    __device__ __forceinline__ void a_offs(int, const Unit&, const int (&Rr)[2], const int (&Cb)[2], unsigned (&va)[2][2]) const {
#pragma unroll
        for (int h = 0; h < 2; ++h)
#pragma unroll
            for (int i = 0; i < 2; ++i) va[h][i] = (unsigned)((Rr[i] + HALF * h) * KB + Cb[i]);
    }
};

__device__ __forceinline__ void store_rows16(LAS unsigned char* scr, int fr, int fq, int lane, u32x4 c0, u32x4 c1, bf16_t* gbase  , size_t ld) {
    LAS unsigned char* wp = scr + (fr >> 3) * 8192 + (fr & 7) * 128;
    *(LAS u32x4*)(wp + (((2 * fq) ^ (fr & 7)) * 16)) = c0;
    *(LAS u32x4*)(wp + (((2 * fq + 1) ^ (fr & 7)) * 16)) = c1;
#pragma unroll
    for (int k = 0; k < 2; ++k) {
        const int rl = lane >> 3, ch = lane & 7;
        const u32x4 v = *(const LAS u32x4*)(scr + k * 8192 + rl * 128 + ((ch ^ rl) * 16));
        *(u32x4*)(gbase + (size_t)(8 * k + rl) * ld + ch * 8) = v;
    }
}
struct EpiP {
    static constexpr int PERM = 2; static constexpr bool HAS_BIAS = false; static constexpr bool MIDSCALE = false; static constexpr int NST = 16; bf16_t* O;
    __device__ __forceinline__ const char* bias_src(const Unit&, int) const { return nullptr; }
    __device__ __forceinline__ void operator()(const f32x4 (&acc)[2][2][4][2], const Unit& u, int wr, int wc, int fr, int fq, LAS unsigned char* scr) const {
        const int lane = fr + 16 * fq;
        if (u.pn >= 5) {
            bf16_t* ub = O + (size_t)(u.pm * BM + wr * 64 + fr) * INCP + 1280 + (u.pn - 5) * 128 + (4 * wc + fq) * 8;
#pragma unroll
            for (int ai = 0; ai < 2; ++ai)
#pragma unroll
                for (int m = 0; m < 4; ++m) {
                    const f32x4 p0 = acc[ai][0][m][0] * acc[ai][1][m][0], p1 = acc[ai][0][m][1] * acc[ai][1][m][1];
                    u32x2 w0, w1; w0.x = cvtpk(p0[0], p0[1]); w0.y = cvtpk(p0[2], p0[3]); w1.x = cvtpk(p1[0], p1[1]); w1.y = cvtpk(p1[2], p1[3]);
                    u32x2* dst = (u32x2*)(ub + (size_t)(ai * HALF + m * 16) * INCP);
                    dst[0] = w0; dst[1] = w1;
                }
            return;
        }
        const float sc = u.pn < 2 ? C2 : 1.f;
        bf16_t* base = O + (size_t)(u.pm * BM + wr * 64) * INCP + u.pn * BM + wc * 64;
#pragma unroll
        for (int ai = 0; ai < 2; ++ai)
#pragma unroll
            for (int m = 0; m < 4; ++m) {
                u32x4 c[2];
#pragma unroll
                for (int bj = 0; bj < 2; ++bj) { const f32x4 v0 = acc[ai][bj][m][0] * sc, v1 = acc[ai][bj][m][1] * sc;
                    c[bj].x = cvtpk(v0[0], v0[1]); c[bj].y = cvtpk(v0[2], v0[3]); c[bj].z = cvtpk(v1[0], v1[1]); c[bj].w = cvtpk(v1[2], v1[3]); }
                store_rows16(scr, fr, fq, lane, c[0], c[1], base + (size_t)(ai * HALF + m * 16) * INCP, INCP);
            }
    }
};
struct EpiMo {
    static constexpr int PERM = 2; static constexpr bool HAS_BIAS = false; static constexpr bool MIDSCALE = true; static constexpr int NST = 16; bf16_t* O; const float* RS;
    __device__ __forceinline__ const char* bias_src(const Unit&, int) const { return nullptr; }
    __device__ __forceinline__ const char* scale_src(const Unit& u, int lane) const { return (const char*)(RS + (size_t)u.pm * BM + lane * 4); }
    __device__ __forceinline__ void operator()(const f32x4 (&acc)[2][2][4][2], const Unit& u, int wr, int wc, int fr, int fq, LAS unsigned char* scr) const {
        const int lane = fr + 16 * fq;
        bf16_t* base = O + (size_t)(u.pm * BM + wr * 64) * DM + u.pn * BM + wc * 64;
#pragma unroll
        for (int ai = 0; ai < 2; ++ai)
#pragma unroll
            for (int m = 0; m < 4; ++m) {
                u32x4 c[2];
#pragma unroll
                for (int bj = 0; bj < 2; ++bj) { const f32x4 v0 = acc[ai][bj][m][0], v1 = acc[ai][bj][m][1];
                    c[bj].x = cvtpk(v0[0], v0[1]); c[bj].y = cvtpk(v0[2], v0[3]); c[bj].z = cvtpk(v1[0], v1[1]); c[bj].w = cvtpk(v1[2], v1[3]); }
                store_rows16(scr, fr, fq, lane, c[0], c[1], base + (size_t)(ai * HALF + m * 16) * DM, DM);
            }
    }
};
struct EpiX1 {
    static constexpr int PERM = 0; static constexpr bool HAS_BIAS = false; static constexpr bool MIDSCALE = false; static constexpr int NST = 0; const float* X; float* O;
    __device__ __forceinline__ const char* bias_src(const Unit&, int) const { return nullptr; }
    __device__ __forceinline__ void operator()(const f32x4 (&acc)[2][2][4][2], const Unit& u, int wr, int wc, int fr, int fq, LAS unsigned char* scr) const {
        const int row0 = u.pm * BM + wr * 64 + fr, col0 = u.pn * BM + wc * 32 + 4 * fq;
#pragma unroll
        for (int ai = 0; ai < 2; ++ai)
#pragma unroll
            for (int m = 0; m < 4; ++m) { const size_t off = (size_t)(row0 + ai * HALF + m * 16) * DM + col0;
#pragma unroll
                for (int bj = 0; bj < 2; ++bj)
#pragma unroll
                    for (int n = 0; n < 2; ++n) { const f32x4 xr = *(const f32x4*)(X + off + bj * HALF + n * 16); *(f32x4*)(O + off + bj * HALF + n * 16) = xr + acc[ai][bj][m][n]; } }
    }
};
struct EpiAct {
    static constexpr int PERM = 1; static constexpr bool HAS_BIAS = false; static constexpr bool MIDSCALE = false; static constexpr int NST = 0; bf16_t* O; const float* b1;
    __device__ __forceinline__ const char* bias_src(const Unit&, int) const { return nullptr; }
    __device__ __forceinline__ void operator()(const f32x4 (&acc)[2][2][4][2], const Unit& u, int wr, int wc, int fr, int fq, LAS unsigned char* scr) const {
        const int row0 = u.pm * BM + wr * 64 + fr, col0 = u.pn * 128 + wc * 32 + 8 * fq;
        const float* bp = b1 + (size_t)u.e * 2048 + col0;
        const f32x4 bg0 = *(const f32x4*)(bp), bg1 = *(const f32x4*)(bp + 4), bl0 = *(const f32x4*)(bp + 1024), bl1 = *(const f32x4*)(bp + 1028);
#pragma unroll
        for (int ai = 0; ai < 2; ++ai)
#pragma unroll
            for (int m = 0; m < 4; ++m) {
                const f32x4 g0 = acc[ai][0][m][0] + bg0, g1 = acc[ai][0][m][1] + bg1, l0 = acc[ai][1][m][0] + bl0, l1 = acc[ai][1][m][1] + bl1;
                u32x4 w; w.x = cvtpk(swiglu(g0[0], l0[0]), swiglu(g0[1], l0[1])); w.y = cvtpk(swiglu(g0[2], l0[2]), swiglu(g0[3], l0[3]));
                w.z = cvtpk(swiglu(g1[0], l1[0]), swiglu(g1[1], l1[1])); w.w = cvtpk(swiglu(g1[2], l1[2]), swiglu(g1[3], l1[3]));
                *(u32x4*)(O + (size_t)(row0 + ai * HALF + m * 16) * DM + col0) = w; }
    }
};
__device__ __forceinline__ unsigned pack4_fp8(float a, float b, float c, float d) {
    a = fminf(fmaxf(a, -448.f), 448.f); b = fminf(fmaxf(b, -448.f), 448.f); c = fminf(fmaxf(c, -448.f), 448.f); d = fminf(fmaxf(d, -448.f), 448.f);
    int p = __builtin_amdgcn_cvt_pk_fp8_f32(a, b, 0, false); p = __builtin_amdgcn_cvt_pk_fp8_f32(c, d, p, true); return (unsigned)p;
}
__device__ __forceinline__ unsigned pack4_fp8_nc(float a, float b, float c, float d) {
    int p = __builtin_amdgcn_cvt_pk_fp8_f32(a, b, 0, false); p = __builtin_amdgcn_cvt_pk_fp8_f32(c, d, p, true); return (unsigned)p;
}
struct EpiAct8 {
    static constexpr int PERM = 1; static constexpr bool HAS_BIAS = true; static constexpr bool MIDSCALE = false; static constexpr int NST = 8; unsigned char* O; const float* b1; const LAS float* bl;
    __device__ __forceinline__ const char* bias_src(const Unit& u, int lane) const { return (const char*)(b1 + (size_t)u.e * 2048 + (size_t)u.pn * 128 + (lane >> 5) * 1024) + (lane & 31) * 16; }
    __device__ __forceinline__ void operator()(const f32x4 (&acc)[2][2][4][2], const Unit& u, int wr, int wc, int fr, int fq, LAS unsigned char* scr) const {
        const int row0 = u.pm * BM + wr * 64 + fr, cl = wc * 32 + 8 * fq, col0 = u.pn * 128 + cl;
        const f32x4 bg0 = *(const LAS f32x4*)(bl + cl), bg1 = *(const LAS f32x4*)(bl + cl + 4), bl0 = *(const LAS f32x4*)(bl + 128 + cl), bl1 = *(const LAS f32x4*)(bl + 128 + cl + 4);
#pragma unroll
        for (int ai = 0; ai < 2; ++ai)
#pragma unroll
            for (int m = 0; m < 4; ++m) {
                const f32x4 g0 = acc[ai][0][m][0] + bg0, g1 = acc[ai][0][m][1] + bg1, l0 = acc[ai][1][m][0] + bl0, l1 = acc[ai][1][m][1] + bl1;
                const f32x2v s0 = swiglu_pk((f32x2v){g0[0], g0[1]}, (f32x2v){l0[0], l0[1]}), s1 = swiglu_pk((f32x2v){g0[2], g0[3]}, (f32x2v){l0[2], l0[3]});
                const f32x2v s2 = swiglu_pk((f32x2v){g1[0], g1[1]}, (f32x2v){l1[0], l1[1]}), s3 = swiglu_pk((f32x2v){g1[2], g1[3]}, (f32x2v){l1[2], l1[3]});
                u32x2 w; w.x = pack4_fp8_nc(s0.x, s0.y, s1.x, s1.y); w.y = pack4_fp8_nc(s2.x, s2.y, s3.x, s3.y);
                *(u32x2*)(O + (size_t)(row0 + ai * HALF + m * 16) * DM + col0) = w; }
    }
};
struct EpiY {
    static constexpr int PERM = 2; static constexpr bool HAS_BIAS = true; static constexpr bool MIDSCALE = false; static constexpr int NST = 16; bf16_t* O; const float* b2; const LAS float* bl;
    __device__ __forceinline__ const char* bias_src(const Unit& u, int lane) const { return (const char*)(b2 + (size_t)u.e * 1024 + (size_t)u.pn * 256) + lane * 16; }
    __device__ __forceinline__ void operator()(const f32x4 (&acc)[2][2][4][2], const Unit& u, int wr, int wc, int fr, int fq, LAS unsigned char* scr) const {
        const int lane = fr + 16 * fq, cl = wc * 64 + 16 * fq;
        f32x4 bv[2][2];
#pragma unroll
        for (int bj = 0; bj < 2; ++bj)
#pragma unroll
            for (int n = 0; n < 2; ++n) bv[bj][n] = *(const LAS f32x4*)(bl + cl + 8 * bj + 4 * n);
        bf16_t* base = O + (size_t)(u.pm * BM + wr * 64) * DM + u.pn * BM + wc * 64;
#pragma unroll
        for (int ai = 0; ai < 2; ++ai)
#pragma unroll
            for (int m = 0; m < 4; ++m) {
                u32x4 c[2];
#pragma unroll
                for (int bj = 0; bj < 2; ++bj) { const f32x4 v0 = acc[ai][bj][m][0] + bv[bj][0], v1 = acc[ai][bj][m][1] + bv[bj][1];
                    c[bj].x = cvtpk(v0[0], v0[1]); c[bj].y = cvtpk(v0[2], v0[3]); c[bj].z = cvtpk(v1[0], v1[1]); c[bj].w = cvtpk(v1[2], v1[3]); }
                store_rows16(scr, fr, fq, lane, c[0], c[1], base + (size_t)(ai * HALF + m * 16) * DM, DM);
            }
    }
};

struct EpiY8 {
    static constexpr int PERM = 2; static constexpr bool HAS_BIAS = true; static constexpr bool MIDSCALE = false; static constexpr int NST = 8; unsigned char* O; const float* b2; const LAS float* bl;
    __device__ __forceinline__ const char* bias_src(const Unit& u, int lane) const { return (const char*)(b2 + (size_t)u.e * 1024 + (size_t)u.pn * 256) + lane * 16; }
    __device__ __forceinline__ void operator()(const f32x4 (&acc)[2][2][4][2], const Unit& u, int wr, int wc, int fr, int fq, LAS unsigned char* scr) const {
        const int lane = fr + 16 * fq, cl = wc * 64 + 16 * fq;
        f32x4 bv[2][2];
#pragma unroll
        for (int bj = 0; bj < 2; ++bj)
#pragma unroll
            for (int n = 0; n < 2; ++n) bv[bj][n] = *(const LAS f32x4*)(bl + cl + 8 * bj + 4 * n);
        unsigned char* base = O + (size_t)(u.pm * BM + wr * 64) * DM + u.pn * BM + wc * 64;
        const int rrow = lane >> 2, rch = lane & 3;
#pragma unroll
        for (int ai = 0; ai < 2; ++ai)
#pragma unroll
            for (int mp = 0; mp < 2; ++mp) {
#pragma unroll
                for (int j = 0; j < 2; ++j) { const int m = 2 * mp + j;
                    const f32x4 a0 = acc[ai][0][m][0] + bv[0][0], a1 = acc[ai][0][m][1] + bv[0][1], a2 = acc[ai][1][m][0] + bv[1][0], a3 = acc[ai][1][m][1] + bv[1][1];
                    u32x4 w; w.x = pack4_fp8(a0[0], a0[1], a0[2], a0[3]); w.y = pack4_fp8(a1[0], a1[1], a1[2], a1[3]); w.z = pack4_fp8(a2[0], a2[1], a2[2], a2[3]); w.w = pack4_fp8(a3[0], a3[1], a3[2], a3[3]);
                    *(LAS u32x4*)(scr + j * 8192 + fr * 64 + ((fq ^ ((fr >> 1) & 3)) * 16)) = w; }
#pragma unroll
                for (int j = 0; j < 2; ++j) {
                    const u32x4 v = *(const LAS u32x4*)(scr + j * 8192 + rrow * 64 + ((rch ^ ((rrow >> 1) & 3)) * 16));
                    __builtin_nontemporal_store(v, (u32x4*)(base + (size_t)(ai * HALF + (2 * mp + j) * 16 + rrow) * DM + rch * 16)); }
            }
    }
};

template <class Prob, class Epi, bool ALIGN_EPI>
__device__ __forceinline__ void gemm_phase(LAS unsigned char* lds, const Prob& S, const Epi& E, int wave_) {
    const int tid = tid_of(wave_), wid = wave_, lane = tid & 63, wr = wid >> 2, wc = wid & 3, fr = lane & 15, fq = lane >> 4;
    constexpr int KB = Prob::KB, nt = KB / 128; constexpr bool F8 = Prob::F8;
    unsigned voffB[2]; int Rr[2], Cb[2];
#pragma unroll
    for (int i = 0; i < 2; ++i) { int R, C; stage_rc(tid * 16 + i * 8192, R, C);
        const int Rb = (Epi::PERM == 2) ? (64 * (R >> 5) + 16 * ((R & 15) >> 2) + 4 * ((R >> 4) & 1) + (R & 3)) : (Epi::PERM == 1) ? ((R & ~31) + perm32(R & 31)) : R;
        voffB[i] = (unsigned)(Rb * KB + C * 2); Rr[i] = R; Cb[i] = C * 2; }
    constexpr size_t kstep = (size_t)(BK * 2);
    constexpr size_t hstepB = (Epi::PERM == 2) ? (size_t)8 * KB : Prob::HSTEPB;
    const unsigned ldsw = (unsigned)wid * 1024u;
    const int aoff = lds_byte(wr * 64 + fr, fq * 8), boff = lds_byte(wc * 32 + fr, fq * 8), aoff1 = lds_byte(wr * 64 + fr, 32 + fq * 8), boff1 = lds_byte(wc * 32 + fr, 32 + fq * 8);
#define PG8_SA(b, h) (((b) * 2 + (h)) * HTB)
#define PG8_SB(b, h) ((4 + (b) * 2 + (h)) * HTB)
#define PG8_STAGE(bufoff, gbase, voff) do { _Pragma("unroll") for (int _i = 0; _i < 2; ++_i) \
        __builtin_amdgcn_global_load_lds((const unsigned*)((const char*)(gbase) + (voff)[_i]), (LAS unsigned*)(lds + (bufoff) + ldsw + _i * 8192), 16, 0, 0); } while (0)
#define PG8_LDA(dst, b, h) do { _Pragma("unroll") for (int m = 0; m < 4; ++m) { const i32x4 x0_ = *(const LAS i32x4*)(lds + PG8_SA(b, h) + aoff + m * 2048), x1_ = *(const LAS i32x4*)(lds + PG8_SA(b, h) + aoff1 + m * 2048); dst[m] = __builtin_shufflevector(x0_, x1_, 0, 1, 2, 3, 4, 5, 6, 7); } } while (0)
#define PG8_LDB(dst, b, h) do { _Pragma("unroll") for (int n = 0; n < 2; ++n) { const i32x4 x0_ = *(const LAS i32x4*)(lds + PG8_SB(b, h) + boff + n * 2048), x1_ = *(const LAS i32x4*)(lds + PG8_SB(b, h) + boff1 + n * 2048); dst[n] = __builtin_shufflevector(x0_, x1_, 0, 1, 2, 3, 4, 5, 6, 7); } } while (0)
#define PG8_MMA(ai, bj, At, Bt) do { __builtin_amdgcn_s_setprio(1); _Pragma("unroll") for (int m = 0; m < 4; ++m) _Pragma("unroll") for (int n = 0; n < 2; ++n) { \
        if constexpr (F8) asm volatile("s_nop 1\n\tv_mfma_scale_f32_16x16x128_f8f6f4 %0, %1, %2, %0, %3, %4 op_sel_hi:[0,0,0]" : "+v"(acc[ai][bj][m][n]) : "v"(Bt[n]), "v"(At[m]), "v"(scw), "v"(sca)); \
        else { acc[ai][bj][m][n] = __builtin_amdgcn_mfma_f32_16x16x32_bf16(__builtin_bit_cast(bf16x8, (i32x4)__builtin_shufflevector(Bt[n], Bt[n], 0, 1, 2, 3)), __builtin_bit_cast(bf16x8, (i32x4)__builtin_shufflevector(At[m], At[m], 0, 1, 2, 3)), acc[ai][bj][m][n], 0, 0, 0); \
               acc[ai][bj][m][n] = __builtin_amdgcn_mfma_f32_16x16x32_bf16(__builtin_bit_cast(bf16x8, (i32x4)__builtin_shufflevector(Bt[n], Bt[n], 4, 5, 6, 7)), __builtin_bit_cast(bf16x8, (i32x4)__builtin_shufflevector(At[m], At[m], 4, 5, 6, 7)), acc[ai][bj][m][n], 0, 0, 0); } } \
        __builtin_amdgcn_s_setprio(0); } while (0)
#define PG8_WAIT_V(n) asm volatile("s_waitcnt vmcnt(" #n ")" ::: "memory")
#define PG8_WAIT_L(n) asm volatile("s_waitcnt lgkmcnt(" #n ")" ::: "memory")
#define PG8_WAIT_VN(n) asm volatile("s_waitcnt vmcnt(%0)" :: "n"(n) : "memory")
#define PG8_BAR __builtin_amdgcn_s_barrier()
#define PG8_SCHED __builtin_amdgcn_sched_barrier(0)
    Unit cur, nxt; int ui = 0;
    if (!S.next(0, cur)) return;
    unsigned vaC[2][2], vaN[2][2];
    S.a_offs(0, cur, Rr, Cb, vaC);
    f32x4 acc[2][2][4][2];
#pragma unroll
    for (int a = 0; a < 2; ++a)
#pragma unroll
        for (int b = 0; b < 2; ++b)
#pragma unroll
            for (int m = 0; m < 4; ++m)
#pragma unroll
                for (int n = 0; n < 2; ++n) acc[a][b][m][n] = (f32x4){0.f, 0.f, 0.f, 0.f};
    i32x8 At[4], B0[2], B1[2];
    int scw = W8_SCALE_E8M0, sca = 127; asm volatile("" : "+v"(scw), "+v"(sca));
    const char* cA = S.a_base(cur); const char* cB = S.b_base(cur);
    PG8_STAGE(PG8_SB(0, 0), cB, voffB); PG8_STAGE(PG8_SB(0, 1), cB + hstepB, voffB); PG8_STAGE(PG8_SA(0, 0), cA, vaC[0]); PG8_STAGE(PG8_SA(0, 1), cA, vaC[1]);
    if (wr == 1) PG8_BAR;
    PG8_WAIT_V(2); PG8_BAR;
#if SCHED44
    PG8_STAGE(PG8_SB(1, 0), cB + kstep, voffB); PG8_STAGE(PG8_SA(1, 0), cA + kstep, vaC[0]);
#else
    PG8_STAGE(PG8_SB(1, 0), cB + kstep, voffB); PG8_STAGE(PG8_SA(1, 0), cA + kstep, vaC[0]); PG8_STAGE(PG8_SB(1, 1), cB + hstepB + kstep, voffB);
#endif
    PG8_WAIT_V(6); PG8_BAR;
#ifdef KREP
    int krep_ = 0;
#endif
    for (;;) {
        bool has_next = S.next(ui + 1, nxt);
#ifdef KREP
        const bool real_next_ = has_next; if (krep_ == 0) has_next = false;
#endif
        const char* nA = has_next ? S.a_base(nxt) : cA; const char* nB = has_next ? S.b_base(nxt) : cB;
        if (has_next) S.a_offs(ui + 1, nxt, Rr, Cb, vaN);
        else {
#pragma unroll
            for (int h = 0; h < 2; ++h)
#pragma unroll
                for (int i = 0; i < 2; ++i) vaN[h][i] = vaC[h][i]; }
#pragma unroll 1
        for (int t = 0; t < nt; t += 2) {
            const bool last = (t == nt - 2);
            const char* a1 = cA + (size_t)(t + 1) * kstep;
            const char* a2 = last ? nA : cA + (size_t)(t + 2) * kstep; const char* b2 = last ? nB : cB + (size_t)(t + 2) * kstep;
            const char* a3 = a2 + kstep; const char* b3 = b2 + kstep;
            unsigned v2[2][2];
#pragma unroll
            for (int h = 0; h < 2; ++h)
#pragma unroll
                for (int i = 0; i < 2; ++i) v2[h][i] = last ? vaN[h][i] : vaC[h][i];
            if constexpr (Epi::HAS_BIAS) { if (last) __builtin_amdgcn_global_load_lds((const unsigned*)E.bias_src(cur, lane), (LAS unsigned*)(lds + (BIAS_OFF - RING_OFF)), 16, 0, 0); }
            if constexpr (Epi::MIDSCALE) {
                if (t == 0) __builtin_amdgcn_global_load_lds((const unsigned*)E.scale_src(cur, lane), (LAS unsigned*)(lds + (BIAS_OFF - RING_OFF)), 16, 0, 0);
                if (t == nt / 2) {
                    const LAS float* sc_ = (const LAS float*)(lds + (BIAS_OFF - RING_OFF)) + wr * 64 + fr;
#pragma unroll
                    for (int a_ = 0; a_ < 2; ++a_)
#pragma unroll
                        for (int m_ = 0; m_ < 4; ++m_) { const float f_ = sc_[a_ * HALF + m_ * 16];
#pragma unroll
                            for (int b_ = 0; b_ < 2; ++b_)
#pragma unroll
                                for (int n_ = 0; n_ < 2; ++n_) acc[a_][b_][m_][n_] *= f_; }
                }
            }
#ifdef KREP
            const bool stq = (Epi::NST > 0) && (t == 0) && (ui > 0) && (krep_ == 0);
#else
            const bool stq = (Epi::NST > 0) && (t == 0) && (ui > 0);
#endif
#if SCHED44
            const char* b1h = cB + hstepB + (size_t)(t + 1) * kstep;
            PG8_LDB(B0, 0, 0); PG8_LDB(B1, 0, 1); PG8_SCHED; PG8_LDA(At, 0, 0); PG8_STAGE(PG8_SB(1, 1), b1h, voffB); PG8_STAGE(PG8_SA(1, 1), a1, vaC[1]);
            if (stq) PG8_WAIT_VN(8 + Epi::NST); else PG8_WAIT_V(8);
            PG8_WAIT_L(0); PG8_BAR; PG8_MMA(0, 0, At, B0); PG8_MMA(0, 1, At, B1); PG8_BAR; PG8_SCHED;
            PG8_LDA(At, 0, 1); PG8_STAGE(PG8_SB(0, 0), b2, voffB); PG8_STAGE(PG8_SA(0, 0), a2, v2[0]);
            PG8_WAIT_V(6); PG8_WAIT_L(0); PG8_BAR; PG8_MMA(1, 0, At, B0); PG8_MMA(1, 1, At, B1); PG8_BAR; PG8_SCHED;
            PG8_LDB(B0, 1, 0); PG8_LDB(B1, 1, 1); PG8_SCHED; PG8_LDA(At, 1, 0); PG8_STAGE(PG8_SB(0, 1), b2 + hstepB, voffB); PG8_STAGE(PG8_SA(0, 1), a2, v2[1]);
            PG8_WAIT_V(8); PG8_WAIT_L(0); PG8_BAR; PG8_MMA(0, 0, At, B0); PG8_MMA(0, 1, At, B1); PG8_BAR; PG8_SCHED;
            PG8_LDA(At, 1, 1); PG8_STAGE(PG8_SB(1, 0), b3, voffB); PG8_STAGE(PG8_SA(1, 0), a3, v2[0]);
            PG8_WAIT_V(6); PG8_WAIT_L(0); PG8_BAR; PG8_MMA(1, 0, At, B0); PG8_MMA(1, 1, At, B1); PG8_BAR; PG8_SCHED;
#else
            PG8_LDB(B0, 0, 0); PG8_LDB(B1, 0, 1); PG8_SCHED; PG8_LDA(At, 0, 0); PG8_STAGE(PG8_SA(1, 1), a1, vaC[1]);
            if (stq) PG8_WAIT_VN(8 + Epi::NST); else PG8_WAIT_V(8);
            PG8_WAIT_L(0); PG8_BAR; PG8_MMA(0, 0, At, B0); PG8_MMA(0, 1, At, B1); PG8_BAR; PG8_SCHED;
            PG8_LDA(At, 0, 1); PG8_STAGE(PG8_SB(0, 0), b2, voffB); PG8_STAGE(PG8_SB(0, 1), b2 + hstepB, voffB); PG8_STAGE(PG8_SA(0, 0), a2, v2[0]);
            if (stq) PG8_WAIT_VN(8 + Epi::NST); else PG8_WAIT_V(8);
            PG8_WAIT_L(0); PG8_BAR; PG8_MMA(1, 0, At, B0); PG8_MMA(1, 1, At, B1); PG8_BAR; PG8_SCHED;
            PG8_LDB(B0, 1, 0); PG8_LDB(B1, 1, 1); PG8_SCHED; PG8_LDA(At, 1, 0); PG8_STAGE(PG8_SA(0, 1), a2, v2[1]);
            PG8_WAIT_V(8); PG8_WAIT_L(0); PG8_BAR; PG8_MMA(0, 0, At, B0); PG8_MMA(0, 1, At, B1); PG8_BAR; PG8_SCHED;
            PG8_LDA(At, 1, 1); PG8_STAGE(PG8_SB(1, 0), b3, voffB); PG8_STAGE(PG8_SB(1, 1), b3 + hstepB, voffB); PG8_STAGE(PG8_SA(1, 0), a3, v2[0]);
            PG8_WAIT_V(8); PG8_WAIT_L(0); PG8_BAR; PG8_MMA(1, 0, At, B0); PG8_MMA(1, 1, At, B1); PG8_BAR; PG8_SCHED;
#endif
        }
#ifdef KREP
        if (krep_ == 0) { krep_ = 1;
            _Pragma("unroll") for (int a = 0; a < 2; ++a) _Pragma("unroll") for (int b = 0; b < 2; ++b) _Pragma("unroll") for (int m = 0; m < 4; ++m) _Pragma("unroll") for (int n = 0; n < 2; ++n) acc[a][b][m][n] = (f32x4){0.f, 0.f, 0.f, 0.f};
            continue; }
        krep_ = 0; has_next = real_next_;
#endif
        if constexpr (ALIGN_EPI) { if (wr == 0) PG8_BAR; }
        if constexpr (F8) asm volatile("s_nop 15\n\ts_nop 15" ::: "memory");
        E(acc, cur, wr, wc, fr, fq, lds + PG8_SA(1, 1) + ldsw);
#ifdef EPI_TWICE
        asm volatile("" ::: "memory"); E(acc, cur, wr, wc, fr, fq, lds + PG8_SA(1, 1) + ldsw);
#endif
#ifdef EPI_DUMMY
        { asm volatile("" ::: "memory"); unsigned char* dp = S.dummy + ((size_t)(blockIdx.x * 8 + wid) * 16) * 1024 + lane * 16;
          const u32x4 w_ = __builtin_bit_cast(u32x4, acc[0][0][0][0]);
          _Pragma("unroll") for (int q_ = 0; q_ < 16; ++q_) { *(volatile u32x4*)(dp + q_ * 1024) = w_; } }
#endif
        if (!has_next) break;
#pragma unroll
        for (int a = 0; a < 2; ++a)
#pragma unroll
            for (int b = 0; b < 2; ++b)
#pragma unroll
                for (int m = 0; m < 4; ++m)
#pragma unroll
                    for (int n = 0; n < 2; ++n) acc[a][b][m][n] = (f32x4){0.f, 0.f, 0.f, 0.f};
        cur = nxt; cA = nA; cB = nB; ++ui;
#pragma unroll
        for (int h = 0; h < 2; ++h)
#pragma unroll
            for (int i = 0; i < 2; ++i) vaC[h][i] = vaN[h][i];
        if constexpr (ALIGN_EPI) { if (wr == 1) PG8_BAR; }
    }
    PG8_WAIT_V(0);
    if constexpr (!ALIGN_EPI) { if (wr == 0) PG8_BAR; }
    PG8_BAR;
#undef PG8_SA
#undef PG8_SB
#undef PG8_STAGE
#undef PG8_LDA
#undef PG8_LDB
#undef PG8_MMA
#undef PG8_WAIT_V
#undef PG8_WAIT_L
#undef PG8_WAIT_VN
#undef PG8_BAR
#undef PG8_SCHED
}
}

#define XB_TMO      128
#define XB_XCNT(j)  (256  + 64 * (j))
#define XB_XSUB(j)  (1280 + 64 * (j))
#define XB_XGEN(j)  (2304 + 64 * (j))
#define XB_TOP      3328
#define XB_TOPGEN   3392
#define XCD_BAR_WORDS 3456
#define XB_SPIN_CAP (1u << 18)
__device__ __forceinline__ unsigned xb_ld(unsigned* p)              { return __hip_atomic_load(p, __ATOMIC_RELAXED, __HIP_MEMORY_SCOPE_AGENT); }
__device__ __forceinline__ unsigned xb_add(unsigned* p, unsigned v) { return __hip_atomic_fetch_add(p, v, __ATOMIC_RELAXED, __HIP_MEMORY_SCOPE_AGENT); }
__device__ __forceinline__ unsigned xb_xcc_id() { return (unsigned)__builtin_amdgcn_s_getreg((3 << 11) | 20) & 0xFu; }
#define XB_SPIN(cond, bar) do { unsigned _sp = 0; while (cond) { __builtin_amdgcn_s_sleep(1); \
    if ((++_sp & 255u) == 0u) { if (xb_ld(&(bar)[XB_TMO])) break; if (_sp > XB_SPIN_CAP) { atomicAdd(&(bar)[XB_TMO], 1u); break; } } } } while (0)
struct XcdBarrier { unsigned* bar; unsigned x; volatile LAS unsigned* st; int wave; };
__device__ __forceinline__ XcdBarrier xcd_barrier_post(unsigned* bar, volatile LAS unsigned* st, int wave) {
    XcdBarrier b; b.bar = bar; b.x = xb_xcc_id(); b.st = st; b.wave = wave;
    if (tid_of(wave) == 0) (void)xb_add(&bar[XB_XCNT(b.x)], 1u);
    return b;
}
__device__ __forceinline__ void xcd_barrier_complete(unsigned* bar, unsigned x, unsigned& nloc, unsigned& nx) {
    const unsigned G = gridDim.x * gridDim.y * gridDim.z;
    unsigned sum, cnt, mine, sp = 0u;
    for (;;) {
        sum = 0u; cnt = 0u; mine = 0u;
#pragma unroll
        for (unsigned j = 0; j < 16; ++j) { const unsigned c = xb_ld(&bar[XB_XCNT(j)]); sum += c; cnt += (c > 0u) ? 1u : 0u; mine = (j == x) ? c : mine; }
        if (sum == G) break;
        __builtin_amdgcn_s_sleep(1);
        if ((++sp & 255u) == 0u) { if (xb_ld(&bar[XB_TMO])) break; if (sp > XB_SPIN_CAP) { atomicAdd(&bar[XB_TMO], 1u); break; } }
    }
    nloc = mine > 0u ? mine : 1u; nx = cnt > 0u ? cnt : 1u;
}
__device__ __forceinline__ void xcd_barrier(const XcdBarrier& b) {
    asm volatile("s_waitcnt vmcnt(0)" ::: "memory");
    __syncthreads();
    if (tid_of(b.wave) == 0) {
        unsigned* bar = b.bar;
        __builtin_amdgcn_s_waitcnt(0);
        unsigned nloc = b.st[0], nx = b.st[1];
        if (nloc == 0u) { xcd_barrier_complete(bar, b.x, nloc, nx); b.st[0] = nloc; b.st[1] = nx; }
        const unsigned old = xb_add(&bar[XB_XSUB(b.x)], 1u);
        const unsigned gen = old / nloc;
        if (old + 1u == (gen + 1u) * nloc) {
            __builtin_amdgcn_fence(__ATOMIC_RELEASE, "agent");
            asm volatile("s_waitcnt vmcnt(0)" ::: "memory");
            const unsigned og = xb_add(&bar[XB_TOP], 1u);
            const unsigned tg = og / nx;
            if (og + 1u == (tg + 1u) * nx) xb_add(&bar[XB_TOPGEN], 1u);
            else XB_SPIN(xb_ld(&bar[XB_TOPGEN]) == tg, bar);
            __builtin_amdgcn_fence(__ATOMIC_ACQUIRE, "agent");
            xb_add(&bar[XB_XGEN(b.x)], 1u);
            asm volatile("s_waitcnt vmcnt(0)" ::: "memory");
        } else {
            XB_SPIN(xb_ld(&bar[XB_XGEN(b.x)]) == gen, bar);
            __builtin_amdgcn_fence(__ATOMIC_ACQUIRE, "agent");
            asm volatile("s_waitcnt vmcnt(0)" ::: "memory");
        }
    }
    __syncthreads();
}

struct MkArgs {
    const float *x, *g_mix, *w_in, *conv_w, *sinks, *g_ao, *g_co, *w_out, *g_ffn, *w_router, *b_router, *w1, *b1, *w2, *b2, *g_final;
    float* out; unsigned char* ws; int ph_lo, ph_hi;
};
struct Frame {
    LAS unsigned char* lds; int tid, lane, wave, G, bx;
};

__device__ __forceinline__ void phase_stagger(const Frame& F, int nwg, unsigned half_unit_ticks) {
    const int rem = nwg % F.G;
    if (rem != 0 && F.bx >= rem && half_unit_ticks != 0u) {
        const unsigned long long t0 = __builtin_amdgcn_s_memrealtime();
        while (__builtin_amdgcn_s_memrealtime() - t0 < (unsigned long long)half_unit_ticks) __builtin_amdgcn_s_sleep(32);
    }
    __syncthreads();
}
__device__ __forceinline__ int win_srccol(int n) {
    if (n < 1280) return n;
    const int t = (n - 1280) >> 8, c = (n - 1280) & 255, g16 = c >> 4, w = c & 15, bj = w >> 3, k8 = w & 7;
    return (bj ? 1792 : 1280) + t * 128 + g16 * 8 + k8;
}
__device__ __forceinline__ void p0_transpose_item(const float* W, int K, int N, bf16_t* WT, const float* g0, const float* g1, int split, LAS unsigned char* scr, int item, int lane, bool cperm = false) {
    const int nblk = N / 64, kb = item / nblk, nb = item % nblk, k0 = 64 * kb, n = cperm ? win_srccol(64 * nb + lane) : 64 * nb + lane;
    const float* src = W + (size_t)k0 * N + n;
    float v[64];
#pragma unroll
    for (int i = 0; i < 64; ++i) v[i] = __builtin_nontemporal_load(src + (size_t)i * N);
#pragma unroll
    for (int q = 0; q < 8; ++q) {
        float w[8];
#pragma unroll
        for (int i = 0; i < 8; ++i) { const int k = k0 + 8 * q + i; const float gg = g0 ? (k < split ? g0[k] : g1[k - split]) : 1.f; w[i] = v[8 * q + i] * gg; }
        u32x4 o; o.x = cvtpk(w[0], w[1]); o.y = cvtpk(w[2], w[3]); o.z = cvtpk(w[4], w[5]); o.w = cvtpk(w[6], w[7]);
        *(LAS u32x4*)(scr + lane * 128 + ((q ^ (lane & 7)) * 16)) = o;
    }
    LDS_WAIT(); asm volatile("" ::: "memory");
#pragma unroll
    for (int j = 0; j < 8; ++j) {
        const int nl = 8 * j + (lane >> 3), ch = lane & 7;
        const u32x4 o = *(const LAS u32x4*)(scr + nl * 128 + ((ch ^ (nl & 7)) * 16));
        *(u32x4*)(WT + (size_t)(64 * nb + nl) * K + k0 + 8 * ch) = o;
    }
    LDS_WAIT(); asm volatile("" ::: "memory");
}
__device__ __forceinline__ void p0_transpose_item8(const float* W, int K, int N, unsigned char* WT, const float* g0, LAS unsigned char* scr, int item, int lane) {
    const int nblk = N / 64, kb = item / nblk, nb = item % nblk, k0 = 128 * kb, n = 64 * nb + lane;
    const float* src = W + (size_t)k0 * N + n;
    float v[128];
#pragma unroll
    for (int i = 0; i < 128; ++i) v[i] = __builtin_nontemporal_load(src + (size_t)i * N);
    constexpr float SC = (float)(1 << W8_SHIFT);
#pragma unroll
    for (int q = 0; q < 8; ++q) {
        float w[16];
#pragma unroll
        for (int i = 0; i < 16; ++i) { const int k = k0 + 16 * q + i; const float gg = g0 ? g0[k] * SC : SC; w[i] = v[16 * q + i] * gg; }
        u32x4 o; o.x = pg8::pack4_fp8(w[0], w[1], w[2], w[3]); o.y = pg8::pack4_fp8(w[4], w[5], w[6], w[7]); o.z = pg8::pack4_fp8(w[8], w[9], w[10], w[11]); o.w = pg8::pack4_fp8(w[12], w[13], w[14], w[15]);
        *(LAS u32x4*)(scr + lane * 128 + ((q ^ (lane & 7)) * 16)) = o;
    }
    LDS_WAIT(); asm volatile("" ::: "memory");
#pragma unroll
    for (int j = 0; j < 8; ++j) {
        const int nl = 8 * j + (lane >> 3), ch = lane & 7;
        const u32x4 o = *(const LAS u32x4*)(scr + nl * 128 + ((ch ^ (nl & 7)) * 16));
        __builtin_nontemporal_store(o, (u32x4*)(WT + (size_t)(64 * nb + nl) * K + k0 + 16 * ch));
    }
    LDS_WAIT(); asm volatile("" ::: "memory");
}
__device__ __forceinline__ void p0_prologue(const Frame& F, const MkArgs& a, int item_lo, int item_hi, int gw, int NGW, bool rows) {
    unsigned char* ws = a.ws;
    bf16_t* Win_t = (bf16_t*)(ws + WS_WIN); bf16_t* Wout_t = (bf16_t*)(ws + WS_WOUT); float* WR = (float*)(ws + WS_WR);
    bf16_t* W1_t = (bf16_t*)(ws + WS_W1); bf16_t* W2_t = (bf16_t*)(ws + WS_W2); bf16_t* XN = (bf16_t*)(ws + WS_XN);
    LAS unsigned char* scr = F.lds + RING_OFF + F.wave * 8192;
    constexpr int I_IN = (DM / 64) * (INC / 64), I_OUT = (DM / 64) * (DM / 64), I_W1E = (DM / (MOE_FP8 ? 128 : 64)) * (2048 / 64), I_W2E = (DFF / (MOE_FP8 ? 128 : 64)) * (DM / 64);
    constexpr int NITEMS = I_IN + I_OUT + NE * I_W1E + NE * I_W2E;
    if (item_hi > NITEMS) item_hi = NITEMS;
    for (int it = item_lo + gw; it < item_hi; it += NGW) {
        int r = it;
        if (r < I_IN) { p0_transpose_item(a.w_in, DM, INC, Win_t, a.g_mix, a.g_mix, DM, scr, r, F.lane, true); continue; } r -= I_IN;
        if (r < I_OUT) { p0_transpose_item(a.w_out, DM, DM, Wout_t, a.g_ao, a.g_co, 512, scr, r, F.lane); continue; } r -= I_OUT;
#if MOE_FP8
        if (r < NE * I_W1E) { const int e = r / I_W1E; p0_transpose_item8(a.w1 + (size_t)e * DM * 2048, DM, 2048, (unsigned char*)W1_t + (size_t)e * 2048 * DM, a.g_ffn, scr, r % I_W1E, F.lane); continue; } r -= NE * I_W1E;
        { const int e = r / I_W2E; p0_transpose_item8(a.w2 + (size_t)e * DFF * DM, DFF, DM, (unsigned char*)W2_t + (size_t)e * DM * DFF, nullptr, scr, r % I_W2E, F.lane); }
#else
        if (r < NE * I_W1E) { const int e = r / I_W1E; p0_transpose_item(a.w1 + (size_t)e * DM * 2048, DM, 2048, W1_t + (size_t)e * 2048 * DM, a.g_ffn, a.g_ffn, DM, scr, r % I_W1E, F.lane); continue; } r -= NE * I_W1E;
        { const int e = r / I_W2E; p0_transpose_item(a.w2 + (size_t)e * DFF * DM, DFF, DM, W2_t + (size_t)e * DM * DFF, nullptr, nullptr, 0, scr, r % I_W2E, F.lane); }
#endif
    }
    if (!rows) return;
    for (int i = (F.bx * NTHREADS + F.tid); i < DM * NE; i += F.G * NTHREADS) WR[i] = a.w_router[i] * a.g_ffn[i >> 5];
    for (int m0 = 8 * gw; m0 < NTOK; m0 += 8 * NGW) {
        f32x4 v[8][4];
#pragma unroll
        for (int r = 0; r < 8; ++r) { const f32x4* xr = (const f32x4*)(a.x + (size_t)(m0 + r) * DM) + F.lane;
#pragma unroll
            for (int j = 0; j < 4; ++j) v[r][j] = __builtin_nontemporal_load(xr + 64 * j); }
#pragma unroll
        for (int r = 0; r < 8; ++r) {
            float s2 = 0.f;
#pragma unroll
            for (int j = 0; j < 4; ++j) s2 += (v[r][j].x * v[r][j].x + v[r][j].y * v[r][j].y) + (v[r][j].z * v[r][j].z + v[r][j].w * v[r][j].w);
            const float rstd = rsqrtf(wave_sum(s2) * (1.f / DM) + EPS);
            u32x2* o8 = (u32x2*)(XN + (size_t)(m0 + r) * DM) + F.lane;
#pragma unroll
            for (int j = 0; j < 4; ++j) { u32x2 w; w.x = cvtpk(v[r][j].x * rstd, v[r][j].y * rstd); w.y = cvtpk(v[r][j].z * rstd, v[r][j].w * rstd); o8[64 * j] = w; }
        }
    }
}

constexpr int A_KOFF = 0, A_VOFF = 32768, A_HK = 65536, A_WSF = 131072, A_OST = A_WSF + 2048, A_SSQ = A_OST + 16384;
static_assert(A_SSQ + 1024 <= MISC_OFF, "P2 LDS map");
__device__ __forceinline__ int crow(int r, int hi) { return (r & 3) + 8 * (r >> 2) + 4 * hi; }
typedef short v4i16_t __attribute__((ext_vector_type(4)));
__device__ __forceinline__ s16x4 vtr(const LAS unsigned char* p) { return __builtin_bit_cast(s16x4, __builtin_amdgcn_ds_read_tr16_b64_v4i16((LAS v4i16_t*)p)); }

__device__ __forceinline__ void attn_core(const Frame& F, bf16x8 (&qr)[4], const bf16_t* qnext, int nb, int hk, int qt, float slope2, float sink2, f32x16 (&o)[2], float& l_out) {
    LAS unsigned char* L = F.lds;
    const int lane = F.lane, r32 = lane & 31, hi = lane >> 5;
    f32x16 p[5];
    const LAS unsigned char* kb = L + hk * A_HK + A_KOFF + hi * 4096 + r32 * 16 + qt * 512;
#pragma unroll
    for (int j = 0; j < 5; ++j) {
#pragma unroll
        for (int r = 0; r < 16; ++r) p[j][r] = 0.f;
#pragma unroll
        for (int d0 = 0; d0 < 4; ++d0) { const bf16x8 kf = *(const LAS bf16x8*)(kb + d0 * 8192 + j * 512); p[j] = __builtin_amdgcn_mfma_f32_32x32x16_bf16(kf, qr[d0], p[j], 0, 0, 0); }
        __builtin_amdgcn_sched_barrier(0);
    }
#pragma unroll
    for (int d0 = 0; d0 < 4; ++d0) qr[d0] = *(const bf16x8*)(qnext + d0 * 16);
    __builtin_amdgcn_sched_barrier(0);
    int dl = r32 - 4 * hi; asm volatile("" : "+v"(dl));
    const float basef = slope2 * (float)dl;
    float mx = sink2;
#pragma unroll
    for (int j = 0; j < 5; ++j) {
        const bool dead = (nb == 0) && (qt + j < 4);
#pragma unroll
        for (int r = 0; r < 16; ++r) {
            const int cc = (r & 3) + 8 * (r >> 2);
            bool ok = (j == 0) ? (dl < cc) : ((j == 4) ? (cc <= dl) : true);
            ok = ok && !dead;
            const float v = ok ? ((p[j][r] - basef) - slope2 * (float)(128 - 32 * j - cc)) : -INFINITY;
            p[j][r] = v; mx = fmaxf(mx, v);
        }
    }
    mx = fmaxf(mx, __shfl_xor(mx, 32));
    float sum = 0.f;
    u32x4 pk[5][2];
#pragma unroll
    for (int j = 0; j < 5; ++j) {
#pragma unroll
        for (int s = 0; s < 2; ++s) {
            float e[8];
#pragma unroll
            for (int i = 0; i < 8; ++i) { e[i] = __builtin_amdgcn_exp2f(p[j][8 * s + i] - mx); sum += e[i]; }
            pk[j][s].x = cvtpk(e[0], e[1]); pk[j][s].y = cvtpk(e[2], e[3]); pk[j][s].z = cvtpk(e[4], e[5]); pk[j][s].w = cvtpk(e[6], e[7]);
        }
        __builtin_amdgcn_sched_barrier(0);
    }
    sum += __shfl_xor(sum, 32);
    const float l = sum + __builtin_amdgcn_exp2f(sink2 - mx);
#pragma unroll
    for (int r = 0; r < 16; ++r) { o[0][r] = 0.f; o[1][r] = 0.f; }
    const LAS unsigned char* vb = L + hk * A_HK + A_VOFF + ((lane >> 4) & 1) * 32 + (lane & 3) * 8 + (4 * hi + ((lane & 15) >> 2)) * 64 + qt * 2048;
#pragma unroll
    for (int j = 0; j < 5; ++j)
#pragma unroll
        for (int s = 0; s < 2; ++s) {
            const bf16x8 pa = __builtin_bit_cast(bf16x8, pk[j][s]);
#pragma unroll
            for (int d0 = 0; d0 < 2; ++d0) {
                const LAS unsigned char* ap = vb + d0 * 16384 + (2 * j + s) * 1024;
                const s16x4 lo = vtr(ap), hh = vtr(ap + 512);
                const bf16x8 vf = (bf16x8){lo[0], lo[1], lo[2], lo[3], hh[0], hh[1], hh[2], hh[3]};
                o[d0] = __builtin_amdgcn_mfma_f32_32x32x16_bf16(pa, vf, o[d0], 0, 0, 0);
            }
            if (s == 1) __builtin_amdgcn_sched_barrier(0);
        }
    l_out = l;
}
__device__ __forceinline__ void attn_store(const Frame& F, const f32x16 (&o)[2], float l, bf16_t* MIX, int row0, int h, int qt, float (&sq)[4]) {
    LAS unsigned char* L = F.lds;
    const int lane = F.lane, r32 = lane & 31, hi = lane >> 5;
    LAS float* wsf = (LAS float*)(L + A_WSF) + F.wave * 64;
    if (hi == 0) wsf[r32] = l;
    LDS_WAIT();
    LAS bf16_t* stg = (LAS bf16_t*)(L + A_OST) + F.wave * 1024;
#pragma unroll
    for (int R = 0; R < 2; ++R) {
#pragma unroll
        for (int rr = 0; rr < 8; ++rr) { const int r = 8 * R + rr, c = crow(r, hi); const float rl = __builtin_amdgcn_rcpf(wsf[c]); const int cl = (rr & 3) + 8 * (rr >> 2) + 4 * hi;
            stg[cl * 64 + r32] = f2bf(o[0][r] * rl); stg[cl * 64 + 32 + r32] = f2bf(o[1][r] * rl); }
        LDS_WAIT();
#pragma unroll
        for (int i = 0; i < 2; ++i) {
            const int row = i * 8 + (lane >> 3), ch = lane & 7;
            const u32x4 v = *(const LAS u32x4*)(stg + row * 64 + ch * 8);
            *(u32x4*)(MIX + (size_t)(row0 + qt * 32 + 16 * R + row) * DM + h * 64 + ch * 8) = v;
            float s2 = 0.f;
#pragma unroll
            for (int q = 0; q < 4; ++q) { const float a = __uint_as_float(v[q] << 16), b = __uint_as_float(v[q] & 0xffff0000u); s2 += a * a + b * b; }
            s2 += __shfl_xor(s2, 1); s2 += __shfl_xor(s2, 2); s2 += __shfl_xor(s2, 4);
            sq[2 * R + i] += s2;
        }
        LDS_WAIT();
    }
}

struct ConvRegs { u32x4 uu[4], bb[4]; };
struct ConvHalo { u32x4 uu[2]; f32x4 w[3][2]; };
__device__ __forceinline__ void conv_issue(ConvRegs& R, const bf16_t* P, int row0, int rl0, int lane) {
    const int c0 = lane * 8;
    const bf16_t* pr = P + (size_t)(row0 + rl0) * INCP;
#pragma unroll
    for (int i = 0; i < 4; ++i) { const bf16_t* q = pr + (size_t)i * INCP;
        R.bb[i] = __builtin_nontemporal_load((const u32x4*)(q + 768 + c0));
        if (i < 2) R.uu[i] = __builtin_nontemporal_load((const u32x4*)(q + 1280 + c0));
        else R.uu[i] = *(const u32x4*)(q + 1280 + c0); }
}
__device__ __forceinline__ void conv_halo(ConvHalo& H, const MkArgs& a, const bf16_t* P, int row0, int nb, int rl0, int lane) {
    const int c0 = lane * 8;
    const float* cwp = a.conv_w; asm volatile("" : "+s"(cwp));
    const bf16_t* pr = P + (size_t)(row0 + rl0 - 2) * INCP;
    const bool halo = (nb > 0) || (rl0 > 0);
#pragma unroll
    for (int i = 0; i < 2; ++i) { H.uu[i] = (u32x4){0u, 0u, 0u, 0u};
        if (halo) H.uu[i] = *(const u32x4*)(pr + (size_t)i * INCP + 1280 + c0); }
#pragma unroll
    for (int d = 0; d < 3; ++d) { H.w[d][0] = *(const f32x4*)(cwp + d * CONVW + c0); H.w[d][1] = *(const f32x4*)(cwp + d * CONVW + c0 + 4); }
}
__device__ __forceinline__ void conv_finish(const ConvRegs& R, const ConvHalo& H, bf16_t* MIX, int row0, int rl0, int lane) {
    const int c0 = lane * 8;
    float cw[3][8];
#pragma unroll
    for (int d = 0; d < 3; ++d) { const f32x4 w0 = H.w[d][0], w1 = H.w[d][1];
        cw[d][0] = w0.x; cw[d][1] = w0.y; cw[d][2] = w0.z; cw[d][3] = w0.w; cw[d][4] = w1.x; cw[d][5] = w1.y; cw[d][6] = w1.z; cw[d][7] = w1.w; }
    float u2[8], u1[8];
#pragma unroll
    for (int q = 0; q < 4; ++q) { u2[2 * q] = __uint_as_float(H.uu[0][q] << 16); u2[2 * q + 1] = __uint_as_float(H.uu[0][q] & 0xffff0000u);
        u1[2 * q] = __uint_as_float(H.uu[1][q] << 16); u1[2 * q + 1] = __uint_as_float(H.uu[1][q] & 0xffff0000u); }
#pragma unroll
    for (int r = 0; r < 4; ++r) {
        float y[8], u0[8], s2 = 0.f;
#pragma unroll
        for (int q = 0; q < 4; ++q) {
            u0[2 * q] = __uint_as_float(R.uu[r][q] << 16); u0[2 * q + 1] = __uint_as_float(R.uu[r][q] & 0xffff0000u);
            y[2 * q] = __uint_as_float(R.bb[r][q] << 16) * (cw[0][2 * q] * u2[2 * q] + cw[1][2 * q] * u1[2 * q] + cw[2][2 * q] * u0[2 * q]);
            y[2 * q + 1] = __uint_as_float(R.bb[r][q] & 0xffff0000u) * (cw[0][2 * q + 1] * u2[2 * q + 1] + cw[1][2 * q + 1] * u1[2 * q + 1] + cw[2][2 * q + 1] * u0[2 * q + 1]);
            s2 += y[2 * q] * y[2 * q] + y[2 * q + 1] * y[2 * q + 1];
        }
        const float rc = rsqrtf(wave_sum(s2) * (1.f / CONVW) + EPS);
        u32x4 w; w.x = cvtpk(y[0] * rc, y[1] * rc); w.y = cvtpk(y[2] * rc, y[3] * rc); w.z = cvtpk(y[4] * rc, y[5] * rc); w.w = cvtpk(y[6] * rc, y[7] * rc);
        *(u32x4*)(MIX + (size_t)(row0 + rl0 + r) * DM + 512 + c0) = w;
#pragma unroll
        for (int q = 0; q < 8; ++q) { u2[q] = u1[q]; u1[q] = u0[q]; }
    }
}

__device__ __forceinline__ void p2_attn_conv(const Frame& F, const MkArgs& a) {
    const bf16_t* P = (const bf16_t*)(a.ws + WS_P); bf16_t* MIX = (bf16_t*)(a.ws + WS_MIX);
    LAS unsigned char* L = F.lds;
    const int wave = F.wave;
    for (int unit = F.bx; unit < NTOK / 128; unit += F.G) {
        const int tid = tid_of(wave);
        const int lane = tid & 63;
        Frame Fl = F; Fl.tid = tid; Fl.lane = lane;
        const int b = unit >> 7, nb = unit & 127, row0 = b * SEQ + nb * 128;
        __syncthreads();
#pragma unroll
        for (int i = 0; i < 8; ++i) {
            const int idx = tid + 512 * i, hk = idx >> 11, key = (idx >> 3) & 255, ch = idx & 7;
            u32x4 kv = (u32x4){0u, 0u, 0u, 0u}, vv = (u32x4){0u, 0u, 0u, 0u};
            if (nb > 0 || key >= 128) { const bf16_t* src = P + (size_t)(row0 - 128 + key) * INCP + 512 + hk * 64 + ch * 8; kv = *(const u32x4*)src; vv = *(const u32x4*)(src + 128); }
            *(LAS u32x4*)(L + hk * A_HK + A_KOFF + ch * 4096 + key * 16) = kv;
            *(LAS u32x4*)(L + hk * A_HK + A_VOFF + (ch >> 2) * 16384 + (key >> 4) * 1024 + (key & 15) * 64 + (ch & 3) * 16) = vv;
        }
        __syncthreads();
        {
            const int qt = wave & 3, gw = wave >> 2, r32 = lane & 31, hi = lane >> 5;
            const bf16_t* Qp = P + (size_t)(row0 + qt * 32 + r32) * INCP + hi * 8;
            float sq[4] = {0.f, 0.f, 0.f, 0.f};
            bf16x8 qc[4];
#pragma unroll
            for (int d0 = 0; d0 < 4; ++d0) qc[d0] = *(const bf16x8*)(Qp + gw * 64 + d0 * 16);
            ConvRegs CR;
            conv_issue(CR, P, row0, wave * 16, lane);
#pragma unroll 1
            for (int s = 0; s < 4; ++s) {
                const int hk = s >> 1, g = gw + 2 * (s & 1), h = hk * 4 + g;
                const float slope2 = __builtin_amdgcn_exp2f(-(float)(h + 1)) * LOG2E, sink2 = a.sinks[h] * LOG2E;
                f32x16 o[2]; float l;
                const int sn = s < 3 ? s + 1 : 3, hn = (sn >> 1) * 4 + gw + 2 * (sn & 1);
                attn_core(Fl, qc, Qp + hn * 64, nb, hk, qt, slope2, sink2, o, l);
                __builtin_amdgcn_sched_barrier(0);
                ConvHalo CH; conv_halo(CH, a, P, row0, nb, wave * 16 + s * 4, lane);
                __builtin_amdgcn_sched_barrier(0);
                attn_store(Fl, o, l, MIX, row0, h, qt, sq);
                conv_finish(CR, CH, MIX, row0, wave * 16 + s * 4, lane);
                if (s < 3) conv_issue(CR, P, row0, wave * 16 + (s + 1) * 4, lane);
            }
            const int l2 = tid_of(wave) & 63;
            if ((l2 & 7) == 0) {
                LAS float* part = (LAS float*)(L + A_SSQ) + wave * 32 + (l2 >> 3);
#pragma unroll
                for (int i = 0; i < 4; ++i) part[i * 8] = sq[i];
            }
        }
        __syncthreads();
        if (tid < 128) { const LAS float* part = (const LAS float*)(L + A_SSQ); const int qt = tid >> 5, r = tid & 31;
            const float s = part[qt * 32 + r] + part[(qt + 4) * 32 + r];
            ((float*)(a.ws + WS_RSA))[row0 + tid] = rsqrtf(s * (1.f / ATTW) + EPS); }
    }
    __syncthreads();
}

constexpr int R_XT = 0, R_PITCH = 4112, R_PART = 32 * R_PITCH, R_RSTD = R_PART + 128 * 33 * 4, R_HIST = R_RSTD + 512, R_BASE = R_HIST + 128;
static_assert(R_BASE + 128 <= MISC_OFF, "P4 LDS map");
__device__ __forceinline__ void p4_router(const Frame& F, const MkArgs& a, bool dummy) {
    const float* X = a.x; const bf16_t* MO = (const bf16_t*)(a.ws + WS_MO); bf16_t* X1B = (bf16_t*)(a.ws + WS_X1B); const float* WR = (const float*)(a.ws + WS_WR); bf16_t* H2 = (bf16_t*)(a.ws + WS_XN);
    unsigned* gcnt = (unsigned*)(a.ws + WS_CTL) + CW_CNT + (dummy ? 64 : 0); int* list = (int*)(a.ws + (dummy ? WS_DUMMY : WS_LIST));
    int* TE = (int*)(a.ws + (dummy ? WS_DUMMY + 8 * MiB : WS_TE)); int* TP = (int*)(a.ws + (dummy ? WS_DUMMY + 9 * MiB : WS_TP)); float* TG = (float*)(a.ws + (dummy ? WS_DUMMY + 10 * MiB : WS_TG));
    LAS unsigned char* L = F.lds;
    LAS float* part = (LAS float*)(L + R_PART); LAS float* rsl = (LAS float*)(L + R_RSTD); LAS unsigned* hist = (LAS unsigned*)(L + R_HIST); LAS unsigned* gb = (LAS unsigned*)(L + R_BASE);
    const int tid = F.tid, lane = F.lane, wave = F.wave;
    float wreg[16][4];
    { const float* wrp = WR + (size_t)(128 * wave + 4 * (lane >> 5)) * NE + (lane & 31);
#pragma unroll
      for (int it = 0; it < 16; ++it)
#pragma unroll
          for (int e = 0; e < 4; ++e) wreg[it][e] = wrp[(8 * it + e) * NE]; }
    for (int chunk = F.bx; chunk < NTOK / 128; chunk += F.G) {
        const int rowbase = chunk * 128;
        __syncthreads();
        if (tid < 32) hist[tid] = 0u;
        f32x4 v[4][4]; u32x2 mo[4][4];
#define P4_LOADROWS(t_) do { _Pragma("unroll") for (int r = 0; r < 4; ++r) { const size_t row_ = (size_t)(rowbase + 32 * (t_) + wave * 4 + r); \
            const f32x4* xr_ = (const f32x4*)(X + row_ * DM) + lane; const u32x2* mr_ = (const u32x2*)(MO + row_ * DM) + lane; \
            _Pragma("unroll") for (int j = 0; j < 4; ++j) { v[r][j] = xr_[64 * j]; mo[r][j] = mr_[64 * j]; } } } while (0)
        P4_LOADROWS(0);
#pragma unroll 1
        for (int t = 0; t < 4; ++t) {
#pragma unroll
            for (int r = 0; r < 4; ++r) {
                const int rl = 32 * t + wave * 4 + r; float s2 = 0.f;
                u32x2* xb = (u32x2*)(X1B + (size_t)(rowbase + rl) * DM) + lane;
#pragma unroll
                for (int j = 0; j < 4; ++j) {
                    v[r][j].x += __uint_as_float(mo[r][j].x << 16); v[r][j].y += __uint_as_float(mo[r][j].x & 0xffff0000u); v[r][j].z += __uint_as_float(mo[r][j].y << 16); v[r][j].w += __uint_as_float(mo[r][j].y & 0xffff0000u);
                    u32x2 w; w.x = cvtpk(v[r][j].x, v[r][j].y); w.y = cvtpk(v[r][j].z, v[r][j].w); __builtin_nontemporal_store(w, xb + 64 * j);
                    s2 += (v[r][j].x * v[r][j].x + v[r][j].y * v[r][j].y) + (v[r][j].z * v[r][j].z + v[r][j].w * v[r][j].w); }
                const float rstd = rsqrtf(wave_sum(s2) * (1.f / DM) + EPS);
#if MOE_FP8
                unsigned* o4 = (unsigned*)((unsigned char*)H2 + (size_t)(rowbase + rl) * DM) + lane;
#pragma unroll
                for (int j = 0; j < 4; ++j) o4[64 * j] = pg8::pack4_fp8(v[r][j].x * rstd, v[r][j].y * rstd, v[r][j].z * rstd, v[r][j].w * rstd);
#else
                u32x2* o8 = (u32x2*)(H2 + (size_t)(rowbase + rl) * DM) + lane;
#pragma unroll
                for (int j = 0; j < 4; ++j) { u32x2 w; w.x = cvtpk(v[r][j].x * rstd, v[r][j].y * rstd); w.y = cvtpk(v[r][j].z * rstd, v[r][j].w * rstd); o8[64 * j] = w; }
#endif
                if (lane == 0) rsl[rl] = rstd;
            }
            __syncthreads();
#pragma unroll
            for (int r = 0; r < 4; ++r)
#pragma unroll
                for (int j = 0; j < 4; ++j) *(LAS f32x4*)(L + R_XT + (wave * 4 + r) * R_PITCH + (256 * j + 4 * lane) * 4) = v[r][j];
            __syncthreads();
            if (t < 3) P4_LOADROWS(t + 1);
            {
                const int i = lane & 31, h = lane >> 5;
                const LAS unsigned char* xp = L + R_XT + i * R_PITCH + (128 * wave + 4 * h) * 4;
                f32x16 acc;
#pragma unroll
                for (int r = 0; r < 16; ++r) acc[r] = 0.f;
#pragma unroll
                for (int it = 0; it < 16; ++it) {
                    const f32x4 xa = *(const LAS f32x4*)(xp + it * 32);
                    acc = __builtin_amdgcn_mfma_f32_32x32x2f32(xa.x, wreg[it][0], acc, 0, 0, 0); acc = __builtin_amdgcn_mfma_f32_32x32x2f32(xa.y, wreg[it][1], acc, 0, 0, 0);
                    acc = __builtin_amdgcn_mfma_f32_32x32x2f32(xa.z, wreg[it][2], acc, 0, 0, 0); acc = __builtin_amdgcn_mfma_f32_32x32x2f32(xa.w, wreg[it][3], acc, 0, 0, 0);
                }
                __syncthreads();
                LAS float* slot = (LAS float*)(L + R_XT) + wave * (32 * 33);
#pragma unroll
                for (int r = 0; r < 16; ++r) slot[crow(r, h) * 33 + (lane & 31)] = acc[r];
                __syncthreads();
#pragma unroll
                for (int q = 0; q < 2; ++q) { const int idx = tid + 512 * q, row = idx >> 5, ex = idx & 31; float sum = 0.f;
#pragma unroll
                    for (int w8 = 0; w8 < 8; ++w8) sum += ((const LAS float*)(L + R_XT))[w8 * (32 * 33) + row * 33 + ex];
                    part[(32 * t + row) * 33 + ex] = sum; }
            }
        }
#undef P4_LOADROWS
        __syncthreads();
        int ek[4] = {0, 0, 0, 0}; unsigned lp[4] = {0u, 0u, 0u, 0u}; float gk[4] = {0.f, 0.f, 0.f, 0.f};
        if (tid < 128) {
            float lg[32]; const float rstd = rsl[tid];
#pragma unroll
            for (int e = 0; e < 32; ++e) lg[e] = part[tid * 33 + e] * rstd + a.b_router[e];
            unsigned used = 0u; float val[4];
#pragma unroll
            for (int k = 0; k < 4; ++k) { float best = -INFINITY; int bi = 0;
#pragma unroll
                for (int j = 0; j < 32; ++j) { const bool take = !((used >> j) & 1u) && lg[j] > best; best = take ? lg[j] : best; bi = take ? j : bi; }
                used |= 1u << bi; ek[k] = bi; val[k] = best; }
            float es[4], sum = 0.f;
#pragma unroll
            for (int k = 0; k < 4; ++k) { es[k] = __expf(val[k] - val[0]); sum += es[k]; }
            const float inv = 1.f / sum;
#pragma unroll
            for (int k = 0; k < 4; ++k) { gk[k] = es[k] * inv; lp[k] = atomicAdd((unsigned*)&hist[ek[k]], 1u); }
        }
        __syncthreads();
        if (tid < 32) { const unsigned n = hist[tid]; gb[tid] = n ? atomicAdd(&gcnt[tid], n) : 0u; }
        __syncthreads();
        if (tid < 128) {
            const int tok = rowbase + tid;
#pragma unroll
            for (int k = 0; k < 4; ++k) { const unsigned pos = gb[ek[k]] + lp[k]; list[(size_t)ek[k] * NTOK + pos] = tok; TE[tok * 4 + k] = ek[k]; TP[tok * 4 + k] = (int)pos; TG[tok * 4 + k] = gk[k]; }
        }
    }
    __syncthreads();
}

__device__ __forceinline__ int moe_tables(const Frame& F, const MkArgs& a) {
    LAS int* cnt = (LAS int*)(F.lds + CNT_OFF); LAS int* ts = (LAS int*)(F.lds + TSTART_OFF); LAS int* te = (LAS int*)(F.lds + TILEE_OFF);
    const unsigned* gcnt = (const unsigned*)(a.ws + WS_CTL) + CW_CNT;
    __syncthreads();
    if (F.tid < 32) cnt[F.tid] = (int)__hip_atomic_load(gcnt + F.tid, RLX_AGENT);
    __syncthreads();
    if (F.tid == 0) { int s = 0; for (int e = 0; e < NE; ++e) { ts[e] = s; s += (cnt[e] + 255) >> 8; } ts[32] = s; }
    __syncthreads();
    const int total = ts[32];
    for (int t = F.tid; t < total && t < MAXTILES; t += NTHREADS) { int e = 0;
#pragma unroll 1
        for (int q = 1; q < NE; ++q) e += (ts[q] <= t) ? 1 : 0;
        te[t] = e; }
    __syncthreads();
    return total < MAXTILES ? total : MAXTILES;
}

__device__ __forceinline__ void p7_combine(const Frame& F, const MkArgs& a, bool dummy) {
    float* const dst = dummy ? (float*)(a.ws + WS_DUMMY) : a.out;
    const bf16_t* Y = (const bf16_t*)(a.ws + WS_Y); const int* TE = (const int*)(a.ws + WS_TE); const int* TP = (const int*)(a.ws + WS_TP); const float* TG = (const float*)(a.ws + WS_TG);
    LAS int* ts = (LAS int*)(F.lds + TSTART_OFF);
    const int gw = F.bx * NWAVES + F.wave, NGW = F.G * NWAVES, lane = F.lane, l7 = lane & 7;
    f32x4 gf[2][2];
#pragma unroll
    for (int j = 0; j < 2; ++j) { gf[j][0] = *(const f32x4*)(a.g_final + 512 * j + 8 * lane); gf[j][1] = *(const f32x4*)(a.g_final + 512 * j + 8 * lane + 4); }
    int t0 = 2 * gw;
    int e_c = 0, p_c = 0; float g_c = 0.f;
    if (t0 < NTOK) { e_c = TE[t0 * 4 + l7]; p_c = TP[t0 * 4 + l7]; g_c = TG[t0 * 4 + l7]; }
    for (; t0 < NTOK; t0 += 2 * NGW) {
        const int slot_l = 256 * ts[e_c & 31] + p_c; const float g_l = g_c;
        const int tn = t0 + 2 * NGW;
        if (tn < NTOK) { e_c = TE[tn * 4 + l7]; p_c = TP[tn * 4 + l7]; g_c = TG[tn * 4 + l7]; }
#if MOE_FP8
        f32x4 v[2][2][2]; u32x2 y[2][4][2]; float gk[2][4];
#else
        f32x4 v[2][2][2]; u32x4 y[2][4][2]; float gk[2][4];
#endif
#pragma unroll
        for (int tt = 0; tt < 2; ++tt) {
            const bf16_t* xr = (const bf16_t*)(a.ws + WS_X1B) + (size_t)(t0 + tt) * DM + 8 * lane;
#pragma unroll
            for (int j = 0; j < 2; ++j) { const u32x4 xb = *(const u32x4*)(xr + 512 * j);
                v[tt][j][0] = (f32x4){__uint_as_float(xb.x << 16), __uint_as_float(xb.x & 0xffff0000u), __uint_as_float(xb.y << 16), __uint_as_float(xb.y & 0xffff0000u)};
                v[tt][j][1] = (f32x4){__uint_as_float(xb.z << 16), __uint_as_float(xb.z & 0xffff0000u), __uint_as_float(xb.w << 16), __uint_as_float(xb.w & 0xffff0000u)}; }
#pragma unroll
            for (int k = 0; k < 4; ++k) {
                const int slot = __builtin_amdgcn_readlane(slot_l, tt * 4 + k);
                gk[tt][k] = __uint_as_float(__builtin_amdgcn_readlane(__float_as_uint(g_l), tt * 4 + k));
#if MOE_FP8
                const unsigned char* yr = (const unsigned char*)Y + (size_t)slot * DM + 8 * lane;
                y[tt][k][0] = *(const u32x2*)(yr); y[tt][k][1] = *(const u32x2*)(yr + 512);
#else
                const bf16_t* yr = Y + (size_t)slot * DM + 8 * lane;
                y[tt][k][0] = *(const u32x4*)(yr); y[tt][k][1] = *(const u32x4*)(yr + 512);
#endif
            }
        }
#pragma unroll
        for (int tt = 0; tt < 2; ++tt) {
#pragma unroll
            for (int k = 0; k < 4; ++k) { const float g = gk[tt][k];
#pragma unroll
#if MOE_FP8
                for (int j = 0; j < 2; ++j) { const u32x2 yy = y[tt][k][j];
                    const f32x2 a0 = __builtin_amdgcn_cvt_pk_f32_fp8((int)yy.x, false), a1 = __builtin_amdgcn_cvt_pk_f32_fp8((int)yy.x, true), a2 = __builtin_amdgcn_cvt_pk_f32_fp8((int)yy.y, false), a3 = __builtin_amdgcn_cvt_pk_f32_fp8((int)yy.y, true);
                    v[tt][j][0].x += g * a0.x; v[tt][j][0].y += g * a0.y; v[tt][j][0].z += g * a1.x; v[tt][j][0].w += g * a1.y;
                    v[tt][j][1].x += g * a2.x; v[tt][j][1].y += g * a2.y; v[tt][j][1].z += g * a3.x; v[tt][j][1].w += g * a3.y; } }
#else
                for (int j = 0; j < 2; ++j) { const u32x4 yy = y[tt][k][j];
                    v[tt][j][0].x += g * __uint_as_float(yy.x << 16); v[tt][j][0].y += g * __uint_as_float(yy.x & 0xffff0000u); v[tt][j][0].z += g * __uint_as_float(yy.y << 16); v[tt][j][0].w += g * __uint_as_float(yy.y & 0xffff0000u);
                    v[tt][j][1].x += g * __uint_as_float(yy.z << 16); v[tt][j][1].y += g * __uint_as_float(yy.z & 0xffff0000u); v[tt][j][1].z += g * __uint_as_float(yy.w << 16); v[tt][j][1].w += g * __uint_as_float(yy.w & 0xffff0000u); } }
#endif
            float s2 = 0.f;
#pragma unroll
            for (int j = 0; j < 2; ++j)
#pragma unroll
                for (int q = 0; q < 2; ++q) s2 += (v[tt][j][q].x * v[tt][j][q].x + v[tt][j][q].y * v[tt][j][q].y) + (v[tt][j][q].z * v[tt][j][q].z + v[tt][j][q].w * v[tt][j][q].w);
            const float rstd = rsqrtf(wave_sum(s2) * (1.f / DM) + EPS);
            float* xr = dst + (size_t)(t0 + tt) * DM + 8 * lane;
#pragma unroll
            for (int j = 0; j < 2; ++j)
#pragma unroll
                for (int q = 0; q < 2; ++q) *(f32x4*)(xr + 512 * j + 4 * q) = v[tt][j][q] * rstd * gf[j][q];
        }
    }
}

__global__ void __launch_bounds__(NTHREADS, 2) mk_fwd(MkArgs args) {
    extern __shared__ __attribute__((aligned(16))) unsigned char lds_raw[];
    Frame F;
    F.lds = (LAS unsigned char*)lds_raw;
    F.tid = threadIdx.x; F.lane = F.tid & 63; F.wave = __builtin_amdgcn_readfirstlane(F.tid >> 6); F.G = gridDim.x; F.bx = blockIdx.x;
    volatile LAS unsigned* MISC = (volatile LAS unsigned*)(F.lds + MISC_OFF);
    if (F.tid < 32) MISC[F.tid] = 0u;
    __syncthreads();
    const int lo = args.ph_lo, hi = args.ph_hi;
    unsigned* ctl = (unsigned*)(args.ws + WS_CTL);
    XcdBarrier bar; bar.bar = ctl + CW_BAR; bar.x = 0; bar.st = nullptr; bar.wave = F.wave;
    if (hi - lo > 1) bar = xcd_barrier_post(ctl + CW_BAR, MISC + 8, F.wave);
#ifndef PHASE_SEL
#define PHASE_SEL 0xFF
#endif
#define IN(k) (((PHASE_SEL >> (k)) & 1) && lo <= (k) && (k) < hi)
#define SEAM(k) do { if (IN(k) && IN((k) + 1)) xcd_barrier(bar); F.tid = tid_of(F.wave); F.lane = F.tid & 63; } while (0)
#ifndef REP_MASK
#define REP_MASK 0
#endif
#define REPS(k) for (int rep_ = 0; rep_ < (((REP_MASK >> (k)) & 1) ? 2 : 1); ++rep_)
    unsigned char* ws = args.ws;
    F.tid = tid_of(F.wave); F.lane = F.tid & 63;
    constexpr int P0_SMALL = (DM / 64) * (INC / 64) + (DM / 64) * (DM / 64);
    const bool split = (F.G == 256) && SPLIT_CONV;
    const int p0_hi = split ? P0_SMALL + CONV_IN_P0 : 0x7fffffff;
    if (IN(0)) REPS(0) { p0_prologue(F, args, 0, p0_hi, F.bx * NWAVES + F.wave, F.G * NWAVES, true); }
    SEAM(0);
    if (IN(1)) REPS(1) {
        const int grp = F.bx >> 3;
        if (split && (grp & 3) == 3) {
            const int rank = (grp >> 2) * 8 + (F.bx & 7);
            p0_prologue(F, args, p0_hi, 0x7fffffff, rank * NWAVES + F.wave, 64 * NWAVES, false);
        } else {
            const int Gg = split ? 192 : F.G, cg = split ? (grp - (grp >> 2)) * 8 + (F.bx & 7) : F.bx;
            pg8::ProbDense S{(const bf16_t*)(ws + WS_XN), (const bf16_t*)(ws + WS_WIN), NTOK / 256, INC / 256, Gg, cg, ws + WS_DUMMY};
            pg8::EpiP E{(bf16_t*)(ws + WS_P)};
            pg8::gemm_phase<pg8::ProbDense, pg8::EpiP, true>(F.lds + RING_OFF, S, E, F.wave);
        }
    }
    SEAM(1);
    if (IN(2)) REPS(2) { p2_attn_conv(F, args); }
    SEAM(2);
    if (IN(3)) REPS(3) {
        pg8::ProbDense S{(const bf16_t*)(ws + WS_MIX), (const bf16_t*)(ws + WS_WOUT), NTOK / 256, DM / 256, F.G, F.bx, ws + WS_DUMMY};
        pg8::EpiMo E{(bf16_t*)(ws + WS_MO), (const float*)(ws + WS_RSA)};
        pg8::gemm_phase<pg8::ProbDense, pg8::EpiMo, true>(F.lds + RING_OFF, S, E, F.wave);
    }
    SEAM(3);
    if (IN(4)) REPS(4) { p4_router(F, args, ((REP_MASK >> 4) & 1) && rep_ == 0); }
    SEAM(4);
    if (IN(5)) REPS(5) {
        const int nM = moe_tables(F, args);
        LAS int* te = (LAS int*)(F.lds + TILEE_OFF); LAS int* ts = (LAS int*)(F.lds + TSTART_OFF); LAS int* cnt = (LAS int*)(F.lds + CNT_OFF); LAS unsigned* idtab = (LAS unsigned*)(F.lds + IDTAB_OFF);
        pg8::ProbG1<MOE_FP8 != 0> S{(const unsigned char*)(ws + WS_XN), (const unsigned char*)(ws + WS_W1), nM, F.G, F.bx, te, idtab, ws + WS_DUMMY};
        const int* list = (const int*)(ws + WS_LIST);
        pg8::Unit u;
        for (int i = 0; i < IDTAB_UNITS && S.next(i, u); ++i) {
            if (F.tid < 256) { const int rie = (u.pm - ts[u.e]) * 256 + F.tid; const int tok = rie < cnt[u.e] ? list[(size_t)u.e * NTOK + rie] : 0; idtab[i * 256 + F.tid] = (unsigned)tok * (unsigned)(pg8::ProbG1<MOE_FP8 != 0>::KB); }
        }
        __syncthreads();
        phase_stagger(F, nM * 8, STG5);
#if MOE_FP8
        pg8::EpiAct8 E{(unsigned char*)(ws + WS_ACT), args.b1, (const LAS float*)(F.lds + BIAS_OFF)};
        pg8::gemm_phase<pg8::ProbG1<true>, pg8::EpiAct8, true>(F.lds + RING_OFF, S, E, F.wave);
#else
        pg8::EpiAct E{(bf16_t*)(ws + WS_ACT), args.b1};
        pg8::gemm_phase<pg8::ProbG1<false>, pg8::EpiAct, true>(F.lds + RING_OFF, S, E, F.wave);
#endif
    }
    SEAM(5);
    if (IN(6)) REPS(6) {
        const int nM = moe_tables(F, args);
        LAS int* te = (LAS int*)(F.lds + TILEE_OFF);
        pg8::ProbG2<MOE_FP8 != 0> S{(const unsigned char*)(ws + WS_ACT), (const unsigned char*)(ws + WS_W2), nM, F.G, F.bx, te, ws + WS_DUMMY};
#if MOE_FP8
        pg8::EpiY8 E{(unsigned char*)(ws + WS_Y), args.b2, (const LAS float*)(F.lds + BIAS_OFF)};
        pg8::gemm_phase<pg8::ProbG2<true>, pg8::EpiY8, true>(F.lds + RING_OFF, S, E, F.wave);
#else
        pg8::EpiY E{(bf16_t*)(ws + WS_Y), args.b2, (const LAS float*)(F.lds + BIAS_OFF)};
        pg8::gemm_phase<pg8::ProbG2<false>, pg8::EpiY, true>(F.lds + RING_OFF, S, E, F.wave);
#endif
    }
    SEAM(6);
    if (IN(7)) REPS(7) { (void)moe_tables(F, args); p7_combine(F, args, ((REP_MASK >> 7) & 1) && rep_ == 0); }
#undef IN
#undef SEAM
}

#ifndef MK_MASK
#define MK_MASK 0xFF
#endif
#ifndef MK_ONE
#define MK_ONE 1
#endif

extern "C" void kernel_launch(void* const* d_in, const int* in_sizes, int n_in, void* d_out, int out_size, void* d_ws, size_t ws_size, hipStream_t stream) {
    if (n_in != 16 || out_size != NTOK * DM || ws_size < WS_END) { fprintf(stderr, "kernel_launch: unexpected shapes (n_in %d out %d ws %zu)\n", n_in, out_size, ws_size); return; }
    const float* x = (const float*)d_in[0]; const float* g_mix = (const float*)d_in[1]; const float* w_in = (const float*)d_in[2]; const float* conv_w = (const float*)d_in[3];
    const float* sinks = (const float*)d_in[4]; const float* g_ao = (const float*)d_in[5]; const float* g_co = (const float*)d_in[6]; const float* w_out = (const float*)d_in[7];
    const float* g_ffn = (const float*)d_in[8]; const float* w_router = (const float*)d_in[9]; const float* b_router = (const float*)d_in[10]; const float* w1 = (const float*)d_in[11];
    const float* b1 = (const float*)d_in[12]; const float* w2 = (const float*)d_in[13]; const float* b2 = (const float*)d_in[14]; const float* g_final = (const float*)d_in[15];
    unsigned char* ws = (unsigned char*)d_ws; float* out = (float*)d_out;
    static int grid = 0;
    if (grid == 0) {
        int dev = 0, cus = 0, per_cu = 0;
        if (hipGetDevice(&dev) != hipSuccess || hipDeviceGetAttribute(&cus, hipDeviceAttributeMultiprocessorCount, dev) != hipSuccess) { fprintf(stderr, "kernel_launch: device query failed\n"); grid = -1; return; }
        if (hipFuncSetAttribute((const void*)mk_fwd, hipFuncAttributeMaxDynamicSharedMemorySize, LDS_BYTES) != hipSuccess) { fprintf(stderr, "kernel_launch: hipFuncSetAttribute failed\n"); grid = -1; return; }
        if (hipOccupancyMaxActiveBlocksPerMultiprocessor(&per_cu, (const void*)mk_fwd, NTHREADS, LDS_BYTES) != hipSuccess || per_cu < 1) { fprintf(stderr, "kernel_launch: occupancy query says %d blocks per CU\n", per_cu); per_cu = 1; }
        (void)hipGetLastError();
        grid = cus;
    }
    if (grid < 0) return;
    (void)hipMemsetAsync(ws + WS_CTL, 0, CTL_BYTES, stream);
    MkArgs a{};
    a.x = x; a.g_mix = g_mix; a.w_in = w_in; a.conv_w = conv_w; a.sinks = sinks; a.g_ao = g_ao; a.g_co = g_co; a.w_out = w_out; a.g_ffn = g_ffn; a.w_router = w_router; a.b_router = b_router;
    a.w1 = w1; a.b1 = b1; a.w2 = w2; a.b2 = b2; a.g_final = g_final; a.out = out; a.ws = ws;
#if MK_ONE
    a.ph_lo = 0; a.ph_hi = 8;
    hipLaunchKernelGGL(mk_fwd, dim3(grid), dim3(NTHREADS), LDS_BYTES, stream, a);
#else
    unsigned* ctl = (unsigned*)(ws + WS_CTL);
    bf16_t* Win_t = (bf16_t*)(ws + WS_WIN); bf16_t* Wout_t = (bf16_t*)(ws + WS_WOUT); float* WR = (float*)(ws + WS_WR); int* list = (int*)(ws + WS_LIST);
    int* TE = (int*)(ws + WS_TE); int* TP = (int*)(ws + WS_TP); float* TG = (float*)(ws + WS_TG); int* tab = (int*)(ws + WS_TAB); float* gcat = (float*)(ws + WS_TAB + 16384);
    bf16_t* W1_t = (bf16_t*)(ws + WS_W1); bf16_t* W2_t = (bf16_t*)(ws + WS_W2); bf16_t* XN = (bf16_t*)(ws + WS_XN); bf16_t* P = (bf16_t*)(ws + WS_P);
    bf16_t* MIX = (bf16_t*)(ws + WS_MIX); bf16_t* ACT = (bf16_t*)(ws + WS_ACT); bf16_t* Y = (bf16_t*)(ws + WS_Y); float* ATT = (float*)(ws + WS_ATT);
    for (int p = 0; p < 8; ++p) {
        if ((MK_MASK >> p) & 1) { a.ph_lo = p; a.ph_hi = p + 1; hipLaunchKernelGGL(mk_fwd, dim3(grid), dim3(NTHREADS), LDS_BYTES, stream, a); continue; }
        switch (p) {
        case 0:
            n_gcat<<<4, 256, 0, stream>>>(g_ao, g_co, gcat);
            n_transpose<<<dim3(DM / 32, INC / 32, 1), dim3(32, 8), 0, stream>>>(w_in, Win_t, DM, INC, g_mix);
            n_transpose<<<dim3(DM / 32, DM / 32, 1), dim3(32, 8), 0, stream>>>(w_out, Wout_t, DM, DM, gcat);
            n_transpose<<<dim3(DM / 32, 2048 / 32, NE), dim3(32, 8), 0, stream>>>(w1, W1_t, DM, 2048, g_ffn);
            n_transpose<<<dim3(DFF / 32, DM / 32, NE), dim3(32, 8), 0, stream>>>(w2, W2_t, DFF, DM, nullptr);
            n_wr<<<DM * NE / 256, 256, 0, stream>>>(w_router, g_ffn, WR);
            n_xn<<<NTOK, 256, 0, stream>>>(x, XN); break;
        case 1: { NG g{}; g.A = XN; g.Bt = Win_t; g.Ob = P; n_gemm<0><<<dim3(NTOK / 128, INC / 128), 256, 0, stream>>>(g); } break;
        case 2: n_attn<<<NTOK * NQH / 4, 256, 0, stream>>>(P, sinks, ATT); n_mix<<<NTOK, 256, 0, stream>>>(P, ATT, conv_w, MIX); break;
        case 3: { NG g{}; g.A = MIX; g.Bt = Wout_t; g.Of = out; g.X = x; n_gemm<1><<<dim3(NTOK / 128, DM / 128), 256, 0, stream>>>(g); } break;
        case 4: n_router<<<NTOK, 256, 0, stream>>>(out, WR, b_router, XN, ctl + CW_CNT, list, TE, TP, TG); break;
        case 5: n_tables<<<1, 64, 0, stream>>>(ctl + CW_CNT, tab);
            { NG g{}; g.A = XN; g.Bt = W1_t; g.Ob = ACT; g.bias = b1; g.list = list; g.cnt = ctl + CW_CNT; g.tab = tab; n_gemm<2><<<dim3(PADROWS / 128, DFF / 128), 256, 0, stream>>>(g); } break;
        case 6: n_tables<<<1, 64, 0, stream>>>(ctl + CW_CNT, tab);
            { NG g{}; g.A = ACT; g.Bt = W2_t; g.Ob = Y; g.bias = b2; g.list = list; g.cnt = ctl + CW_CNT; g.tab = tab; n_gemm<3><<<dim3(PADROWS / 128, DM / 128), 256, 0, stream>>>(g); } break;
        case 7: n_tables<<<1, 64, 0, stream>>>(ctl + CW_CNT, tab); n_combine<<<NTOK, 256, 0, stream>>>(out, Y, TE, TP, TG, tab, g_final, out); break;
        }
    }
#endif
}
```

```cpp
#include <hip/hip_runtime.h>
#include <cstdint>
#include <cstdio>
#ifndef SCHED44
#define SCHED44 0
#endif
#ifndef SPLIT_CONV
#define SPLIT_CONV 0
#define CONV_IN_P0 0
#endif
#ifndef STG1
#define STG1 0
#define STG3 0
#define STG5 0
#define STG6 0
#endif

typedef unsigned short bf16_t;
typedef short bf16x8 __attribute__((ext_vector_type(8)));
typedef float f32x4 __attribute__((ext_vector_type(4)));

constexpr int BATCH = 2, SEQ = 16384, DM = 1024, NTOK = BATCH * SEQ;
constexpr int NQH = 8, HD = 64, ATTW = 512, CONVW = 512, INC = 2304;
constexpr int INCP = 1792;
constexpr int NE = 32, DFF = 1024;
constexpr int MAXTILES = 544, PADROWS = MAXTILES * 256;
constexpr float EPS = 1e-5f;
constexpr float LOG2E = 1.4426950408889634f;
constexpr float C2 = 0.125f * LOG2E;
constexpr int W8_SHIFT = 5;
constexpr int W8_SCALE_E8M0 = 127 - W8_SHIFT;
#ifndef MOE_FP8
#define MOE_FP8 1
#endif

constexpr size_t MiB = 1u << 20;
constexpr size_t WS_CTL = 0, CTL_BYTES = 64 * 1024;
constexpr size_t WS_WIN = 1 * MiB, WS_WOUT = 6 * MiB, WS_WR = 8 * MiB, WS_LIST = 9 * MiB;
constexpr size_t WS_TE = 13 * MiB, WS_TP = 13 * MiB + 512 * 1024, WS_TG = 14 * MiB, WS_TAB = 14 * MiB + 512 * 1024;
constexpr size_t WS_RSA = 15 * MiB;
constexpr size_t WS_W1 = 16 * MiB, WS_W2 = 144 * MiB, WS_XN = 208 * MiB, WS_P = 272 * MiB, WS_MIX = 416 * MiB;
constexpr size_t WS_MO = 272 * MiB  , WS_X1B = 816 * MiB  ;
constexpr size_t WS_ACT = 272 * MiB, WS_Y = 544 * MiB, WS_ATT = 816 * MiB, WS_DUMMY = 880 * MiB, WS_END = 1016 * MiB;
constexpr int CW_CNT = 0;

__device__ __forceinline__ float bf2f(bf16_t v) { return __uint_as_float((unsigned)v << 16); }
__device__ __forceinline__ bf16_t f2bf(float f) { unsigned u = __float_as_uint(f); return (bf16_t)((u + 0x7fffu + ((u >> 16) & 1u)) >> 16); }

__device__ __forceinline__ float wave_sum(float v) {
#pragma unroll
    for (int o = 1; o < 64; o <<= 1) v += __shfl_xor(v, o);
    return v;
}
__device__ __forceinline__ float wave_max(float v) {
#pragma unroll
    for (int o = 1; o < 64; o <<= 1) v = fmaxf(v, __shfl_xor(v, o));
    return v;
}
__device__ __forceinline__ float block_sum256(float v, float* red) {
    v = wave_sum(v);
    __syncthreads();
    if ((threadIdx.x & 63) == 0) red[threadIdx.x >> 6] = v;
    __syncthreads();
    return red[0] + red[1] + red[2] + red[3];
}

__global__ void n_transpose(const float* W, bf16_t* WT, int K, int N, const float* g) {
    __shared__ float tile[32][33];
    const size_t zoff = (size_t)blockIdx.z * K * N;
    const int k0 = blockIdx.x * 32, n0 = blockIdx.y * 32, tx = threadIdx.x, ty = threadIdx.y;
#pragma unroll
    for (int i = 0; i < 4; ++i) { const int kk = ty + 8 * i; tile[kk][tx] = W[zoff + (size_t)(k0 + kk) * N + n0 + tx] * (g ? g[k0 + kk] : 1.f); }
    __syncthreads();
#pragma unroll
    for (int i = 0; i < 4; ++i) { const int nn = ty + 8 * i; WT[zoff + (size_t)(n0 + nn) * K + k0 + tx] = f2bf(tile[tx][nn]); }
}
__global__ void n_wr(const float* wr, const float* g, float* out) {
    const int i = blockIdx.x * 256 + threadIdx.x; if (i < DM * NE) out[i] = wr[i] * g[i >> 5];
}
__global__ void n_gcat(const float* ga, const float* gc, float* out) { const int i = blockIdx.x * 256 + threadIdx.x; if (i < DM) out[i] = i < 512 ? ga[i] : gc[i - 512]; }
__global__ __launch_bounds__(256) void n_xn(const float* x, bf16_t* XN) {
    __shared__ float red[4];
    const int row = blockIdx.x, t = threadIdx.x;
    const f32x4 v = *(const f32x4*)(x + (size_t)row * DM + 4 * t);
    const float ss = block_sum256(v.x * v.x + v.y * v.y + v.z * v.z + v.w * v.w, red);
    const float rstd = rsqrtf(ss * (1.f / DM) + EPS);
    bf16_t* o = XN + (size_t)row * DM + 4 * t;
    o[0] = f2bf(v.x * rstd); o[1] = f2bf(v.y * rstd); o[2] = f2bf(v.z * rstd); o[3] = f2bf(v.w * rstd);
}

struct NG {
    const bf16_t* A; const bf16_t* Bt; bf16_t* Ob; float* Of; const float* X; const float* bias;
    const int* list; const unsigned* cnt; const int* tab;
};
__device__ __forceinline__ float swiglu(float g, float l) {
    g = fminf(g, 7.f); l = fminf(fmaxf(l, -7.f), 7.f);
    const float s = __builtin_amdgcn_rcpf(1.f + __builtin_amdgcn_exp2f(-1.702f * LOG2E * g));
    const float a = g * s;
    return __builtin_fmaf(a, l, a);
}
typedef float f32x2v __attribute__((ext_vector_type(2)));
__device__ __forceinline__ f32x2v swiglu_pk(f32x2v g, f32x2v l) {
    g.x = __builtin_amdgcn_fmed3f(g.x, -24.f, 7.f); g.y = __builtin_amdgcn_fmed3f(g.y, -24.f, 7.f);
    l.x = __builtin_amdgcn_fmed3f(l.x, -7.f, 7.f); l.y = __builtin_amdgcn_fmed3f(l.y, -7.f, 7.f);
    const f32x2v t = g * (-1.702f * LOG2E);
    f32x2v e; e.x = __builtin_amdgcn_exp2f(t.x); e.y = __builtin_amdgcn_exp2f(t.y);
    const f32x2v d = e + 1.0f;
    const float rr = __builtin_amdgcn_rcpf(d.x * d.y);
    const f32x2v ds = {d.y, d.x};
    const f32x2v a = g * (ds * rr);
    return a * l + a;
}
template <int MODE> __global__ __launch_bounds__(256) void n_gemm(NG a) {
    const int lane = threadIdx.x & 63, w = threadIdx.x >> 6, row = lane & 15, quad = lane >> 4;
    const int m0 = blockIdx.x * 128 + (w >> 1) * 64, n0 = blockIdx.y * 128 + (w & 1) * 64;
    int e = 0, rbase = 0, cnt = 0;
    if (MODE >= 2) {
        const int pm = (blockIdx.x * 128) >> 8;
        if (pm >= a.tab[32]) return;
        e = a.tab[64 + pm]; rbase = m0 - 256 * a.tab[e]; cnt = (int)a.cnt[e];
    }
    const bf16_t* ar[4]; const bf16_t* br[4]; const bf16_t* br2[4];
#pragma unroll
    for (int i = 0; i < 4; ++i) {
        const int m = m0 + 16 * i + row;
        if (MODE == 2) { const int rr = rbase + 16 * i + row; const int tok = rr < cnt ? a.list[e * NTOK + rr] : 0; ar[i] = a.A + (size_t)tok * DM; }
        else ar[i] = a.A + (size_t)m * DM;
        const int n = n0 + 16 * i + row;
        if (MODE == 2) { br[i] = a.Bt + ((size_t)e * 2048 + n) * DM; br2[i] = br[i] + (size_t)1024 * DM; }
        else if (MODE == 3) { br[i] = a.Bt + ((size_t)e * 1024 + n) * DM; br2[i] = br[i]; }
        else { br[i] = a.Bt + (size_t)n * DM; br2[i] = br[i]; }
    }
    f32x4 acc[4][4], acc2[4][4];
#pragma unroll
    for (int i = 0; i < 4; ++i)
#pragma unroll
        for (int j = 0; j < 4; ++j) { acc[i][j] = (f32x4){0.f, 0.f, 0.f, 0.f}; acc2[i][j] = (f32x4){0.f, 0.f, 0.f, 0.f}; }
    for (int k0 = 0; k0 < DM; k0 += 32) {
        bf16x8 fa[4], fb[4], fb2[4];
#pragma unroll
        for (int i = 0; i < 4; ++i) { fa[i] = *(const bf16x8*)(ar[i] + k0 + quad * 8); fb[i] = *(const bf16x8*)(br[i] + k0 + quad * 8); if (MODE == 2) fb2[i] = *(const bf16x8*)(br2[i] + k0 + quad * 8); }
#pragma unroll
        for (int i = 0; i < 4; ++i)
#pragma unroll
            for (int j = 0; j < 4; ++j) {
                acc[i][j] = __builtin_amdgcn_mfma_f32_16x16x32_bf16(fa[i], fb[j], acc[i][j], 0, 0, 0);
                if (MODE == 2) acc2[i][j] = __builtin_amdgcn_mfma_f32_16x16x32_bf16(fa[i], fb2[j], acc2[i][j], 0, 0, 0);
            }
    }
#pragma unroll
    for (int i = 0; i < 4; ++i)
#pragma unroll
        for (int j = 0; j < 4; ++j)
#pragma unroll
            for (int r = 0; r < 4; ++r) {
                const int m = m0 + 16 * i + quad * 4 + r, n = n0 + 16 * j + row;
                const float v = acc[i][j][r];
                if (MODE == 0) a.Ob[(size_t)m * INC + n] = f2bf(n < 512 ? v * C2 : v);
                else if (MODE == 1) a.Of[(size_t)m * DM + n] = a.X[(size_t)m * DM + n] + v;
                else if (MODE == 2) a.Ob[(size_t)m * DM + n] = f2bf(swiglu(v + a.bias[e * 2048 + n], acc2[i][j][r] + a.bias[e * 2048 + 1024 + n]));
                else a.Ob[(size_t)m * DM + n] = f2bf(v + a.bias[e * 1024 + n]);
            }
}

__global__ __launch_bounds__(256) void n_attn(const bf16_t* P, const float* sinks, float* ATT) {
    const int gw = blockIdx.x * 4 + (threadIdx.x >> 6), lane = threadIdx.x & 63;
    const int tok = gw >> 3, h = gw & 7, hk = h >> 2, t = tok % SEQ;
    const float slope2 = exp2f(-(float)(h + 1)) * LOG2E, sink2 = sinks[h] * LOG2E;
    float q[64];
    const bf16_t* qp = P + (size_t)tok * INC + h * 64;
#pragma unroll
    for (int d = 0; d < 64; ++d) q[d] = bf2f(qp[d]);
    float s[2];
#pragma unroll
    for (int jj = 0; jj < 2; ++jj) {
        const int j = lane + 64 * jj, kp = t - 127 + j;
        float acc = -INFINITY;
        if (kp >= 0) {
            const bf16_t* kr = P + (size_t)(tok - 127 + j) * INC + 512 + hk * 64;
            acc = 0.f;
#pragma unroll
            for (int d = 0; d < 64; ++d) acc += q[d] * bf2f(kr[d]);
            acc -= slope2 * (float)(127 - j);
        }
        s[jj] = acc;
    }
    const float m = fmaxf(wave_max(fmaxf(s[0], s[1])), sink2);
    const float e0 = exp2f(s[0] - m), e1 = exp2f(s[1] - m);
    const float l = wave_sum(e0 + e1) + exp2f(sink2 - m);
    const float p0 = e0 / l, p1 = e1 / l;
    float o = 0.f;
    for (int j = 0; j < 128; ++j) {
        const float pj = __shfl(j < 64 ? p0 : p1, j & 63);
        if (t - 127 + j >= 0) o += pj * bf2f(P[(size_t)(tok - 127 + j) * INC + 640 + hk * 64 + lane]);
    }
    ATT[(size_t)tok * ATTW + h * 64 + lane] = o;
}
__global__ __launch_bounds__(256) void n_mix(const bf16_t* P, const float* ATT, const float* convw, bf16_t* MIX) {
    __shared__ float red[4];
    const int tok = blockIdx.x, tid = threadIdx.x, t = tok % SEQ;
    const float a0 = ATT[(size_t)tok * ATTW + tid], a1 = ATT[(size_t)tok * ATTW + 256 + tid];
    const float ssa = block_sum256(a0 * a0 + a1 * a1, red);
    const float ra = rsqrtf(ssa * (1.f / ATTW) + EPS);
    MIX[(size_t)tok * DM + tid] = f2bf(a0 * ra); MIX[(size_t)tok * DM + 256 + tid] = f2bf(a1 * ra);
    float y[2];
#pragma unroll
    for (int i = 0; i < 2; ++i) {
        const int c = tid + 256 * i;
        float acc = 0.f;
#pragma unroll
        for (int dt = 0; dt < 3; ++dt) {
            const int tt = t - 2 + dt;
            if (tt >= 0) { const bf16_t* pr = P + (size_t)(tok - 2 + dt) * INC; acc += convw[dt * CONVW + c] * (bf2f(pr[1280 + c]) * bf2f(pr[1792 + c])); }
        }
        y[i] = bf2f(P[(size_t)tok * INC + 768 + c]) * acc;
    }
    const float ssc = block_sum256(y[0] * y[0] + y[1] * y[1], red);
    const float rc = rsqrtf(ssc * (1.f / CONVW) + EPS);
    MIX[(size_t)tok * DM + 512 + tid] = f2bf(y[0] * rc); MIX[(size_t)tok * DM + 768 + tid] = f2bf(y[1] * rc);
}
__global__ __launch_bounds__(256) void n_router(const float* X1, const float* WR, const float* br, bf16_t* H2, unsigned* cnt, int* list, int* TE, int* TP, float* TG) {
    __shared__ float red[4]; __shared__ float xs[DM]; __shared__ float part[8][32]; __shared__ float lg[32];
    const int tok = blockIdx.x, tid = threadIdx.x;
    const f32x4 v = *(const f32x4*)(X1 + (size_t)tok * DM + 4 * tid);
    const float ss = block_sum256(v.x * v.x + v.y * v.y + v.z * v.z + v.w * v.w, red);
    const float rstd = rsqrtf(ss * (1.f / DM) + EPS);
    bf16_t* o = H2 + (size_t)tok * DM + 4 * tid;
    o[0] = f2bf(v.x * rstd); o[1] = f2bf(v.y * rstd); o[2] = f2bf(v.z * rstd); o[3] = f2bf(v.w * rstd);
    xs[4 * tid] = v.x; xs[4 * tid + 1] = v.y; xs[4 * tid + 2] = v.z; xs[4 * tid + 3] = v.w;
    __syncthreads();
    const int e = tid & 31, pt = tid >> 5;
    float acc = 0.f;
    for (int k = pt * 128; k < pt * 128 + 128; ++k) acc += xs[k] * WR[k * NE + e];
    part[pt][e] = acc;
    __syncthreads();
    if (tid < 32) { float sum = 0.f; for (int p = 0; p < 8; ++p) sum += part[p][tid]; lg[tid] = sum * rstd + br[tid]; }
    __syncthreads();
    if (tid == 0) {
        int idx[4]; float val[4]; unsigned used = 0u;
        for (int k = 0; k < 4; ++k) { float best = -INFINITY; int bi = 0; for (int j = 0; j < 32; ++j) if (!((used >> j) & 1u) && lg[j] > best) { best = lg[j]; bi = j; } used |= 1u << bi; idx[k] = bi; val[k] = best; }
        float es[4], sum = 0.f; for (int k = 0; k < 4; ++k) { es[k] = expf(val[k] - val[0]); sum += es[k]; }
        for (int k = 0; k < 4; ++k) {
            const unsigned pos = atomicAdd(&cnt[idx[k]], 1u);
            list[idx[k] * NTOK + pos] = tok; TE[tok * 4 + k] = idx[k]; TP[tok * 4 + k] = (int)pos; TG[tok * 4 + k] = es[k] / sum;
        }
    }
}
__global__ void n_tables(const unsigned* cnt, int* tab) {
    if (threadIdx.x == 0) { int s = 0; for (int e = 0; e < NE; ++e) { tab[e] = s; const int nt = ((int)cnt[e] + 255) >> 8; for (int i = 0; i < nt; ++i) tab[64 + s + i] = e; s += nt; } tab[32] = s; }
}
__global__ __launch_bounds__(256) void n_combine(const float* X1, const bf16_t* Y, const int* TE, const int* TP, const float* TG, const int* tab, const float* gf, float* out) {
    __shared__ float red[4];
    const int tok = blockIdx.x, tid = threadIdx.x;
    f32x4 v = *(const f32x4*)(X1 + (size_t)tok * DM + 4 * tid);
#pragma unroll
    for (int k = 0; k < 4; ++k) {
        const int e = TE[tok * 4 + k]; const size_t slot = (size_t)256 * tab[e] + TP[tok * 4 + k]; const float g = TG[tok * 4 + k];
        const bf16_t* yr = Y + slot * DM + 4 * tid;
        v.x += g * bf2f(yr[0]); v.y += g * bf2f(yr[1]); v.z += g * bf2f(yr[2]); v.w += g * bf2f(yr[3]);
    }
    const float ss = block_sum256(v.x * v.x + v.y * v.y + v.z * v.z + v.w * v.w, red);
    const float rstd = rsqrtf(ss * (1.f / DM) + EPS);
    const f32x4 g4 = *(const f32x4*)(gf + 4 * tid);
    *(f32x4*)(out + (size_t)tok * DM + 4 * tid) = (f32x4){v.x * rstd * g4.x, v.y * rstd * g4.y, v.z * rstd * g4.z, v.w * rstd * g4.w};
}


#define LAS __attribute__((address_space(3)))
#define GAS __attribute__((address_space(1)))
typedef unsigned u32x4 __attribute__((ext_vector_type(4)));
typedef unsigned u32x2 __attribute__((ext_vector_type(2)));
typedef float f32x16 __attribute__((ext_vector_type(16)));
typedef float f32x2 __attribute__((ext_vector_type(2)));
typedef short s16x4 __attribute__((ext_vector_type(4)));
typedef __bf16 bf16x2_t __attribute__((ext_vector_type(2)));
typedef GAS unsigned gu32;
#define RLX_AGENT __ATOMIC_RELAXED, __HIP_MEMORY_SCOPE_AGENT
#define LDS_WAIT() asm volatile("s_waitcnt lgkmcnt(0)" ::: "memory")
#define VM_WAIT() asm volatile("s_waitcnt vmcnt(0)" ::: "memory")

constexpr int NWAVES = 8, NTHREADS = 512;
constexpr int RING_OFF = 0, RING_BYTES = 131072;
constexpr int IDTAB_OFF = RING_BYTES, IDTAB_UNITS = 17, IDTAB_BYTES = IDTAB_UNITS * 1024;
constexpr int TILEE_OFF = IDTAB_OFF + IDTAB_BYTES;
constexpr int TSTART_OFF = TILEE_OFF + 2304;
constexpr int CNT_OFF = TSTART_OFF + 256;
constexpr int MISC_OFF = CNT_OFF + 128;
constexpr int BIAS_OFF = MISC_OFF + 128;
constexpr int LDS_BYTES = 155648;
static_assert(BIAS_OFF % 16 == 0 && BIAS_OFF + 1024 <= LDS_BYTES, "LDS map");
constexpr int CW_BAR = 4096;

__device__ __forceinline__ unsigned cvtpk(float lo, float hi) { f32x2 v = {lo, hi}; bf16x2_t b = __builtin_convertvector(v, bf16x2_t); return __builtin_bit_cast(unsigned, b); }

__device__ __forceinline__ int tid_of(int wave) { unsigned z = 0u; asm volatile("" : "+v"(z)); const int l = (int)__builtin_amdgcn_mbcnt_hi(~0u, __builtin_amdgcn_mbcnt_lo(~0u, z)); return wave * 64 + l; }

namespace pg8 {
constexpr int BM = 256, BK = 64, HALF = 128, HTB = HALF * BK * 2, NXCD = 8, WGM = 8, KD = 1024;
typedef int i32x8 __attribute__((ext_vector_type(8)));
typedef int i32x4 __attribute__((ext_vector_type(4)));
__host__ __device__ __forceinline__ int lds_byte(int r, int c) { return r * 128 + ((((c >> 3) ^ (r >> 1)) & 7) << 4) + (c & 7) * 2; }
__host__ __device__ __forceinline__ void stage_rc(int b, int& R, int& C) { R = b >> 7; C = ((((b >> 4) & 7) ^ ((R >> 1) & 7)) << 3); }
__host__ __device__ __forceinline__ int perm32(int rho) { const int n = rho >> 4, i = rho & 15; return 8 * (i >> 2) + 4 * n + (i & 3); }
struct Unit { int pm, pn, e; };
__device__ __forceinline__ bool order_next(int i, int G, int c, int nM, int nN, Unit& u) {
    const int nwg = nM * nN; const long L = (long)i * G + c; if (L >= nwg) return false;
    int wgid = (int)L; { const int q = nwg / NXCD, r = nwg % NXCD, xcd = wgid % NXCD, off = wgid / NXCD; wgid = (xcd < r ? xcd * (q + 1) : r * (q + 1) + (xcd - r) * q) + off; }
    const int nig = WGM * nN, gid = wgid / nig, fm = gid * WGM, gsz = (nM - fm) < WGM ? (nM - fm) : WGM;
    u.pm = fm + ((wgid % nig) % gsz); u.pn = (wgid % nig) / gsz; u.e = 0; return true;
}
struct ProbDense {
    static constexpr int KB = KD * 2; static constexpr bool F8 = false;
    static constexpr size_t HSTEPB = (size_t)HALF * KD * 2;
    const bf16_t* A; const bf16_t* Bt; int nM, nN, G, c; unsigned char* dummy;
    __device__ __forceinline__ bool next(int i, Unit& u) const { return order_next(i, G, c, nM, nN, u); }
    __device__ __forceinline__ const char* a_base(const Unit& u) const { return (const char*)A + (size_t)u.pm * BM * KD * 2; }
    __device__ __forceinline__ const char* b_base(const Unit& u) const { return (const char*)Bt + (size_t)u.pn * BM * KD * 2; }
    __device__ __forceinline__ void a_offs(int, const Unit&, const int (&Rr)[2], const int (&Cb)[2], unsigned (&va)[2][2]) const {
#pragma unroll
        for (int h = 0; h < 2; ++h)
#pragma unroll
            for (int i = 0; i < 2; ++i) va[h][i] = (unsigned)((Rr[i] + HALF * h) * KD * 2 + Cb[i]);
    }
};
template <bool F8_> struct ProbG1 {
    static constexpr int KB = F8_ ? KD : KD * 2; static constexpr bool F8 = F8_;
    static constexpr size_t HSTEPB = (size_t)1024 * KB;
    const unsigned char* H2; const unsigned char* W1t; int nM, G, c; const LAS int* tile_e; const LAS unsigned* idtab; unsigned char* dummy;
    __device__ __forceinline__ bool next(int i, Unit& u) const { if (!order_next(i, G, c, nM, 8, u)) return false; u.e = __builtin_amdgcn_readfirstlane(tile_e[u.pm]); return true; }
    __device__ __forceinline__ const char* a_base(const Unit&) const { return (const char*)H2; }
    __device__ __forceinline__ const char* b_base(const Unit& u) const { return (const char*)W1t + ((size_t)u.e * 2048 + (size_t)u.pn * 128) * KB; }
    __device__ __forceinline__ void a_offs(int ui, const Unit&, const int (&Rr)[2], const int (&Cb)[2], unsigned (&va)[2][2]) const {
        const int uu = ui < IDTAB_UNITS ? ui : IDTAB_UNITS - 1;
#pragma unroll
        for (int h = 0; h < 2; ++h)
#pragma unroll
            for (int i = 0; i < 2; ++i) va[h][i] = idtab[uu * 256 + h * HALF + Rr[i]] + (unsigned)Cb[i];
    }
};
template <bool F8_> struct ProbG2 {
    static constexpr int KB = F8_ ? KD : KD * 2; static constexpr bool F8 = F8_;
    static constexpr size_t HSTEPB = (size_t)HALF * KB;
    const unsigned char* ACT; const unsigned char* W2t; int nM, G, c; const LAS int* tile_e; unsigned char* dummy;
    __device__ __forceinline__ bool next(int i, Unit& u) const { if (!order_next(i, G, c, nM, 4, u)) return false; u.e = __builtin_amdgcn_readfirstlane(tile_e[u.pm]); return true; }
    __device__ __forceinline__ const char* a_base(const Unit& u) const { return (const char*)ACT + (size_t)u.pm * BM * KB; }
    __device__ __forceinline__ const char* b_base(const Unit& u) const { return (const char*)W2t + ((size_t)u.e * 1024 + (size_t)u.pn * 256) * KB; }
    __device__ __forceinline__ void a_offs(int, const Unit&, const int (&Rr)[2], const int (&Cb)[2], unsigned (&va)[2][2]) const {
#pragma unroll
        for (int h = 0; h < 2; ++h)
#pragma unroll
            for (int i = 0; i < 2; ++i) va[h][i] = (unsigned)((Rr[i] + HALF * h) * KB + Cb[i]);
    }
};

__device__ __forceinline__ void store_rows16(LAS unsigned char* scr, int fr, int fq, int lane, u32x4 c0, u32x4 c1, bf16_t* gbase  , size_t ld) {
    LAS unsigned char* wp = scr + (fr >> 3) * 8192 + (fr & 7) * 128;
    *(LAS u32x4*)(wp + (((2 * fq) ^ (fr & 7)) * 16)) = c0;
    *(LAS u32x4*)(wp + (((2 * fq + 1) ^ (fr & 7)) * 16)) = c1;
#pragma unroll
    for (int k = 0; k < 2; ++k) {
        const int rl = lane >> 3, ch = lane & 7;
        const u32x4 v = *(const LAS u32x4*)(scr + k * 8192 + rl * 128 + ((ch ^ rl) * 16));
        *(u32x4*)(gbase + (size_t)(8 * k + rl) * ld + ch * 8) = v;
    }
}
struct EpiP {
    static constexpr int PERM = 2; static constexpr bool HAS_BIAS = false; static constexpr bool MIDSCALE = false; static constexpr int NST = 16; bf16_t* O;
    __device__ __forceinline__ const char* bias_src(const Unit&, int) const { return nullptr; }
    __device__ __forceinline__ void operator()(const f32x4 (&acc)[2][2][4][2], const Unit& u, int wr, int wc, int fr, int fq, LAS unsigned char* scr) const {
        const int lane = fr + 16 * fq;
        if (u.pn >= 5) {
            bf16_t* ub = O + (size_t)(u.pm * BM + wr * 64 + fr) * INCP + 1280 + (u.pn - 5) * 128 + (4 * wc + fq) * 8;
#pragma unroll
            for (int ai = 0; ai < 2; ++ai)
#pragma unroll
                for (int m = 0; m < 4; ++m) {
                    const f32x4 p0 = acc[ai][0][m][0] * acc[ai][1][m][0], p1 = acc[ai][0][m][1] * acc[ai][1][m][1];
                    u32x2 w0, w1; w0.x = cvtpk(p0[0], p0[1]); w0.y = cvtpk(p0[2], p0[3]); w1.x = cvtpk(p1[0], p1[1]); w1.y = cvtpk(p1[2], p1[3]);
                    u32x2* dst = (u32x2*)(ub + (size_t)(ai * HALF + m * 16) * INCP);
                    dst[0] = w0; dst[1] = w1;
                }
            return;
        }
        const float sc = u.pn < 2 ? C2 : 1.f;
        bf16_t* base = O + (size_t)(u.pm * BM + wr * 64) * INCP + u.pn * BM + wc * 64;
#pragma unroll
        for (int ai = 0; ai < 2; ++ai)
#pragma unroll
            for (int m = 0; m < 4; ++m) {
                u32x4 c[2];
#pragma unroll
                for (int bj = 0; bj < 2; ++bj) { const f32x4 v0 = acc[ai][bj][m][0] * sc, v1 = acc[ai][bj][m][1] * sc;
                    c[bj].x = cvtpk(v0[0], v0[1]); c[bj].y = cvtpk(v0[2], v0[3]); c[bj].z = cvtpk(v1[0], v1[1]); c[bj].w = cvtpk(v1[2], v1[3]); }
                store_rows16(scr, fr, fq, lane, c[0], c[1], base + (size_t)(ai * HALF + m * 16) * INCP, INCP);
            }
    }
};
struct EpiMo {
    static constexpr int PERM = 2; static constexpr bool HAS_BIAS = false; static constexpr bool MIDSCALE = true; static constexpr int NST = 16; bf16_t* O; const float* RS;
    __device__ __forceinline__ const char* bias_src(const Unit&, int) const { return nullptr; }
    __device__ __forceinline__ const char* scale_src(const Unit& u, int lane) const { return (const char*)(RS + (size_t)u.pm * BM + lane * 4); }
    __device__ __forceinline__ void operator()(const f32x4 (&acc)[2][2][4][2], const Unit& u, int wr, int wc, int fr, int fq, LAS unsigned char* scr) const {
        const int lane = fr + 16 * fq;
        bf16_t* base = O + (size_t)(u.pm * BM + wr * 64) * DM + u.pn * BM + wc * 64;
#pragma unroll
        for (int ai = 0; ai < 2; ++ai)
#pragma unroll
            for (int m = 0; m < 4; ++m) {
                u32x4 c[2];
#pragma unroll
                for (int bj = 0; bj < 2; ++bj) { const f32x4 v0 = acc[ai][bj][m][0], v1 = acc[ai][bj][m][1];
                    c[bj].x = cvtpk(v0[0], v0[1]); c[bj].y = cvtpk(v0[2], v0[3]); c[bj].z = cvtpk(v1[0], v1[1]); c[bj].w = cvtpk(v1[2], v1[3]); }
                store_rows16(scr, fr, fq, lane, c[0], c[1], base + (size_t)(ai * HALF + m * 16) * DM, DM);
            }
    }
};
struct EpiX1 {
    static constexpr int PERM = 0; static constexpr bool HAS_BIAS = false; static constexpr bool MIDSCALE = false; static constexpr int NST = 0; const float* X; float* O;
    __device__ __forceinline__ const char* bias_src(const Unit&, int) const { return nullptr; }
    __device__ __forceinline__ void operator()(const f32x4 (&acc)[2][2][4][2], const Unit& u, int wr, int wc, int fr, int fq, LAS unsigned char* scr) const {
        const int row0 = u.pm * BM + wr * 64 + fr, col0 = u.pn * BM + wc * 32 + 4 * fq;
#pragma unroll
        for (int ai = 0; ai < 2; ++ai)
#pragma unroll
            for (int m = 0; m < 4; ++m) { const size_t off = (size_t)(row0 + ai * HALF + m * 16) * DM + col0;
#pragma unroll
                for (int bj = 0; bj < 2; ++bj)
#pragma unroll
                    for (int n = 0; n < 2; ++n) { const f32x4 xr = *(const f32x4*)(X + off + bj * HALF + n * 16); *(f32x4*)(O + off + bj * HALF + n * 16) = xr + acc[ai][bj][m][n]; } }
    }
};
struct EpiAct {
    static constexpr int PERM = 1; static constexpr bool HAS_BIAS = false; static constexpr bool MIDSCALE = false; static constexpr int NST = 0; bf16_t* O; const float* b1;
    __device__ __forceinline__ const char* bias_src(const Unit&, int) const { return nullptr; }
    __device__ __forceinline__ void operator()(const f32x4 (&acc)[2][2][4][2], const Unit& u, int wr, int wc, int fr, int fq, LAS unsigned char* scr) const {
        const int row0 = u.pm * BM + wr * 64 + fr, col0 = u.pn * 128 + wc * 32 + 8 * fq;
        const float* bp = b1 + (size_t)u.e * 2048 + col0;
        const f32x4 bg0 = *(const f32x4*)(bp), bg1 = *(const f32x4*)(bp + 4), bl0 = *(const f32x4*)(bp + 1024), bl1 = *(const f32x4*)(bp + 1028);
#pragma unroll
        for (int ai = 0; ai < 2; ++ai)
#pragma unroll
            for (int m = 0; m < 4; ++m) {
                const f32x4 g0 = acc[ai][0][m][0] + bg0, g1 = acc[ai][0][m][1] + bg1, l0 = acc[ai][1][m][0] + bl0, l1 = acc[ai][1][m][1] + bl1;
                u32x4 w; w.x = cvtpk(swiglu(g0[0], l0[0]), swiglu(g0[1], l0[1])); w.y = cvtpk(swiglu(g0[2], l0[2]), swiglu(g0[3], l0[3]));
                w.z = cvtpk(swiglu(g1[0], l1[0]), swiglu(g1[1], l1[1])); w.w = cvtpk(swiglu(g1[2], l1[2]), swiglu(g1[3], l1[3]));
                *(u32x4*)(O + (size_t)(row0 + ai * HALF + m * 16) * DM + col0) = w; }
    }
};
__device__ __forceinline__ unsigned pack4_fp8(float a, float b, float c, float d) {
    a = fminf(fmaxf(a, -448.f), 448.f); b = fminf(fmaxf(b, -448.f), 448.f); c = fminf(fmaxf(c, -448.f), 448.f); d = fminf(fmaxf(d, -448.f), 448.f);
    int p = __builtin_amdgcn_cvt_pk_fp8_f32(a, b, 0, false); p = __builtin_amdgcn_cvt_pk_fp8_f32(c, d, p, true); return (unsigned)p;
}
__device__ __forceinline__ unsigned pack4_fp8_nc(float a, float b, float c, float d) {
    int p = __builtin_amdgcn_cvt_pk_fp8_f32(a, b, 0, false); p = __builtin_amdgcn_cvt_pk_fp8_f32(c, d, p, true); return (unsigned)p;
}
struct EpiAct8 {
    static constexpr int PERM = 1; static constexpr bool HAS_BIAS = true; static constexpr bool MIDSCALE = false; static constexpr int NST = 8; unsigned char* O; const float* b1; const LAS float* bl;
    __device__ __forceinline__ const char* bias_src(const Unit& u, int lane) const { return (const char*)(b1 + (size_t)u.e * 2048 + (size_t)u.pn * 128 + (lane >> 5) * 1024) + (lane & 31) * 16; }
    __device__ __forceinline__ void operator()(const f32x4 (&acc)[2][2][4][2], const Unit& u, int wr, int wc, int fr, int fq, LAS unsigned char* scr) const {
        const int row0 = u.pm * BM + wr * 64 + fr, cl = wc * 32 + 8 * fq, col0 = u.pn * 128 + cl;
        const f32x4 bg0 = *(const LAS f32x4*)(bl + cl), bg1 = *(const LAS f32x4*)(bl + cl + 4), bl0 = *(const LAS f32x4*)(bl + 128 + cl), bl1 = *(const LAS f32x4*)(bl + 128 + cl + 4);
#pragma unroll
        for (int ai = 0; ai < 2; ++ai)
#pragma unroll
            for (int m = 0; m < 4; ++m) {
                const f32x4 g0 = acc[ai][0][m][0] + bg0, g1 = acc[ai][0][m][1] + bg1, l0 = acc[ai][1][m][0] + bl0, l1 = acc[ai][1][m][1] + bl1;
                const f32x2v s0 = swiglu_pk((f32x2v){g0[0], g0[1]}, (f32x2v){l0[0], l0[1]}), s1 = swiglu_pk((f32x2v){g0[2], g0[3]}, (f32x2v){l0[2], l0[3]});
                const f32x2v s2 = swiglu_pk((f32x2v){g1[0], g1[1]}, (f32x2v){l1[0], l1[1]}), s3 = swiglu_pk((f32x2v){g1[2], g1[3]}, (f32x2v){l1[2], l1[3]});
                u32x2 w; w.x = pack4_fp8_nc(s0.x, s0.y, s1.x, s1.y); w.y = pack4_fp8_nc(s2.x, s2.y, s3.x, s3.y);
                *(u32x2*)(O + (size_t)(row0 + ai * HALF + m * 16) * DM + col0) = w; }
    }
};
struct EpiY {
    static constexpr int PERM = 2; static constexpr bool HAS_BIAS = true; static constexpr bool MIDSCALE = false; static constexpr int NST = 16; bf16_t* O; const float* b2; const LAS float* bl;
    __device__ __forceinline__ const char* bias_src(const Unit& u, int lane) const { return (const char*)(b2 + (size_t)u.e * 1024 + (size_t)u.pn * 256) + lane * 16; }
    __device__ __forceinline__ void operator()(const f32x4 (&acc)[2][2][4][2], const Unit& u, int wr, int wc, int fr, int fq, LAS unsigned char* scr) const {
        const int lane = fr + 16 * fq, cl = wc * 64 + 16 * fq;
        f32x4 bv[2][2];
#pragma unroll
        for (int bj = 0; bj < 2; ++bj)
#pragma unroll
            for (int n = 0; n < 2; ++n) bv[bj][n] = *(const LAS f32x4*)(bl + cl + 8 * bj + 4 * n);
        bf16_t* base = O + (size_t)(u.pm * BM + wr * 64) * DM + u.pn * BM + wc * 64;
#pragma unroll
        for (int ai = 0; ai < 2; ++ai)
#pragma unroll
            for (int m = 0; m < 4; ++m) {
                u32x4 c[2];
#pragma unroll
                for (int bj = 0; bj < 2; ++bj) { const f32x4 v0 = acc[ai][bj][m][0] + bv[bj][0], v1 = acc[ai][bj][m][1] + bv[bj][1];
                    c[bj].x = cvtpk(v0[0], v0[1]); c[bj].y = cvtpk(v0[2], v0[3]); c[bj].z = cvtpk(v1[0], v1[1]); c[bj].w = cvtpk(v1[2], v1[3]); }
                store_rows16(scr, fr, fq, lane, c[0], c[1], base + (size_t)(ai * HALF + m * 16) * DM, DM);
            }
    }
};

struct EpiY8 {
    static constexpr int PERM = 2; static constexpr bool HAS_BIAS = true; static constexpr bool MIDSCALE = false; static constexpr int NST = 8; unsigned char* O; const float* b2; const LAS float* bl;
    __device__ __forceinline__ const char* bias_src(const Unit& u, int lane) const { return (const char*)(b2 + (size_t)u.e * 1024 + (size_t)u.pn * 256) + lane * 16; }
    __device__ __forceinline__ void operator()(const f32x4 (&acc)[2][2][4][2], const Unit& u, int wr, int wc, int fr, int fq, LAS unsigned char* scr) const {
        const int lane = fr + 16 * fq, cl = wc * 64 + 16 * fq;
        f32x4 bv[2][2];
#pragma unroll
        for (int bj = 0; bj < 2; ++bj)
#pragma unroll
            for (int n = 0; n < 2; ++n) bv[bj][n] = *(const LAS f32x4*)(bl + cl + 8 * bj + 4 * n);
        unsigned char* base = O + (size_t)(u.pm * BM + wr * 64) * DM + u.pn * BM + wc * 64;
        const int rrow = lane >> 2, rch = lane & 3;
#pragma unroll
        for (int ai = 0; ai < 2; ++ai)
#pragma unroll
            for (int mp = 0; mp < 2; ++mp) {
#pragma unroll
                for (int j = 0; j < 2; ++j) { const int m = 2 * mp + j;
                    const f32x4 a0 = acc[ai][0][m][0] + bv[0][0], a1 = acc[ai][0][m][1] + bv[0][1], a2 = acc[ai][1][m][0] + bv[1][0], a3 = acc[ai][1][m][1] + bv[1][1];
                    u32x4 w; w.x = pack4_fp8(a0[0], a0[1], a0[2], a0[3]); w.y = pack4_fp8(a1[0], a1[1], a1[2], a1[3]); w.z = pack4_fp8(a2[0], a2[1], a2[2], a2[3]); w.w = pack4_fp8(a3[0], a3[1], a3[2], a3[3]);
                    *(LAS u32x4*)(scr + j * 8192 + fr * 64 + ((fq ^ ((fr >> 1) & 3)) * 16)) = w; }
#pragma unroll
                for (int j = 0; j < 2; ++j) {
                    const u32x4 v = *(const LAS u32x4*)(scr + j * 8192 + rrow * 64 + ((rch ^ ((rrow >> 1) & 3)) * 16));
                    __builtin_nontemporal_store(v, (u32x4*)(base + (size_t)(ai * HALF + (2 * mp + j) * 16 + rrow) * DM + rch * 16)); }
            }
    }
};

template <class Prob, class Epi, bool ALIGN_EPI>
__device__ __forceinline__ void gemm_phase(LAS unsigned char* lds, const Prob& S, const Epi& E, int wave_) {
    const int tid = tid_of(wave_), wid = wave_, lane = tid & 63, wr = wid >> 2, wc = wid & 3, fr = lane & 15, fq = lane >> 4;
    constexpr int KB = Prob::KB, nt = KB / 128; constexpr bool F8 = Prob::F8;
    unsigned voffB[2]; int Rr[2], Cb[2];
#pragma unroll
    for (int i = 0; i < 2; ++i) { int R, C; stage_rc(tid * 16 + i * 8192, R, C);
        const int Rb = (Epi::PERM == 2) ? (64 * (R >> 5) + 16 * ((R & 15) >> 2) + 4 * ((R >> 4) & 1) + (R & 3)) : (Epi::PERM == 1) ? ((R & ~31) + perm32(R & 31)) : R;
        voffB[i] = (unsigned)(Rb * KB + C * 2); Rr[i] = R; Cb[i] = C * 2; }
    constexpr size_t kstep = (size_t)(BK * 2);
    constexpr size_t hstepB = (Epi::PERM == 2) ? (size_t)8 * KB : Prob::HSTEPB;
    const unsigned ldsw = (unsigned)wid * 1024u;
    const int aoff = lds_byte(wr * 64 + fr, fq * 8), boff = lds_byte(wc * 32 + fr, fq * 8), aoff1 = lds_byte(wr * 64 + fr, 32 + fq * 8), boff1 = lds_byte(wc * 32 + fr, 32 + fq * 8);
#define PG8_SA(b, h) (((b) * 2 + (h)) * HTB)
#define PG8_SB(b, h) ((4 + (b) * 2 + (h)) * HTB)
#define PG8_STAGE(bufoff, gbase, voff) do { _Pragma("unroll") for (int _i = 0; _i < 2; ++_i) \
        __builtin_amdgcn_global_load_lds((const unsigned*)((const char*)(gbase) + (voff)[_i]), (LAS unsigned*)(lds + (bufoff) + ldsw + _i * 8192), 16, 0, 0); } while (0)
#define PG8_LDA(dst, b, h) do { _Pragma("unroll") for (int m = 0; m < 4; ++m) { const i32x4 x0_ = *(const LAS i32x4*)(lds + PG8_SA(b, h) + aoff + m * 2048), x1_ = *(const LAS i32x4*)(lds + PG8_SA(b, h) + aoff1 + m * 2048); dst[m] = __builtin_shufflevector(x0_, x1_, 0, 1, 2, 3, 4, 5, 6, 7); } } while (0)
#define PG8_LDB(dst, b, h) do { _Pragma("unroll") for (int n = 0; n < 2; ++n) { const i32x4 x0_ = *(const LAS i32x4*)(lds + PG8_SB(b, h) + boff + n * 2048), x1_ = *(const LAS i32x4*)(lds + PG8_SB(b, h) + boff1 + n * 2048); dst[n] = __builtin_shufflevector(x0_, x1_, 0, 1, 2, 3, 4, 5, 6, 7); } } while (0)
#define PG8_MMA(ai, bj, At, Bt) do { __builtin_amdgcn_s_setprio(1); _Pragma("unroll") for (int m = 0; m < 4; ++m) _Pragma("unroll") for (int n = 0; n < 2; ++n) { \
        if constexpr (F8) asm volatile("s_nop 1\n\tv_mfma_scale_f32_16x16x128_f8f6f4 %0, %1, %2, %0, %3, %4 op_sel_hi:[0,0,0]" : "+v"(acc[ai][bj][m][n]) : "v"(Bt[n]), "v"(At[m]), "v"(scw), "v"(sca)); \
        else { acc[ai][bj][m][n] = __builtin_amdgcn_mfma_f32_16x16x32_bf16(__builtin_bit_cast(bf16x8, (i32x4)__builtin_shufflevector(Bt[n], Bt[n], 0, 1, 2, 3)), __builtin_bit_cast(bf16x8, (i32x4)__builtin_shufflevector(At[m], At[m], 0, 1, 2, 3)), acc[ai][bj][m][n], 0, 0, 0); \
               acc[ai][bj][m][n] = __builtin_amdgcn_mfma_f32_16x16x32_bf16(__builtin_bit_cast(bf16x8, (i32x4)__builtin_shufflevector(Bt[n], Bt[n], 4, 5, 6, 7)), __builtin_bit_cast(bf16x8, (i32x4)__builtin_shufflevector(At[m], At[m], 4, 5, 6, 7)), acc[ai][bj][m][n], 0, 0, 0); } } \
        __builtin_amdgcn_s_setprio(0); } while (0)
#define PG8_WAIT_V(n) asm volatile("s_waitcnt vmcnt(" #n ")" ::: "memory")
#define PG8_WAIT_L(n) asm volatile("s_waitcnt lgkmcnt(" #n ")" ::: "memory")
#define PG8_WAIT_VN(n) asm volatile("s_waitcnt vmcnt(%0)" :: "n"(n) : "memory")
#define PG8_BAR __builtin_amdgcn_s_barrier()
#define PG8_SCHED __builtin_amdgcn_sched_barrier(0)
    Unit cur, nxt; int ui = 0;
    if (!S.next(0, cur)) return;
    unsigned vaC[2][2], vaN[2][2];
    S.a_offs(0, cur, Rr, Cb, vaC);
    f32x4 acc[2][2][4][2];
#pragma unroll
    for (int a = 0; a < 2; ++a)
#pragma unroll
        for (int b = 0; b < 2; ++b)
#pragma unroll
            for (int m = 0; m < 4; ++m)
#pragma unroll
                for (int n = 0; n < 2; ++n) acc[a][b][m][n] = (f32x4){0.f, 0.f, 0.f, 0.f};
    i32x8 At[4], B0[2], B1[2];
    int scw = W8_SCALE_E8M0, sca = 127; asm volatile("" : "+v"(scw), "+v"(sca));
    const char* cA = S.a_base(cur); const char* cB = S.b_base(cur);
    PG8_STAGE(PG8_SB(0, 0), cB, voffB); PG8_STAGE(PG8_SB(0, 1), cB + hstepB, voffB); PG8_STAGE(PG8_SA(0, 0), cA, vaC[0]); PG8_STAGE(PG8_SA(0, 1), cA, vaC[1]);
    if (wr == 1) PG8_BAR;
    PG8_WAIT_V(2); PG8_BAR;
#if SCHED44
    PG8_STAGE(PG8_SB(1, 0), cB + kstep, voffB); PG8_STAGE(PG8_SA(1, 0), cA + kstep, vaC[0]);
#else
    PG8_STAGE(PG8_SB(1, 0), cB + kstep, voffB); PG8_STAGE(PG8_SA(1, 0), cA + kstep, vaC[0]); PG8_STAGE(PG8_SB(1, 1), cB + hstepB + kstep, voffB);
#endif
    PG8_WAIT_V(6); PG8_BAR;
#ifdef KREP
    int krep_ = 0;
#endif
    for (;;) {
        bool has_next = S.next(ui + 1, nxt);
#ifdef KREP
        const bool real_next_ = has_next; if (krep_ == 0) has_next = false;
#endif
        const char* nA = has_next ? S.a_base(nxt) : cA; const char* nB = has_next ? S.b_base(nxt) : cB;
        if (has_next) S.a_offs(ui + 1, nxt, Rr, Cb, vaN);
        else {
#pragma unroll
            for (int h = 0; h < 2; ++h)
#pragma unroll
                for (int i = 0; i < 2; ++i) vaN[h][i] = vaC[h][i]; }
#pragma unroll 1
        for (int t = 0; t < nt; t += 2) {
            const bool last = (t == nt - 2);
            const char* a1 = cA + (size_t)(t + 1) * kstep;
            const char* a2 = last ? nA : cA + (size_t)(t + 2) * kstep; const char* b2 = last ? nB : cB + (size_t)(t + 2) * kstep;
            const char* a3 = a2 + kstep; const char* b3 = b2 + kstep;
            unsigned v2[2][2];
#pragma unroll
            for (int h = 0; h < 2; ++h)
#pragma unroll
                for (int i = 0; i < 2; ++i) v2[h][i] = last ? vaN[h][i] : vaC[h][i];
            if constexpr (Epi::HAS_BIAS) { if (last) __builtin_amdgcn_global_load_lds((const unsigned*)E.bias_src(cur, lane), (LAS unsigned*)(lds + (BIAS_OFF - RING_OFF)), 16, 0, 0); }
            if constexpr (Epi::MIDSCALE) {
                if (t == 0) __builtin_amdgcn_global_load_lds((const unsigned*)E.scale_src(cur, lane), (LAS unsigned*)(lds + (BIAS_OFF - RING_OFF)), 16, 0, 0);
                if (t == nt / 2) {
                    const LAS float* sc_ = (const LAS float*)(lds + (BIAS_OFF - RING_OFF)) + wr * 64 + fr;
#pragma unroll
                    for (int a_ = 0; a_ < 2; ++a_)
#pragma unroll
                        for (int m_ = 0; m_ < 4; ++m_) { const float f_ = sc_[a_ * HALF + m_ * 16];
#pragma unroll
                            for (int b_ = 0; b_ < 2; ++b_)
#pragma unroll
                                for (int n_ = 0; n_ < 2; ++n_) acc[a_][b_][m_][n_] *= f_; }
                }
            }
#ifdef KREP
            const bool stq = (Epi::NST > 0) && (t == 0) && (ui > 0) && (krep_ == 0);
#else
            const bool stq = (Epi::NST > 0) && (t == 0) && (ui > 0);
#endif
#if SCHED44
            const char* b1h = cB + hstepB + (size_t)(t + 1) * kstep;
            PG8_LDB(B0, 0, 0); PG8_LDB(B1, 0, 1); PG8_SCHED; PG8_LDA(At, 0, 0); PG8_STAGE(PG8_SB(1, 1), b1h, voffB); PG8_STAGE(PG8_SA(1, 1), a1, vaC[1]);
            if (stq) PG8_WAIT_VN(8 + Epi::NST); else PG8_WAIT_V(8);
            PG8_WAIT_L(0); PG8_BAR; PG8_MMA(0, 0, At, B0); PG8_MMA(0, 1, At, B1); PG8_BAR; PG8_SCHED;
            PG8_LDA(At, 0, 1); PG8_STAGE(PG8_SB(0, 0), b2, voffB); PG8_STAGE(PG8_SA(0, 0), a2, v2[0]);
            PG8_WAIT_V(6); PG8_WAIT_L(0); PG8_BAR; PG8_MMA(1, 0, At, B0); PG8_MMA(1, 1, At, B1); PG8_BAR; PG8_SCHED;
            PG8_LDB(B0, 1, 0); PG8_LDB(B1, 1, 1); PG8_SCHED; PG8_LDA(At, 1, 0); PG8_STAGE(PG8_SB(0, 1), b2 + hstepB, voffB); PG8_STAGE(PG8_SA(0, 1), a2, v2[1]);
            PG8_WAIT_V(8); PG8_WAIT_L(0); PG8_BAR; PG8_MMA(0, 0, At, B0); PG8_MMA(0, 1, At, B1); PG8_BAR; PG8_SCHED;
            PG8_LDA(At, 1, 1); PG8_STAGE(PG8_SB(1, 0), b3, voffB); PG8_STAGE(PG8_SA(1, 0), a3, v2[0]);
            PG8_WAIT_V(6); PG8_WAIT_L(0); PG8_BAR; PG8_MMA(1, 0, At, B0); PG8_MMA(1, 1, At, B1); PG8_BAR; PG8_SCHED;
#else
            PG8_LDB(B0, 0, 0); PG8_LDB(B1, 0, 1); PG8_SCHED; PG8_LDA(At, 0, 0); PG8_STAGE(PG8_SA(1, 1), a1, vaC[1]);
            if (stq) PG8_WAIT_VN(8 + Epi::NST); else PG8_WAIT_V(8);
            PG8_WAIT_L(0); PG8_BAR; PG8_MMA(0, 0, At, B0); PG8_MMA(0, 1, At, B1); PG8_BAR; PG8_SCHED;
            PG8_LDA(At, 0, 1); PG8_STAGE(PG8_SB(0, 0), b2, voffB); PG8_STAGE(PG8_SB(0, 1), b2 + hstepB, voffB); PG8_STAGE(PG8_SA(0, 0), a2, v2[0]);
            if (stq) PG8_WAIT_VN(8 + Epi::NST); else PG8_WAIT_V(8);
            PG8_WAIT_L(0); PG8_BAR; PG8_MMA(1, 0, At, B0); PG8_MMA(1, 1, At, B1); PG8_BAR; PG8_SCHED;
            PG8_LDB(B0, 1, 0); PG8_LDB(B1, 1, 1); PG8_SCHED; PG8_LDA(At, 1, 0); PG8_STAGE(PG8_SA(0, 1), a2, v2[1]);
            PG8_WAIT_V(8); PG8_WAIT_L(0); PG8_BAR; PG8_MMA(0, 0, At, B0); PG8_MMA(0, 1, At, B1); PG8_BAR; PG8_SCHED;
            PG8_LDA(At, 1, 1); PG8_STAGE(PG8_SB(1, 0), b3, voffB); PG8_STAGE(PG8_SB(1, 1), b3 + hstepB, voffB); PG8_STAGE(PG8_SA(1, 0), a3, v2[0]);
            PG8_WAIT_V(8); PG8_WAIT_L(0); PG8_BAR; PG8_MMA(1, 0, At, B0); PG8_MMA(1, 1, At, B1); PG8_BAR; PG8_SCHED;
#endif
        }
#ifdef KREP
        if (krep_ == 0) { krep_ = 1;
            _Pragma("unroll") for (int a = 0; a < 2; ++a) _Pragma("unroll") for (int b = 0; b < 2; ++b) _Pragma("unroll") for (int m = 0; m < 4; ++m) _Pragma("unroll") for (int n = 0; n < 2; ++n) acc[a][b][m][n] = (f32x4){0.f, 0.f, 0.f, 0.f};
            continue; }
        krep_ = 0; has_next = real_next_;
#endif
        if constexpr (ALIGN_EPI) { if (wr == 0) PG8_BAR; }
        if constexpr (F8) asm volatile("s_nop 15\n\ts_nop 15" ::: "memory");
        E(acc, cur, wr, wc, fr, fq, lds + PG8_SA(1, 1) + ldsw);
#ifdef EPI_TWICE
        asm volatile("" ::: "memory"); E(acc, cur, wr, wc, fr, fq, lds + PG8_SA(1, 1) + ldsw);
#endif
#ifdef EPI_DUMMY
        { asm volatile("" ::: "memory"); unsigned char* dp = S.dummy + ((size_t)(blockIdx.x * 8 + wid) * 16) * 1024 + lane * 16;
          const u32x4 w_ = __builtin_bit_cast(u32x4, acc[0][0][0][0]);
          _Pragma("unroll") for (int q_ = 0; q_ < 16; ++q_) { *(volatile u32x4*)(dp + q_ * 1024) = w_; } }
#endif
        if (!has_next) break;
#pragma unroll
        for (int a = 0; a < 2; ++a)
#pragma unroll
            for (int b = 0; b < 2; ++b)
#pragma unroll
                for (int m = 0; m < 4; ++m)
#pragma unroll
                    for (int n = 0; n < 2; ++n) acc[a][b][m][n] = (f32x4){0.f, 0.f, 0.f, 0.f};
        cur = nxt; cA = nA; cB = nB; ++ui;
#pragma unroll
        for (int h = 0; h < 2; ++h)
#pragma unroll
            for (int i = 0; i < 2; ++i) vaC[h][i] = vaN[h][i];
        if constexpr (ALIGN_EPI) { if (wr == 1) PG8_BAR; }
    }
    PG8_WAIT_V(0);
    if constexpr (!ALIGN_EPI) { if (wr == 0) PG8_BAR; }
    PG8_BAR;
#undef PG8_SA
#undef PG8_SB
#undef PG8_STAGE
#undef PG8_LDA
#undef PG8_LDB
#undef PG8_MMA
#undef PG8_WAIT_V
#undef PG8_WAIT_L
#undef PG8_WAIT_VN
#undef PG8_BAR
#undef PG8_SCHED
}
}

#define XB_TMO      128
#define XB_XCNT(j)  (256  + 64 * (j))
#define XB_XSUB(j)  (1280 + 64 * (j))
#define XB_XGEN(j)  (2304 + 64 * (j))
#define XB_TOP      3328
#define XB_TOPGEN   3392
#define XCD_BAR_WORDS 3456
#define XB_SPIN_CAP (1u << 18)
__device__ __forceinline__ unsigned xb_ld(unsigned* p)              { return __hip_atomic_load(p, __ATOMIC_RELAXED, __HIP_MEMORY_SCOPE_AGENT); }
__device__ __forceinline__ unsigned xb_add(unsigned* p, unsigned v) { return __hip_atomic_fetch_add(p, v, __ATOMIC_RELAXED, __HIP_MEMORY_SCOPE_AGENT); }
__device__ __forceinline__ unsigned xb_xcc_id() { return (unsigned)__builtin_amdgcn_s_getreg((3 << 11) | 20) & 0xFu; }
#define XB_SPIN(cond, bar) do { unsigned _sp = 0; while (cond) { __builtin_amdgcn_s_sleep(1); \
    if ((++_sp & 255u) == 0u) { if (xb_ld(&(bar)[XB_TMO])) break; if (_sp > XB_SPIN_CAP) { atomicAdd(&(bar)[XB_TMO], 1u); break; } } } } while (0)
struct XcdBarrier { unsigned* bar; unsigned x; volatile LAS unsigned* st; int wave; };
__device__ __forceinline__ XcdBarrier xcd_barrier_post(unsigned* bar, volatile LAS unsigned* st, int wave) {
    XcdBarrier b; b.bar = bar; b.x = xb_xcc_id(); b.st = st; b.wave = wave;
    if (tid_of(wave) == 0) (void)xb_add(&bar[XB_XCNT(b.x)], 1u);
    return b;
}
__device__ __forceinline__ void xcd_barrier_complete(unsigned* bar, unsigned x, unsigned& nloc, unsigned& nx) {
    const unsigned G = gridDim.x * gridDim.y * gridDim.z;
    unsigned sum, cnt, mine, sp = 0u;
    for (;;) {
        sum = 0u; cnt = 0u; mine = 0u;
#pragma unroll
        for (unsigned j = 0; j < 16; ++j) { const unsigned c = xb_ld(&bar[XB_XCNT(j)]); sum += c; cnt += (c > 0u) ? 1u : 0u; mine = (j == x) ? c : mine; }
        if (sum == G) break;
        __builtin_amdgcn_s_sleep(1);
        if ((++sp & 255u) == 0u) { if (xb_ld(&bar[XB_TMO])) break; if (sp > XB_SPIN_CAP) { atomicAdd(&bar[XB_TMO], 1u); break; } }
    }
    nloc = mine > 0u ? mine : 1u; nx = cnt > 0u ? cnt : 1u;
}
__device__ __forceinline__ void xcd_barrier(const XcdBarrier& b) {
    asm volatile("s_waitcnt vmcnt(0)" ::: "memory");
    __syncthreads();
    if (tid_of(b.wave) == 0) {
        unsigned* bar = b.bar;
        __builtin_amdgcn_s_waitcnt(0);
        unsigned nloc = b.st[0], nx = b.st[1];
        if (nloc == 0u) { xcd_barrier_complete(bar, b.x, nloc, nx); b.st[0] = nloc; b.st[1] = nx; }
        const unsigned old = xb_add(&bar[XB_XSUB(b.x)], 1u);
        const unsigned gen = old / nloc;
        if (old + 1u == (gen + 1u) * nloc) {
            __builtin_amdgcn_fence(__ATOMIC_RELEASE, "agent");
            asm volatile("s_waitcnt vmcnt(0)" ::: "memory");
            const unsigned og = xb_add(&bar[XB_TOP], 1u);
            const unsigned tg = og / nx;
            if (og + 1u == (tg + 1u) * nx) xb_add(&bar[XB_TOPGEN], 1u);
            else XB_SPIN(xb_ld(&bar[XB_TOPGEN]) == tg, bar);
            __builtin_amdgcn_fence(__ATOMIC_ACQUIRE, "agent");
            xb_add(&bar[XB_XGEN(b.x)], 1u);
            asm volatile("s_waitcnt vmcnt(0)" ::: "memory");
        } else {
            XB_SPIN(xb_ld(&bar[XB_XGEN(b.x)]) == gen, bar);
            __builtin_amdgcn_fence(__ATOMIC_ACQUIRE, "agent");
            asm volatile("s_waitcnt vmcnt(0)" ::: "memory");
        }
    }
    __syncthreads();
}

struct MkArgs {
    const float *x, *g_mix, *w_in, *conv_w, *sinks, *g_ao, *g_co, *w_out, *g_ffn, *w_router, *b_router, *w1, *b1, *w2, *b2, *g_final;
    float* out; unsigned char* ws; int ph_lo, ph_hi;
};
struct Frame {
    LAS unsigned char* lds; int tid, lane, wave, G, bx;
};

__device__ __forceinline__ void phase_stagger(const Frame& F, int nwg, unsigned half_unit_ticks) {
    const int rem = nwg % F.G;
    if (rem != 0 && F.bx >= rem && half_unit_ticks != 0u) {
        const unsigned long long t0 = __builtin_amdgcn_s_memrealtime();
        while (__builtin_amdgcn_s_memrealtime() - t0 < (unsigned long long)half_unit_ticks) __builtin_amdgcn_s_sleep(32);
    }
    __syncthreads();
}
__device__ __forceinline__ int win_srccol(int n) {
    if (n < 1280) return n;
    const int t = (n - 1280) >> 8, c = (n - 1280) & 255, g16 = c >> 4, w = c & 15, bj = w >> 3, k8 = w & 7;
    return (bj ? 1792 : 1280) + t * 128 + g16 * 8 + k8;
}
__device__ __forceinline__ void p0_transpose_item(const float* W, int K, int N, bf16_t* WT, const float* g0, const float* g1, int split, LAS unsigned char* scr, int item, int lane, bool cperm = false) {
    const int nblk = N / 64, kb = item / nblk, nb = item % nblk, k0 = 64 * kb, n = cperm ? win_srccol(64 * nb + lane) : 64 * nb + lane;
    const float* src = W + (size_t)k0 * N + n;
    float v[64];
#pragma unroll
    for (int i = 0; i < 64; ++i) v[i] = __builtin_nontemporal_load(src + (size_t)i * N);
#pragma unroll
    for (int q = 0; q < 8; ++q) {
        float w[8];
#pragma unroll
        for (int i = 0; i < 8; ++i) { const int k = k0 + 8 * q + i; const float gg = g0 ? (k < split ? g0[k] : g1[k - split]) : 1.f; w[i] = v[8 * q + i] * gg; }
        u32x4 o; o.x = cvtpk(w[0], w[1]); o.y = cvtpk(w[2], w[3]); o.z = cvtpk(w[4], w[5]); o.w = cvtpk(w[6], w[7]);
        *(LAS u32x4*)(scr + lane * 128 + ((q ^ (lane & 7)) * 16)) = o;
    }
    LDS_WAIT(); asm volatile("" ::: "memory");
#pragma unroll
    for (int j = 0; j < 8; ++j) {
        const int nl = 8 * j + (lane >> 3), ch = lane & 7;
        const u32x4 o = *(const LAS u32x4*)(scr + nl * 128 + ((ch ^ (nl & 7)) * 16));
        *(u32x4*)(WT + (size_t)(64 * nb + nl) * K + k0 + 8 * ch) = o;
    }
    LDS_WAIT(); asm volatile("" ::: "memory");
}
__device__ __forceinline__ void p0_transpose_item8(const float* W, int K, int N, unsigned char* WT, const float* g0, LAS unsigned char* scr, int item, int lane) {
    const int nblk = N / 64, kb = item / nblk, nb = item % nblk, k0 = 128 * kb, n = 64 * nb + lane;
    const float* src = W + (size_t)k0 * N + n;
    float v[128];
#pragma unroll
    for (int i = 0; i < 128; ++i) v[i] = __builtin_nontemporal_load(src + (size_t)i * N);
    constexpr float SC = (float)(1 << W8_SHIFT);
#pragma unroll
    for (int q = 0; q < 8; ++q) {
        float w[16];
#pragma unroll
        for (int i = 0; i < 16; ++i) { const int k = k0 + 16 * q + i; const float gg = g0 ? g0[k] * SC : SC; w[i] = v[16 * q + i] * gg; }
        u32x4 o; o.x = pg8::pack4_fp8(w[0], w[1], w[2], w[3]); o.y = pg8::pack4_fp8(w[4], w[5], w[6], w[7]); o.z = pg8::pack4_fp8(w[8], w[9], w[10], w[11]); o.w = pg8::pack4_fp8(w[12], w[13], w[14], w[15]);
        *(LAS u32x4*)(scr + lane * 128 + ((q ^ (lane & 7)) * 16)) = o;
    }
    LDS_WAIT(); asm volatile("" ::: "memory");
#pragma unroll
    for (int j = 0; j < 8; ++j) {
        const int nl = 8 * j + (lane >> 3), ch = lane & 7;
        const u32x4 o = *(const LAS u32x4*)(scr + nl * 128 + ((ch ^ (nl & 7)) * 16));
        __builtin_nontemporal_store(o, (u32x4*)(WT + (size_t)(64 * nb + nl) * K + k0 + 16 * ch));
    }
    LDS_WAIT(); asm volatile("" ::: "memory");
}
__device__ __forceinline__ void p0_prologue(const Frame& F, const MkArgs& a, int item_lo, int item_hi, int gw, int NGW, bool rows) {
    unsigned char* ws = a.ws;
    bf16_t* Win_t = (bf16_t*)(ws + WS_WIN); bf16_t* Wout_t = (bf16_t*)(ws + WS_WOUT); float* WR = (float*)(ws + WS_WR);
    bf16_t* W1_t = (bf16_t*)(ws + WS_W1); bf16_t* W2_t = (bf16_t*)(ws + WS_W2); bf16_t* XN = (bf16_t*)(ws + WS_XN);
    LAS unsigned char* scr = F.lds + RING_OFF + F.wave * 8192;
    constexpr int I_IN = (DM / 64) * (INC / 64), I_OUT = (DM / 64) * (DM / 64), I_W1E = (DM / (MOE_FP8 ? 128 : 64)) * (2048 / 64), I_W2E = (DFF / (MOE_FP8 ? 128 : 64)) * (DM / 64);
    constexpr int NITEMS = I_IN + I_OUT + NE * I_W1E + NE * I_W2E;
    if (item_hi > NITEMS) item_hi = NITEMS;
    for (int it = item_lo + gw; it < item_hi; it += NGW) {
        int r = it;
        if (r < I_IN) { p0_transpose_item(a.w_in, DM, INC, Win_t, a.g_mix, a.g_mix, DM, scr, r, F.lane, true); continue; } r -= I_IN;
        if (r < I_OUT) { p0_transpose_item(a.w_out, DM, DM, Wout_t, a.g_ao, a.g_co, 512, scr, r, F.lane); continue; } r -= I_OUT;
#if MOE_FP8
        if (r < NE * I_W1E) { const int e = r / I_W1E; p0_transpose_item8(a.w1 + (size_t)e * DM * 2048, DM, 2048, (unsigned char*)W1_t + (size_t)e * 2048 * DM, a.g_ffn, scr, r % I_W1E, F.lane); continue; } r -= NE * I_W1E;
        { const int e = r / I_W2E; p0_transpose_item8(a.w2 + (size_t)e * DFF * DM, DFF, DM, (unsigned char*)W2_t + (size_t)e * DM * DFF, nullptr, scr, r % I_W2E, F.lane); }
#else
        if (r < NE * I_W1E) { const int e = r / I_W1E; p0_transpose_item(a.w1 + (size_t)e * DM * 2048, DM, 2048, W1_t + (size_t)e * 2048 * DM, a.g_ffn, a.g_ffn, DM, scr, r % I_W1E, F.lane); continue; } r -= NE * I_W1E;
        { const int e = r / I_W2E; p0_transpose_item(a.w2 + (size_t)e * DFF * DM, DFF, DM, W2_t + (size_t)e * DM * DFF, nullptr, nullptr, 0, scr, r % I_W2E, F.lane); }
#endif
    }
    if (!rows) return;
    for (int i = (F.bx * NTHREADS + F.tid); i < DM * NE; i += F.G * NTHREADS) WR[i] = a.w_router[i] * a.g_ffn[i >> 5];
    for (int m0 = 8 * gw; m0 < NTOK; m0 += 8 * NGW) {
        f32x4 v[8][4];
#pragma unroll
        for (int r = 0; r < 8; ++r) { const f32x4* xr = (const f32x4*)(a.x + (size_t)(m0 + r) * DM) + F.lane;
#pragma unroll
            for (int j = 0; j < 4; ++j) v[r][j] = __builtin_nontemporal_load(xr + 64 * j); }
#pragma unroll
        for (int r = 0; r < 8; ++r) {
            float s2 = 0.f;
#pragma unroll
            for (int j = 0; j < 4; ++j) s2 += (v[r][j].x * v[r][j].x + v[r][j].y * v[r][j].y) + (v[r][j].z * v[r][j].z + v[r][j].w * v[r][j].w);
            const float rstd = rsqrtf(wave_sum(s2) * (1.f / DM) + EPS);
            u32x2* o8 = (u32x2*)(XN + (size_t)(m0 + r) * DM) + F.lane;
#pragma unroll
            for (int j = 0; j < 4; ++j) { u32x2 w; w.x = cvtpk(v[r][j].x * rstd, v[r][j].y * rstd); w.y = cvtpk(v[r][j].z * rstd, v[r][j].w * rstd); o8[64 * j] = w; }
        }
    }
}

constexpr int A_KOFF = 0, A_VOFF = 32768, A_HK = 65536, A_WSF = 131072, A_OST = A_WSF + 2048, A_SSQ = A_OST + 16384;
static_assert(A_SSQ + 1024 <= MISC_OFF, "P2 LDS map");
__device__ __forceinline__ int crow(int r, int hi) { return (r & 3) + 8 * (r >> 2) + 4 * hi; }
typedef short v4i16_t __attribute__((ext_vector_type(4)));
__device__ __forceinline__ s16x4 vtr(const LAS unsigned char* p) { return __builtin_bit_cast(s16x4, __builtin_amdgcn_ds_read_tr16_b64_v4i16((LAS v4i16_t*)p)); }

__device__ __forceinline__ void attn_core(const Frame& F, bf16x8 (&qr)[4], const bf16_t* qnext, int nb, int hk, int qt, float slope2, float sink2, f32x16 (&o)[2], float& l_out) {
    LAS unsigned char* L = F.lds;
    const int lane = F.lane, r32 = lane & 31, hi = lane >> 5;
    f32x16 p[5];
    const LAS unsigned char* kb = L + hk * A_HK + A_KOFF + hi * 4096 + r32 * 16 + qt * 512;
#pragma unroll
    for (int j = 0; j < 5; ++j) {
#pragma unroll
        for (int r = 0; r < 16; ++r) p[j][r] = 0.f;
#pragma unroll
        for (int d0 = 0; d0 < 4; ++d0) { const bf16x8 kf = *(const LAS bf16x8*)(kb + d0 * 8192 + j * 512); p[j] = __builtin_amdgcn_mfma_f32_32x32x16_bf16(kf, qr[d0], p[j], 0, 0, 0); }
        __builtin_amdgcn_sched_barrier(0);
    }
#pragma unroll
    for (int d0 = 0; d0 < 4; ++d0) qr[d0] = *(const bf16x8*)(qnext + d0 * 16);
    __builtin_amdgcn_sched_barrier(0);
    int dl = r32 - 4 * hi; asm volatile("" : "+v"(dl));
    const float basef = slope2 * (float)dl;
    float mx = sink2;
#pragma unroll
    for (int j = 0; j < 5; ++j) {
        const bool dead = (nb == 0) && (qt + j < 4);
#pragma unroll
        for (int r = 0; r < 16; ++r) {
            const int cc = (r & 3) + 8 * (r >> 2);
            bool ok = (j == 0) ? (dl < cc) : ((j == 4) ? (cc <= dl) : true);
            ok = ok && !dead;
            const float v = ok ? ((p[j][r] - basef) - slope2 * (float)(128 - 32 * j - cc)) : -INFINITY;
            p[j][r] = v; mx = fmaxf(mx, v);
        }
    }
    mx = fmaxf(mx, __shfl_xor(mx, 32));
    float sum = 0.f;
    u32x4 pk[5][2];
#pragma unroll
    for (int j = 0; j < 5; ++j) {
#pragma unroll
        for (int s = 0; s < 2; ++s) {
            float e[8];
#pragma unroll
            for (int i = 0; i < 8; ++i) { e[i] = __builtin_amdgcn_exp2f(p[j][8 * s + i] - mx); sum += e[i]; }
            pk[j][s].x = cvtpk(e[0], e[1]); pk[j][s].y = cvtpk(e[2], e[3]); pk[j][s].z = cvtpk(e[4], e[5]); pk[j][s].w = cvtpk(e[6], e[7]);
        }
        __builtin_amdgcn_sched_barrier(0);
    }
    sum += __shfl_xor(sum, 32);
    const float l = sum + __builtin_amdgcn_exp2f(sink2 - mx);
#pragma unroll
    for (int r = 0; r < 16; ++r) { o[0][r] = 0.f; o[1][r] = 0.f; }
    const LAS unsigned char* vb = L + hk * A_HK + A_VOFF + ((lane >> 4) & 1) * 32 + (lane & 3) * 8 + (4 * hi + ((lane & 15) >> 2)) * 64 + qt * 2048;
#pragma unroll
    for (int j = 0; j < 5; ++j)
#pragma unroll
        for (int s = 0; s < 2; ++s) {
            const bf16x8 pa = __builtin_bit_cast(bf16x8, pk[j][s]);
#pragma unroll
            for (int d0 = 0; d0 < 2; ++d0) {
                const LAS unsigned char* ap = vb + d0 * 16384 + (2 * j + s) * 1024;
                const s16x4 lo = vtr(ap), hh = vtr(ap + 512);
                const bf16x8 vf = (bf16x8){lo[0], lo[1], lo[2], lo[3], hh[0], hh[1], hh[2], hh[3]};
                o[d0] = __builtin_amdgcn_mfma_f32_32x32x16_bf16(pa, vf, o[d0], 0, 0, 0);
            }
            if (s == 1) __builtin_amdgcn_sched_barrier(0);
        }
    l_out = l;
}
__device__ __forceinline__ void attn_store(const Frame& F, const f32x16 (&o)[2], float l, bf16_t* MIX, int row0, int h, int qt, float (&sq)[4]) {
    LAS unsigned char* L = F.lds;
    const int lane = F.lane, r32 = lane & 31, hi = lane >> 5;
    LAS float* wsf = (LAS float*)(L + A_WSF) + F.wave * 64;
    if (hi == 0) wsf[r32] = l;
    LDS_WAIT();
    LAS bf16_t* stg = (LAS bf16_t*)(L + A_OST) + F.wave * 1024;
#pragma unroll
    for (int R = 0; R < 2; ++R) {
#pragma unroll
        for (int rr = 0; rr < 8; ++rr) { const int r = 8 * R + rr, c = crow(r, hi); const float rl = __builtin_amdgcn_rcpf(wsf[c]); const int cl = (rr & 3) + 8 * (rr >> 2) + 4 * hi;
            stg[cl * 64 + r32] = f2bf(o[0][r] * rl); stg[cl * 64 + 32 + r32] = f2bf(o[1][r] * rl); }
        LDS_WAIT();
#pragma unroll
        for (int i = 0; i < 2; ++i) {
            const int row = i * 8 + (lane >> 3), ch = lane & 7;
            const u32x4 v = *(const LAS u32x4*)(stg + row * 64 + ch * 8);
            *(u32x4*)(MIX + (size_t)(row0 + qt * 32 + 16 * R + row) * DM + h * 64 + ch * 8) = v;
            float s2 = 0.f;
#pragma unroll
            for (int q = 0; q < 4; ++q) { const float a = __uint_as_float(v[q] << 16), b = __uint_as_float(v[q] & 0xffff0000u); s2 += a * a + b * b; }
            s2 += __shfl_xor(s2, 1); s2 += __shfl_xor(s2, 2); s2 += __shfl_xor(s2, 4);
            sq[2 * R + i] += s2;
        }
        LDS_WAIT();
    }
}

struct ConvRegs { u32x4 uu[4], bb[4]; };
struct ConvHalo { u32x4 uu[2]; f32x4 w[3][2]; };
__device__ __forceinline__ void conv_issue(ConvRegs& R, const bf16_t* P, int row0, int rl0, int lane) {
    const int c0 = lane * 8;
    const bf16_t* pr = P + (size_t)(row0 + rl0) * INCP;
#pragma unroll
    for (int i = 0; i < 4; ++i) { const bf16_t* q = pr + (size_t)i * INCP;
        R.bb[i] = __builtin_nontemporal_load((const u32x4*)(q + 768 + c0));
        if (i < 2) R.uu[i] = __builtin_nontemporal_load((const u32x4*)(q + 1280 + c0));
        else R.uu[i] = *(const u32x4*)(q + 1280 + c0); }
}
__device__ __forceinline__ void conv_halo(ConvHalo& H, const MkArgs& a, const bf16_t* P, int row0, int nb, int rl0, int lane) {
    const int c0 = lane * 8;
    const float* cwp = a.conv_w; asm volatile("" : "+s"(cwp));
    const bf16_t* pr = P + (size_t)(row0 + rl0 - 2) * INCP;
    const bool halo = (nb > 0) || (rl0 > 0);
#pragma unroll
    for (int i = 0; i < 2; ++i) { H.uu[i] = (u32x4){0u, 0u, 0u, 0u};
        if (halo) H.uu[i] = *(const u32x4*)(pr + (size_t)i * INCP + 1280 + c0); }
#pragma unroll
    for (int d = 0; d < 3; ++d) { H.w[d][0] = *(const f32x4*)(cwp + d * CONVW + c0); H.w[d][1] = *(const f32x4*)(cwp + d * CONVW + c0 + 4); }
}
__device__ __forceinline__ void conv_finish(const ConvRegs& R, const ConvHalo& H, bf16_t* MIX, int row0, int rl0, int lane) {
    const int c0 = lane * 8;
    float cw[3][8];
#pragma unroll
    for (int d = 0; d < 3; ++d) { const f32x4 w0 = H.w[d][0], w1 = H.w[d][1];
        cw[d][0] = w0.x; cw[d][1] = w0.y; cw[d][2] = w0.z; cw[d][3] = w0.w; cw[d][4] = w1.x; cw[d][5] = w1.y; cw[d][6] = w1.z; cw[d][7] = w1.w; }
    float u2[8], u1[8];
#pragma unroll
    for (int q = 0; q < 4; ++q) { u2[2 * q] = __uint_as_float(H.uu[0][q] << 16); u2[2 * q + 1] = __uint_as_float(H.uu[0][q] & 0xffff0000u);
        u1[2 * q] = __uint_as_float(H.uu[1][q] << 16); u1[2 * q + 1] = __uint_as_float(H.uu[1][q] & 0xffff0000u); }
#pragma unroll
    for (int r = 0; r < 4; ++r) {
        float y[8], u0[8], s2 = 0.f;
#pragma unroll
        for (int q = 0; q < 4; ++q) {
            u0[2 * q] = __uint_as_float(R.uu[r][q] << 16); u0[2 * q + 1] = __uint_as_float(R.uu[r][q] & 0xffff0000u);
            y[2 * q] = __uint_as_float(R.bb[r][q] << 16) * (cw[0][2 * q] * u2[2 * q] + cw[1][2 * q] * u1[2 * q] + cw[2][2 * q] * u0[2 * q]);
            y[2 * q + 1] = __uint_as_float(R.bb[r][q] & 0xffff0000u) * (cw[0][2 * q + 1] * u2[2 * q + 1] + cw[1][2 * q + 1] * u1[2 * q + 1] + cw[2][2 * q + 1] * u0[2 * q + 1]);
            s2 += y[2 * q] * y[2 * q] + y[2 * q + 1] * y[2 * q + 1];
        }
        const float rc = rsqrtf(wave_sum(s2) * (1.f / CONVW) + EPS);
        u32x4 w; w.x = cvtpk(y[0] * rc, y[1] * rc); w.y = cvtpk(y[2] * rc, y[3] * rc); w.z = cvtpk(y[4] * rc, y[5] * rc); w.w = cvtpk(y[6] * rc, y[7] * rc);
        *(u32x4*)(MIX + (size_t)(row0 + rl0 + r) * DM + 512 + c0) = w;
#pragma unroll
        for (int q = 0; q < 8; ++q) { u2[q] = u1[q]; u1[q] = u0[q]; }
    }
}

__device__ __forceinline__ void p2_attn_conv(const Frame& F, const MkArgs& a) {
    const bf16_t* P = (const bf16_t*)(a.ws + WS_P); bf16_t* MIX = (bf16_t*)(a.ws + WS_MIX);
    LAS unsigned char* L = F.lds;
    const int wave = F.wave;
    for (int unit = F.bx; unit < NTOK / 128; unit += F.G) {
        const int tid = tid_of(wave);
        const int lane = tid & 63;
        Frame Fl = F; Fl.tid = tid; Fl.lane = lane;
        const int b = unit >> 7, nb = unit & 127, row0 = b * SEQ + nb * 128;
        __syncthreads();
#pragma unroll
        for (int i = 0; i < 8; ++i) {
            const int idx = tid + 512 * i, hk = idx >> 11, key = (idx >> 3) & 255, ch = idx & 7;
            u32x4 kv = (u32x4){0u, 0u, 0u, 0u}, vv = (u32x4){0u, 0u, 0u, 0u};
            if (nb > 0 || key >= 128) { const bf16_t* src = P + (size_t)(row0 - 128 + key) * INCP + 512 + hk * 64 + ch * 8; kv = *(const u32x4*)src; vv = *(const u32x4*)(src + 128); }
            *(LAS u32x4*)(L + hk * A_HK + A_KOFF + ch * 4096 + key * 16) = kv;
            *(LAS u32x4*)(L + hk * A_HK + A_VOFF + (ch >> 2) * 16384 + (key >> 4) * 1024 + (key & 15) * 64 + (ch & 3) * 16) = vv;
        }
        __syncthreads();
        {
            const int qt = wave & 3, gw = wave >> 2, r32 = lane & 31, hi = lane >> 5;
            const bf16_t* Qp = P + (size_t)(row0 + qt * 32 + r32) * INCP + hi * 8;
            float sq[4] = {0.f, 0.f, 0.f, 0.f};
            bf16x8 qc[4];
#pragma unroll
            for (int d0 = 0; d0 < 4; ++d0) qc[d0] = *(const bf16x8*)(Qp + gw * 64 + d0 * 16);
            ConvRegs CR;
            conv_issue(CR, P, row0, wave * 16, lane);
#pragma unroll 1
            for (int s = 0; s < 4; ++s) {
                const int hk = s >> 1, g = gw + 2 * (s & 1), h = hk * 4 + g;
                const float slope2 = __builtin_amdgcn_exp2f(-(float)(h + 1)) * LOG2E, sink2 = a.sinks[h] * LOG2E;
                f32x16 o[2]; float l;
                const int sn = s < 3 ? s + 1 : 3, hn = (sn >> 1) * 4 + gw + 2 * (sn & 1);
                attn_core(Fl, qc, Qp + hn * 64, nb, hk, qt, slope2, sink2, o, l);
                __builtin_amdgcn_sched_barrier(0);
                ConvHalo CH; conv_halo(CH, a, P, row0, nb, wave * 16 + s * 4, lane);
                __builtin_amdgcn_sched_barrier(0);
                attn_store(Fl, o, l, MIX, row0, h, qt, sq);
                conv_finish(CR, CH, MIX, row0, wave * 16 + s * 4, lane);
                if (s < 3) conv_issue(CR, P, row0, wave * 16 + (s + 1) * 4, lane);
            }
            const int l2 = tid_of(wave) & 63;
            if ((l2 & 7) == 0) {
                LAS float* part = (LAS float*)(L + A_SSQ) + wave * 32 + (l2 >> 3);
#pragma unroll
                for (int i = 0; i < 4; ++i) part[i * 8] = sq[i];
            }
        }
        __syncthreads();
        if (tid < 128) { const LAS float* part = (const LAS float*)(L + A_SSQ); const int qt = tid >> 5, r = tid & 31;
            const float s = part[qt * 32 + r] + part[(qt + 4) * 32 + r];
            ((float*)(a.ws + WS_RSA))[row0 + tid] = rsqrtf(s * (1.f / ATTW) + EPS); }
    }
    __syncthreads();
}

constexpr int R_XT = 0, R_PITCH = 4112, R_PART = 32 * R_PITCH, R_RSTD = R_PART + 128 * 33 * 4, R_HIST = R_RSTD + 512, R_BASE = R_HIST + 128;
static_assert(R_BASE + 128 <= MISC_OFF, "P4 LDS map");
__device__ __forceinline__ void p4_router(const Frame& F, const MkArgs& a, bool dummy) {
    const float* X = a.x; const bf16_t* MO = (const bf16_t*)(a.ws + WS_MO); bf16_t* X1B = (bf16_t*)(a.ws + WS_X1B); const float* WR = (const float*)(a.ws + WS_WR); bf16_t* H2 = (bf16_t*)(a.ws + WS_XN);
    unsigned* gcnt = (unsigned*)(a.ws + WS_CTL) + CW_CNT + (dummy ? 64 : 0); int* list = (int*)(a.ws + (dummy ? WS_DUMMY : WS_LIST));
    int* TE = (int*)(a.ws + (dummy ? WS_DUMMY + 8 * MiB : WS_TE)); int* TP = (int*)(a.ws + (dummy ? WS_DUMMY + 9 * MiB : WS_TP)); float* TG = (float*)(a.ws + (dummy ? WS_DUMMY + 10 * MiB : WS_TG));
    LAS unsigned char* L = F.lds;
    LAS float* part = (LAS float*)(L + R_PART); LAS float* rsl = (LAS float*)(L + R_RSTD); LAS unsigned* hist = (LAS unsigned*)(L + R_HIST); LAS unsigned* gb = (LAS unsigned*)(L + R_BASE);
    const int tid = F.tid, lane = F.lane, wave = F.wave;
    float wreg[16][4];
    { const float* wrp = WR + (size_t)(128 * wave + 4 * (lane >> 5)) * NE + (lane & 31);
#pragma unroll
      for (int it = 0; it < 16; ++it)
#pragma unroll
          for (int e = 0; e < 4; ++e) wreg[it][e] = wrp[(8 * it + e) * NE]; }
    for (int chunk = F.bx; chunk < NTOK / 128; chunk += F.G) {
        const int rowbase = chunk * 128;
        __syncthreads();
        if (tid < 32) hist[tid] = 0u;
        f32x4 v[4][4]; u32x2 mo[4][4];
#define P4_LOADROWS(t_) do { _Pragma("unroll") for (int r = 0; r < 4; ++r) { const size_t row_ = (size_t)(rowbase + 32 * (t_) + wave * 4 + r); \
            const f32x4* xr_ = (const f32x4*)(X + row_ * DM) + lane; const u32x2* mr_ = (const u32x2*)(MO + row_ * DM) + lane; \
            _Pragma("unroll") for (int j = 0; j < 4; ++j) { v[r][j] = xr_[64 * j]; mo[r][j] = mr_[64 * j]; } } } while (0)
        P4_LOADROWS(0);
#pragma unroll 1
        for (int t = 0; t < 4; ++t) {
#pragma unroll
            for (int r = 0; r < 4; ++r) {
                const int rl = 32 * t + wave * 4 + r; float s2 = 0.f;
                u32x2* xb = (u32x2*)(X1B + (size_t)(rowbase + rl) * DM) + lane;
#pragma unroll
                for (int j = 0; j < 4; ++j) {
                    v[r][j].x += __uint_as_float(mo[r][j].x << 16); v[r][j].y += __uint_as_float(mo[r][j].x & 0xffff0000u); v[r][j].z += __uint_as_float(mo[r][j].y << 16); v[r][j].w += __uint_as_float(mo[r][j].y & 0xffff0000u);
                    u32x2 w; w.x = cvtpk(v[r][j].x, v[r][j].y); w.y = cvtpk(v[r][j].z, v[r][j].w); __builtin_nontemporal_store(w, xb + 64 * j);
                    s2 += (v[r][j].x * v[r][j].x + v[r][j].y * v[r][j].y) + (v[r][j].z * v[r][j].z + v[r][j].w * v[r][j].w); }
                const float rstd = rsqrtf(wave_sum(s2) * (1.f / DM) + EPS);
#if MOE_FP8
                unsigned* o4 = (unsigned*)((unsigned char*)H2 + (size_t)(rowbase + rl) * DM) + lane;
#pragma unroll
                for (int j = 0; j < 4; ++j) o4[64 * j] = pg8::pack4_fp8(v[r][j].x * rstd, v[r][j].y * rstd, v[r][j].z * rstd, v[r][j].w * rstd);
#else
                u32x2* o8 = (u32x2*)(H2 + (size_t)(rowbase + rl) * DM) + lane;
#pragma unroll
                for (int j = 0; j < 4; ++j) { u32x2 w; w.x = cvtpk(v[r][j].x * rstd, v[r][j].y * rstd); w.y = cvtpk(v[r][j].z * rstd, v[r][j].w * rstd); o8[64 * j] = w; }
#endif
                if (lane == 0) rsl[rl] = rstd;
            }
            __syncthreads();
#pragma unroll
            for (int r = 0; r < 4; ++r)
#pragma unroll
                for (int j = 0; j < 4; ++j) *(LAS f32x4*)(L + R_XT + (wave * 4 + r) * R_PITCH + (256 * j + 4 * lane) * 4) = v[r][j];
            __syncthreads();
            if (t < 3) P4_LOADROWS(t + 1);
            {
                const int i = lane & 31, h = lane >> 5;
                const LAS unsigned char* xp = L + R_XT + i * R_PITCH + (128 * wave + 4 * h) * 4;
                f32x16 acc;
#pragma unroll
                for (int r = 0; r < 16; ++r) acc[r] = 0.f;
#pragma unroll
                for (int it = 0; it < 16; ++it) {
                    const f32x4 xa = *(const LAS f32x4*)(xp + it * 32);
                    acc = __builtin_amdgcn_mfma_f32_32x32x2f32(xa.x, wreg[it][0], acc, 0, 0, 0); acc = __builtin_amdgcn_mfma_f32_32x32x2f32(xa.y, wreg[it][1], acc, 0, 0, 0);
                    acc = __builtin_amdgcn_mfma_f32_32x32x2f32(xa.z, wreg[it][2], acc, 0, 0, 0); acc = __builtin_amdgcn_mfma_f32_32x32x2f32(xa.w, wreg[it][3], acc, 0, 0, 0);
                }
                __syncthreads();
                LAS float* slot = (LAS float*)(L + R_XT) + wave * (32 * 33);
#pragma unroll
                for (int r = 0; r < 16; ++r) slot[crow(r, h) * 33 + (lane & 31)] = acc[r];
                __syncthreads();
#pragma unroll
                for (int q = 0; q < 2; ++q) { const int idx = tid + 512 * q, row = idx >> 5, ex = idx & 31; float sum = 0.f;
#pragma unroll
                    for (int w8 = 0; w8 < 8; ++w8) sum += ((const LAS float*)(L + R_XT))[w8 * (32 * 33) + row * 33 + ex];
                    part[(32 * t + row) * 33 + ex] = sum; }
            }
        }
#undef P4_LOADROWS
        __syncthreads();
        int ek[4] = {0, 0, 0, 0}; unsigned lp[4] = {0u, 0u, 0u, 0u}; float gk[4] = {0.f, 0.f, 0.f, 0.f};
        if (tid < 128) {
            float lg[32]; const float rstd = rsl[tid];
#pragma unroll
            for (int e = 0; e < 32; ++e) lg[e] = part[tid * 33 + e] * rstd + a.b_router[e];
            unsigned used = 0u; float val[4];
#pragma unroll
            for (int k = 0; k < 4; ++k) { float best = -INFINITY; int bi = 0;
#pragma unroll
                for (int j = 0; j < 32; ++j) { const bool take = !((used >> j) & 1u) && lg[j] > best; best = take ? lg[j] : best; bi = take ? j : bi; }
                used |= 1u << bi; ek[k] = bi; val[k] = best; }
            float es[4], sum = 0.f;
#pragma unroll
            for (int k = 0; k < 4; ++k) { es[k] = __expf(val[k] - val[0]); sum += es[k]; }
            const float inv = 1.f / sum;
#pragma unroll
            for (int k = 0; k < 4; ++k) { gk[k] = es[k] * inv; lp[k] = atomicAdd((unsigned*)&hist[ek[k]], 1u); }
        }
        __syncthreads();
        if (tid < 32) { const unsigned n = hist[tid]; gb[tid] = n ? atomicAdd(&gcnt[tid], n) : 0u; }
        __syncthreads();
        if (tid < 128) {
            const int tok = rowbase + tid;
#pragma unroll
            for (int k = 0; k < 4; ++k) { const unsigned pos = gb[ek[k]] + lp[k]; list[(size_t)ek[k] * NTOK + pos] = tok; TE[tok * 4 + k] = ek[k]; TP[tok * 4 + k] = (int)pos; TG[tok * 4 + k] = gk[k]; }
        }
    }
    __syncthreads();
}

__device__ __forceinline__ int moe_tables(const Frame& F, const MkArgs& a) {
    LAS int* cnt = (LAS int*)(F.lds + CNT_OFF); LAS int* ts = (LAS int*)(F.lds + TSTART_OFF); LAS int* te = (LAS int*)(F.lds + TILEE_OFF);
    const unsigned* gcnt = (const unsigned*)(a.ws + WS_CTL) + CW_CNT;
    __syncthreads();
    if (F.tid < 32) cnt[F.tid] = (int)__hip_atomic_load(gcnt + F.tid, RLX_AGENT);
    __syncthreads();
    if (F.tid == 0) { int s = 0; for (int e = 0; e < NE; ++e) { ts[e] = s; s += (cnt[e] + 255) >> 8; } ts[32] = s; }
    __syncthreads();
    const int total = ts[32];
    for (int t = F.tid; t < total && t < MAXTILES; t += NTHREADS) { int e = 0;
#pragma unroll 1
        for (int q = 1; q < NE; ++q) e += (ts[q] <= t) ? 1 : 0;
        te[t] = e; }
    __syncthreads();
    return total < MAXTILES ? total : MAXTILES;
}

__device__ __forceinline__ void p7_combine(const Frame& F, const MkArgs& a, bool dummy) {
    float* const dst = dummy ? (float*)(a.ws + WS_DUMMY) : a.out;
    const bf16_t* Y = (const bf16_t*)(a.ws + WS_Y); const int* TE = (const int*)(a.ws + WS_TE); const int* TP = (const int*)(a.ws + WS_TP); const float* TG = (const float*)(a.ws + WS_TG);
    LAS int* ts = (LAS int*)(F.lds + TSTART_OFF);
    const int gw = F.bx * NWAVES + F.wave, NGW = F.G * NWAVES, lane = F.lane, l7 = lane & 7;
    f32x4 gf[2][2];
#pragma unroll
    for (int j = 0; j < 2; ++j) { gf[j][0] = *(const f32x4*)(a.g_final + 512 * j + 8 * lane); gf[j][1] = *(const f32x4*)(a.g_final + 512 * j + 8 * lane + 4); }
    int t0 = 2 * gw;
    int e_c = 0, p_c = 0; float g_c = 0.f;
    if (t0 < NTOK) { e_c = TE[t0 * 4 + l7]; p_c = TP[t0 * 4 + l7]; g_c = TG[t0 * 4 + l7]; }
    for (; t0 < NTOK; t0 += 2 * NGW) {
        const int slot_l = 256 * ts[e_c & 31] + p_c; const float g_l = g_c;
        const int tn = t0 + 2 * NGW;
        if (tn < NTOK) { e_c = TE[tn * 4 + l7]; p_c = TP[tn * 4 + l7]; g_c = TG[tn * 4 + l7]; }
#if MOE_FP8
        f32x4 v[2][2][2]; u32x2 y[2][4][2]; float gk[2][4];
#else
        f32x4 v[2][2][2]; u32x4 y[2][4][2]; float gk[2][4];
#endif
#pragma unroll
        for (int tt = 0; tt < 2; ++tt) {
            const bf16_t* xr = (const bf16_t*)(a.ws + WS_X1B) + (size_t)(t0 + tt) * DM + 8 * lane;
#pragma unroll
            for (int j = 0; j < 2; ++j) { const u32x4 xb = *(const u32x4*)(xr + 512 * j);
                v[tt][j][0] = (f32x4){__uint_as_float(xb.x << 16), __uint_as_float(xb.x & 0xffff0000u), __uint_as_float(xb.y << 16), __uint_as_float(xb.y & 0xffff0000u)};
                v[tt][j][1] = (f32x4){__uint_as_float(xb.z << 16), __uint_as_float(xb.z & 0xffff0000u), __uint_as_float(xb.w << 16), __uint_as_float(xb.w & 0xffff0000u)}; }
#pragma unroll
            for (int k = 0; k < 4; ++k) {
                const int slot = __builtin_amdgcn_readlane(slot_l, tt * 4 + k);
                gk[tt][k] = __uint_as_float(__builtin_amdgcn_readlane(__float_as_uint(g_l), tt * 4 + k));
#if MOE_FP8
                const unsigned char* yr = (const unsigned char*)Y + (size_t)slot * DM + 8 * lane;
                y[tt][k][0] = *(const u32x2*)(yr); y[tt][k][1] = *(const u32x2*)(yr + 512);
#else
                const bf16_t* yr = Y + (size_t)slot * DM + 8 * lane;
                y[tt][k][0] = *(const u32x4*)(yr); y[tt][k][1] = *(const u32x4*)(yr + 512);
#endif
            }
        }
#pragma unroll
        for (int tt = 0; tt < 2; ++tt) {
#pragma unroll
            for (int k = 0; k < 4; ++k) { const float g = gk[tt][k];
#pragma unroll
#if MOE_FP8
                for (int j = 0; j < 2; ++j) { const u32x2 yy = y[tt][k][j];
                    const f32x2 a0 = __builtin_amdgcn_cvt_pk_f32_fp8((int)yy.x, false), a1 = __builtin_amdgcn_cvt_pk_f32_fp8((int)yy.x, true), a2 = __builtin_amdgcn_cvt_pk_f32_fp8((int)yy.y, false), a3 = __builtin_amdgcn_cvt_pk_f32_fp8((int)yy.y, true);
                    v[tt][j][0].x += g * a0.x; v[tt][j][0].y += g * a0.y; v[tt][j][0].z += g * a1.x; v[tt][j][0].w += g * a1.y;
                    v[tt][j][1].x += g * a2.x; v[tt][j][1].y += g * a2.y; v[tt][j][1].z += g * a3.x; v[tt][j][1].w += g * a3.y; } }
#else
                for (int j = 0; j < 2; ++j) { const u32x4 yy = y[tt][k][j];
                    v[tt][j][0].x += g * __uint_as_float(yy.x << 16); v[tt][j][0].y += g * __uint_as_float(yy.x & 0xffff0000u); v[tt][j][0].z += g * __uint_as_float(yy.y << 16); v[tt][j][0].w += g * __uint_as_float(yy.y & 0xffff0000u);
                    v[tt][j][1].x += g * __uint_as_float(yy.z << 16); v[tt][j][1].y += g * __uint_as_float(yy.z & 0xffff0000u); v[tt][j][1].z += g * __uint_as_float(yy.w << 16); v[tt][j][1].w += g * __uint_as_float(yy.w & 0xffff0000u); } }
#endif
            float s2 = 0.f;
#pragma unroll
            for (int j = 0; j < 2; ++j)
#pragma unroll
                for (int q = 0; q < 2; ++q) s2 += (v[tt][j][q].x * v[tt][j][q].x + v[tt][j][q].y * v[tt][j][q].y) + (v[tt][j][q].z * v[tt][j][q].z + v[tt][j][q].w * v[tt][j][q].w);
            const float rstd = rsqrtf(wave_sum(s2) * (1.f / DM) + EPS);
            float* xr = dst + (size_t)(t0 + tt) * DM + 8 * lane;
#pragma unroll
            for (int j = 0; j < 2; ++j)
#pragma unroll
                for (int q = 0; q < 2; ++q) *(f32x4*)(xr + 512 * j + 4 * q) = v[tt][j][q] * rstd * gf[j][q];
        }
    }
}

__global__ void __launch_bounds__(NTHREADS, 2) mk_fwd(MkArgs args) {
    extern __shared__ __attribute__((aligned(16))) unsigned char lds_raw[];
    Frame F;
    F.lds = (LAS unsigned char*)lds_raw;
    F.tid = threadIdx.x; F.lane = F.tid & 63; F.wave = __builtin_amdgcn_readfirstlane(F.tid >> 6); F.G = gridDim.x; F.bx = blockIdx.x;
    volatile LAS unsigned* MISC = (volatile LAS unsigned*)(F.lds + MISC_OFF);
    if (F.tid < 32) MISC[F.tid] = 0u;
    __syncthreads();
    const int lo = args.ph_lo, hi = args.ph_hi;
    unsigned* ctl = (unsigned*)(args.ws + WS_CTL);
    XcdBarrier bar; bar.bar = ctl + CW_BAR; bar.x = 0; bar.st = nullptr; bar.wave = F.wave;
    if (hi - lo > 1) bar = xcd_barrier_post(ctl + CW_BAR, MISC + 8, F.wave);
#ifndef PHASE_SEL
#define PHASE_SEL 0xFF
#endif
#define IN(k) (((PHASE_SEL >> (k)) & 1) && lo <= (k) && (k) < hi)
#define SEAM(k) do { if (IN(k) && IN((k) + 1)) xcd_barrier(bar); F.tid = tid_of(F.wave); F.lane = F.tid & 63; } while (0)
#ifndef REP_MASK
#define REP_MASK 0
#endif
#define REPS(k) for (int rep_ = 0; rep_ < (((REP_MASK >> (k)) & 1) ? 2 : 1); ++rep_)
    unsigned char* ws = args.ws;
    F.tid = tid_of(F.wave); F.lane = F.tid & 63;
    constexpr int P0_SMALL = (DM / 64) * (INC / 64) + (DM / 64) * (DM / 64);
    const bool split = (F.G == 256) && SPLIT_CONV;
    const int p0_hi = split ? P0_SMALL + CONV_IN_P0 : 0x7fffffff;
    if (IN(0)) REPS(0) { p0_prologue(F, args, 0, p0_hi, F.bx * NWAVES + F.wave, F.G * NWAVES, true); }
    SEAM(0);
    if (IN(1)) REPS(1) {
        const int grp = F.bx >> 3;
        if (split && (grp & 3) == 3) {
            const int rank = (grp >> 2) * 8 + (F.bx & 7);
            p0_prologue(F, args, p0_hi, 0x7fffffff, rank * NWAVES + F.wave, 64 * NWAVES, false);
        } else {
            const int Gg = split ? 192 : F.G, cg = split ? (grp - (grp >> 2)) * 8 + (F.bx & 7) : F.bx;
            pg8::ProbDense S{(const bf16_t*)(ws + WS_XN), (const bf16_t*)(ws + WS_WIN), NTOK / 256, INC / 256, Gg, cg, ws + WS_DUMMY};
            pg8::EpiP E{(bf16_t*)(ws + WS_P)};
            pg8::gemm_phase<pg8::ProbDense, pg8::EpiP, true>(F.lds + RING_OFF, S, E, F.wave);
        }
    }
    SEAM(1);
    if (IN(2)) REPS(2) { p2_attn_conv(F, args); }
    SEAM(2);
    if (IN(3)) REPS(3) {
        pg8::ProbDense S{(const bf16_t*)(ws + WS_MIX), (const bf16_t*)(ws + WS_WOUT), NTOK / 256, DM / 256, F.G, F.bx, ws + WS_DUMMY};
        pg8::EpiMo E{(bf16_t*)(ws + WS_MO), (const float*)(ws + WS_RSA)};
        pg8::gemm_phase<pg8::ProbDense, pg8::EpiMo, true>(F.lds + RING_OFF, S, E, F.wave);
    }
    SEAM(3);
    if (IN(4)) REPS(4) { p4_router(F, args, ((REP_MASK >> 4) & 1) && rep_ == 0); }
    SEAM(4);
    int nM_keep = -1;
    if (IN(5)) REPS(5) {
        const int nM = moe_tables(F, args); nM_keep = nM;
        LAS int* te = (LAS int*)(F.lds + TILEE_OFF); LAS int* ts = (LAS int*)(F.lds + TSTART_OFF); LAS int* cnt = (LAS int*)(F.lds + CNT_OFF); LAS unsigned* idtab = (LAS unsigned*)(F.lds + IDTAB_OFF);
        pg8::ProbG1<MOE_FP8 != 0> S{(const unsigned char*)(ws + WS_XN), (const unsigned char*)(ws + WS_W1), nM, F.G, F.bx, te, idtab, ws + WS_DUMMY};
        const int* list = (const int*)(ws + WS_LIST);
        pg8::Unit u;
        for (int i = 0; i < IDTAB_UNITS && S.next(i, u); ++i) {
            if (F.tid < 256) { const int rie = (u.pm - ts[u.e]) * 256 + F.tid; const int tok = rie < cnt[u.e] ? list[(size_t)u.e * NTOK + rie] : 0; idtab[i * 256 + F.tid] = (unsigned)tok * (unsigned)(pg8::ProbG1<MOE_FP8 != 0>::KB); }
        }
        __syncthreads();
        phase_stagger(F, nM * 8, STG5);
#if MOE_FP8
        pg8::EpiAct8 E{(unsigned char*)(ws + WS_ACT), args.b1, (const LAS float*)(F.lds + BIAS_OFF)};
        pg8::gemm_phase<pg8::ProbG1<true>, pg8::EpiAct8, true>(F.lds + RING_OFF, S, E, F.wave);
#else
        pg8::EpiAct E{(bf16_t*)(ws + WS_ACT), args.b1};
        pg8::gemm_phase<pg8::ProbG1<false>, pg8::EpiAct, true>(F.lds + RING_OFF, S, E, F.wave);
#endif
    }
    SEAM(5);
    if (IN(6)) REPS(6) {
        const int nM = (nM_keep >= 0) ? nM_keep : moe_tables(F, args);
        LAS int* te = (LAS int*)(F.lds + TILEE_OFF);
        pg8::ProbG2<MOE_FP8 != 0> S{(const unsigned char*)(ws + WS_ACT), (const unsigned char*)(ws + WS_W2), nM, F.G, F.bx, te, ws + WS_DUMMY};
#if MOE_FP8
        pg8::EpiY8 E{(unsigned char*)(ws + WS_Y), args.b2, (const LAS float*)(F.lds + BIAS_OFF)};
        pg8::gemm_phase<pg8::ProbG2<true>, pg8::EpiY8, true>(F.lds + RING_OFF, S, E, F.wave);
#else
        pg8::EpiY E{(bf16_t*)(ws + WS_Y), args.b2, (const LAS float*)(F.lds + BIAS_OFF)};
        pg8::gemm_phase<pg8::ProbG2<false>, pg8::EpiY, true>(F.lds + RING_OFF, S, E, F.wave);
#endif
    }
    SEAM(6);
    if (IN(7)) REPS(7) { if (nM_keep < 0) (void)moe_tables(F, args); p7_combine(F, args, ((REP_MASK >> 7) & 1) && rep_ == 0); }
#undef IN
#undef SEAM
}

#ifndef MK_MASK
#define MK_MASK 0xFF
#endif
#ifndef MK_ONE
#define MK_ONE 1
#endif

extern "C" void kernel_launch(void* const* d_in, const int* in_sizes, int n_in, void* d_out, int out_size, void* d_ws, size_t ws_size, hipStream_t stream) {
    if (n_in != 16 || out_size != NTOK * DM || ws_size < WS_END) { fprintf(stderr, "kernel_launch: unexpected shapes (n_in %d out %d ws %zu)\n", n_in, out_size, ws_size); return; }
    const float* x = (const float*)d_in[0]; const float* g_mix = (const float*)d_in[1]; const float* w_in = (const float*)d_in[2]; const float* conv_w = (const float*)d_in[3];
    const float* sinks = (const float*)d_in[4]; const float* g_ao = (const float*)d_in[5]; const float* g_co = (const float*)d_in[6]; const float* w_out = (const float*)d_in[7];
    const float* g_ffn = (const float*)d_in[8]; const float* w_router = (const float*)d_in[9]; const float* b_router = (const float*)d_in[10]; const float* w1 = (const float*)d_in[11];
    const float* b1 = (const float*)d_in[12]; const float* w2 = (const float*)d_in[13]; const float* b2 = (const float*)d_in[14]; const float* g_final = (const float*)d_in[15];
    unsigned char* ws = (unsigned char*)d_ws; float* out = (float*)d_out;
    static int grid = 0;
    if (grid == 0) {
        int dev = 0, cus = 0, per_cu = 0;
        if (hipGetDevice(&dev) != hipSuccess || hipDeviceGetAttribute(&cus, hipDeviceAttributeMultiprocessorCount, dev) != hipSuccess) { fprintf(stderr, "kernel_launch: device query failed\n"); grid = -1; return; }
        if (hipFuncSetAttribute((const void*)mk_fwd, hipFuncAttributeMaxDynamicSharedMemorySize, LDS_BYTES) != hipSuccess) { fprintf(stderr, "kernel_launch: hipFuncSetAttribute failed\n"); grid = -1; return; }
        if (hipOccupancyMaxActiveBlocksPerMultiprocessor(&per_cu, (const void*)mk_fwd, NTHREADS, LDS_BYTES) != hipSuccess || per_cu < 1) { fprintf(stderr, "kernel_launch: occupancy query says %d blocks per CU\n", per_cu); per_cu = 1; }
        (void)hipGetLastError();
        grid = cus;
    }
    if (grid < 0) return;
    (void)hipMemsetAsync(ws + WS_CTL, 0, CTL_BYTES, stream);
    MkArgs a{};
    a.x = x; a.g_mix = g_mix; a.w_in = w_in; a.conv_w = conv_w; a.sinks = sinks; a.g_ao = g_ao; a.g_co = g_co; a.w_out = w_out; a.g_ffn = g_ffn; a.w_router = w_router; a.b_router = b_router;
    a.w1 = w1; a.b1 = b1; a.w2 = w2; a.b2 = b2; a.g_final = g_final; a.out = out; a.ws = ws;
#if MK_ONE
    a.ph_lo = 0; a.ph_hi = 8;
    hipLaunchKernelGGL(mk_fwd, dim3(grid), dim3(NTHREADS), LDS_BYTES, stream, a);
#else
    unsigned* ctl = (unsigned*)(ws + WS_CTL);
    bf16_t* Win_t = (bf16_t*)(ws + WS_WIN); bf16_t* Wout_t = (bf16_t*)(ws + WS_WOUT); float* WR = (float*)(ws + WS_WR); int* list = (int*)(ws + WS_LIST);
    int* TE = (int*)(ws + WS_TE); int* TP = (int*)(ws + WS_TP); float* TG = (float*)(ws + WS_TG); int* tab = (int*)(ws + WS_TAB); float* gcat = (float*)(ws + WS_TAB + 16384);
    bf16_t* W1_t = (bf16_t*)(ws + WS_W1); bf16_t* W2_t = (bf16_t*)(ws + WS_W2); bf16_t* XN = (bf16_t*)(ws + WS_XN); bf16_t* P = (bf16_t*)(ws + WS_P);
    bf16_t* MIX = (bf16_t*)(ws + WS_MIX); bf16_t* ACT = (bf16_t*)(ws + WS_ACT); bf16_t* Y = (bf16_t*)(ws + WS_Y); float* ATT = (float*)(ws + WS_ATT);
    for (int p = 0; p < 8; ++p) {
        if ((MK_MASK >> p) & 1) { a.ph_lo = p; a.ph_hi = p + 1; hipLaunchKernelGGL(mk_fwd, dim3(grid), dim3(NTHREADS), LDS_BYTES, stream, a); continue; }
        switch (p) {
        case 0:
            n_gcat<<<4, 256, 0, stream>>>(g_ao, g_co, gcat);
            n_transpose<<<dim3(DM / 32, INC / 32, 1), dim3(32, 8), 0, stream>>>(w_in, Win_t, DM, INC, g_mix);
            n_transpose<<<dim3(DM / 32, DM / 32, 1), dim3(32, 8), 0, stream>>>(w_out, Wout_t, DM, DM, gcat);
            n_transpose<<<dim3(DM / 32, 2048 / 32, NE), dim3(32, 8), 0, stream>>>(w1, W1_t, DM, 2048, g_ffn);
            n_transpose<<<dim3(DFF / 32, DM / 32, NE), dim3(32, 8), 0, stream>>>(w2, W2_t, DFF, DM, nullptr);
            n_wr<<<DM * NE / 256, 256, 0, stream>>>(w_router, g_ffn, WR);
            n_xn<<<NTOK, 256, 0, stream>>>(x, XN); break;
        case 1: { NG g{}; g.A = XN; g.Bt = Win_t; g.Ob = P; n_gemm<0><<<dim3(NTOK / 128, INC / 128), 256, 0, stream>>>(g); } break;
        case 2: n_attn<<<NTOK * NQH / 4, 256, 0, stream>>>(P, sinks, ATT); n_mix<<<NTOK, 256, 0, stream>>>(P, ATT, conv_w, MIX); break;
        case 3: { NG g{}; g.A = MIX; g.Bt = Wout_t; g.Of = out; g.X = x; n_gemm<1><<<dim3(NTOK / 128, DM / 128), 256, 0, stream>>>(g); } break;
        case 4: n_router<<<NTOK, 256, 0, stream>>>(out, WR, b_router, XN, ctl + CW_CNT, list, TE, TP, TG); break;
        case 5: n_tables<<<1, 64, 0, stream>>>(ctl + CW_CNT, tab);
            { NG g{}; g.A = XN; g.Bt = W1_t; g.Ob = ACT; g.bias = b1; g.list = list; g.cnt = ctl + CW_CNT; g.tab = tab; n_gemm<2><<<dim3(PADROWS / 128, DFF / 128), 256, 0, stream>>>(g); } break;
        case 6: n_tables<<<1, 64, 0, stream>>>(ctl + CW_CNT, tab);
            { NG g{}; g.A = ACT; g.Bt = W2_t; g.Ob = Y; g.bias = b2; g.list = list; g.cnt = ctl + CW_CNT; g.tab = tab; n_gemm<3><<<dim3(PADROWS / 128, DM / 128), 256, 0, stream>>>(g); } break;
        case 7: n_tables<<<1, 64, 0, stream>>>(ctl + CW_CNT, tab); n_combine<<<NTOK, 256, 0, stream>>>(out, Y, TE, TP, TG, tab, g_final, out); break;
        }
    }
#endif
}
```

```cpp
#include <hip/hip_runtime.h>
#include <cstdint>
#include <cstdio>
#ifndef SCHED44
#define SCHED44 0
#endif
#ifndef SPLIT_CONV
#define SPLIT_CONV 0
#define CONV_IN_P0 0
#endif
#ifndef STG1
#define STG1 0
#define STG3 0
#define STG5 0
#define STG6 0
#endif

typedef unsigned short bf16_t;
typedef short bf16x8 __attribute__((ext_vector_type(8)));
typedef float f32x4 __attribute__((ext_vector_type(4)));

constexpr int BATCH = 2, SEQ = 16384, DM = 1024, NTOK = BATCH * SEQ;
constexpr int NQH = 8, HD = 64, ATTW = 512, CONVW = 512, INC = 2304;
constexpr int INCP = 1792;
constexpr int NE = 32, DFF = 1024;
constexpr int MAXTILES = 544, PADROWS = MAXTILES * 256;
constexpr float EPS = 1e-5f;
constexpr float LOG2E = 1.4426950408889634f;
constexpr float C2 = 0.125f * LOG2E;
constexpr int W8_SHIFT = 5;
constexpr int W8_SCALE_E8M0 = 127 - W8_SHIFT;
#ifndef MOE_FP8
#define MOE_FP8 1
#endif

constexpr size_t MiB = 1u << 20;
constexpr size_t WS_CTL = 0, CTL_BYTES = 64 * 1024;
constexpr size_t WS_WIN = 1 * MiB, WS_WOUT = 6 * MiB, WS_WR = 8 * MiB, WS_LIST = 9 * MiB;
constexpr size_t WS_TE = 13 * MiB, WS_TP = 13 * MiB + 512 * 1024, WS_TG = 14 * MiB, WS_TAB = 14 * MiB + 512 * 1024;
constexpr size_t WS_RSA = 15 * MiB;
constexpr size_t WS_W1 = 16 * MiB, WS_W2 = 144 * MiB, WS_XN = 208 * MiB, WS_P = 272 * MiB, WS_MIX = 416 * MiB;
constexpr size_t WS_MO = 272 * MiB  , WS_X1B = 816 * MiB  ;
constexpr size_t WS_ACT = 272 * MiB, WS_Y = 544 * MiB, WS_ATT = 816 * MiB, WS_DUMMY = 880 * MiB, WS_END = 1016 * MiB;
constexpr int CW_CNT = 0;

__device__ __forceinline__ float bf2f(bf16_t v) { return __uint_as_float((unsigned)v << 16); }
__device__ __forceinline__ bf16_t f2bf(float f) { unsigned u = __float_as_uint(f); return (bf16_t)((u + 0x7fffu + ((u >> 16) & 1u)) >> 16); }

__device__ __forceinline__ float wave_sum(float v) {
#pragma unroll
    for (int o = 1; o < 64; o <<= 1) v += __shfl_xor(v, o);
    return v;
}
__device__ __forceinline__ float wave_max(float v) {
#pragma unroll
    for (int o = 1; o < 64; o <<= 1) v = fmaxf(v, __shfl_xor(v, o));
    return v;
}
__device__ __forceinline__ float block_sum256(float v, float* red) {
    v = wave_sum(v);
    __syncthreads();
    if ((threadIdx.x & 63) == 0) red[threadIdx.x >> 6] = v;
    __syncthreads();
    return red[0] + red[1] + red[2] + red[3];
}

__global__ void n_transpose(const float* W, bf16_t* WT, int K, int N, const float* g) {
    __shared__ float tile[32][33];
    const size_t zoff = (size_t)blockIdx.z * K * N;
    const int k0 = blockIdx.x * 32, n0 = blockIdx.y * 32, tx = threadIdx.x, ty = threadIdx.y;
#pragma unroll
    for (int i = 0; i < 4; ++i) { const int kk = ty + 8 * i; tile[kk][tx] = W[zoff + (size_t)(k0 + kk) * N + n0 + tx] * (g ? g[k0 + kk] : 1.f); }
    __syncthreads();
#pragma unroll
    for (int i = 0; i < 4; ++i) { const int nn = ty + 8 * i; WT[zoff + (size_t)(n0 + nn) * K + k0 + tx] = f2bf(tile[tx][nn]); }
}
__global__ void n_wr(const float* wr, const float* g, float* out) {
    const int i = blockIdx.x * 256 + threadIdx.x; if (i < DM * NE) out[i] = wr[i] * g[i >> 5];
}
__global__ void n_gcat(const float* ga, const float* gc, float* out) { const int i = blockIdx.x * 256 + threadIdx.x; if (i < DM) out[i] = i < 512 ? ga[i] : gc[i - 512]; }
__global__ __launch_bounds__(256) void n_xn(const float* x, bf16_t* XN) {
    __shared__ float red[4];
    const int row = blockIdx.x, t = threadIdx.x;
    const f32x4 v = *(const f32x4*)(x + (size_t)row * DM + 4 * t);
    const float ss = block_sum256(v.x * v.x + v.y * v.y + v.z * v.z + v.w * v.w, red);
    const float rstd = rsqrtf(ss * (1.f / DM) + EPS);
    bf16_t* o = XN + (size_t)row * DM + 4 * t;
    o[0] = f2bf(v.x * rstd); o[1] = f2bf(v.y * rstd); o[2] = f2bf(v.z * rstd); o[3] = f2bf(v.w * rstd);
}

struct NG {
    const bf16_t* A; const bf16_t* Bt; bf16_t* Ob; float* Of; const float* X; const float* bias;
    const int* list; const unsigned* cnt; const int* tab;
};
__device__ __forceinline__ float swiglu(float g, float l) {
    g = fminf(g, 7.f); l = fminf(fmaxf(l, -7.f), 7.f);
    const float s = __builtin_amdgcn_rcpf(1.f + __builtin_amdgcn_exp2f(-1.702f * LOG2E * g));
    const float a = g * s;
    return __builtin_fmaf(a, l, a);
}
typedef float f32x2v __attribute__((ext_vector_type(2)));
__device__ __forceinline__ f32x2v swiglu_pk(f32x2v g, f32x2v l) {
    g.x = __builtin_amdgcn_fmed3f(g.x, -24.f, 7.f); g.y = __builtin_amdgcn_fmed3f(g.y, -24.f, 7.f);
    l.x = __builtin_amdgcn_fmed3f(l.x, -7.f, 7.f); l.y = __builtin_amdgcn_fmed3f(l.y, -7.f, 7.f);
    const f32x2v t = g * (-1.702f * LOG2E);
    f32x2v e; e.x = __builtin_amdgcn_exp2f(t.x); e.y = __builtin_amdgcn_exp2f(t.y);
    const f32x2v d = e + 1.0f;
    const float rr = __builtin_amdgcn_rcpf(d.x * d.y);
    const f32x2v ds = {d.y, d.x};
    const f32x2v a = g * (ds * rr);
    return a * l + a;
}
template <int MODE> __global__ __launch_bounds__(256) void n_gemm(NG a) {
    const int lane = threadIdx.x & 63, w = threadIdx.x >> 6, row = lane & 15, quad = lane >> 4;
    const int m0 = blockIdx.x * 128 + (w >> 1) * 64, n0 = blockIdx.y * 128 + (w & 1) * 64;
    int e = 0, rbase = 0, cnt = 0;
    if (MODE >= 2) {
        const int pm = (blockIdx.x * 128) >> 8;
        if (pm >= a.tab[32]) return;
        e = a.tab[64 + pm]; rbase = m0 - 256 * a.tab[e]; cnt = (int)a.cnt[e];
    }
    const bf16_t* ar[4]; const bf16_t* br[4]; const bf16_t* br2[4];
#pragma unroll
    for (int i = 0; i < 4; ++i) {
        const int m = m0 + 16 * i + row;
        if (MODE == 2) { const int rr = rbase + 16 * i + row; const int tok = rr < cnt ? a.list[e * NTOK + rr] : 0; ar[i] = a.A + (size_t)tok * DM; }
        else ar[i] = a.A + (size_t)m * DM;
        const int n = n0 + 16 * i + row;
        if (MODE == 2) { br[i] = a.Bt + ((size_t)e * 2048 + n) * DM; br2[i] = br[i] + (size_t)1024 * DM; }
        else if (MODE == 3) { br[i] = a.Bt + ((size_t)e * 1024 + n) * DM; br2[i] = br[i]; }
        else { br[i] = a.Bt + (size_t)n * DM; br2[i] = br[i]; }
    }
    f32x4 acc[4][4], acc2[4][4];
#pragma unroll
    for (int i = 0; i < 4; ++i)
#pragma unroll
        for (int j = 0; j < 4; ++j) { acc[i][j] = (f32x4){0.f, 0.f, 0.f, 0.f}; acc2[i][j] = (f32x4){0.f, 0.f, 0.f, 0.f}; }
    for (int k0 = 0; k0 < DM; k0 += 32) {
        bf16x8 fa[4], fb[4], fb2[4];
#pragma unroll
        for (int i = 0; i < 4; ++i) { fa[i] = *(const bf16x8*)(ar[i] + k0 + quad * 8); fb[i] = *(const bf16x8*)(br[i] + k0 + quad * 8); if (MODE == 2) fb2[i] = *(const bf16x8*)(br2[i] + k0 + quad * 8); }
#pragma unroll
        for (int i = 0; i < 4; ++i)
#pragma unroll
            for (int j = 0; j < 4; ++j) {
                acc[i][j] = __builtin_amdgcn_mfma_f32_16x16x32_bf16(fa[i], fb[j], acc[i][j], 0, 0, 0);
                if (MODE == 2) acc2[i][j] = __builtin_amdgcn_mfma_f32_16x16x32_bf16(fa[i], fb2[j], acc2[i][j], 0, 0, 0);
            }
    }
#pragma unroll
    for (int i = 0; i < 4; ++i)
#pragma unroll
        for (int j = 0; j < 4; ++j)
#pragma unroll
            for (int r = 0; r < 4; ++r) {
                const int m = m0 + 16 * i + quad * 4 + r, n = n0 + 16 * j + row;
                const float v = acc[i][j][r];
                if (MODE == 0) a.Ob[(size_t)m * INC + n] = f2bf(n < 512 ? v * C2 : v);
                else if (MODE == 1) a.Of[(size_t)m * DM + n] = a.X[(size_t)m * DM + n] + v;
                else if (MODE == 2) a.Ob[(size_t)m * DM + n] = f2bf(swiglu(v + a.bias[e * 2048 + n], acc2[i][j][r] + a.bias[e * 2048 + 1024 + n]));
                else a.Ob[(size_t)m * DM + n] = f2bf(v + a.bias[e * 1024 + n]);
            }
}

__global__ __launch_bounds__(256) void n_attn(const bf16_t* P, const float* sinks, float* ATT) {
    const int gw = blockIdx.x * 4 + (threadIdx.x >> 6), lane = threadIdx.x & 63;
    const int tok = gw >> 3, h = gw & 7, hk = h >> 2, t = tok % SEQ;
    const float slope2 = exp2f(-(float)(h + 1)) * LOG2E, sink2 = sinks[h] * LOG2E;
    float q[64];
    const bf16_t* qp = P + (size_t)tok * INC + h * 64;
#pragma unroll
    for (int d = 0; d < 64; ++d) q[d] = bf2f(qp[d]);
    float s[2];
#pragma unroll
    for (int jj = 0; jj < 2; ++jj) {
        const int j = lane + 64 * jj, kp = t - 127 + j;
        float acc = -INFINITY;
        if (kp >= 0) {
            const bf16_t* kr = P + (size_t)(tok - 127 + j) * INC + 512 + hk * 64;
            acc = 0.f;
#pragma unroll
            for (int d = 0; d < 64; ++d) acc += q[d] * bf2f(kr[d]);
            acc -= slope2 * (float)(127 - j);
        }
        s[jj] = acc;
    }
    const float m = fmaxf(wave_max(fmaxf(s[0], s[1])), sink2);
    const float e0 = exp2f(s[0] - m), e1 = exp2f(s[1] - m);
    const float l = wave_sum(e0 + e1) + exp2f(sink2 - m);
    const float p0 = e0 / l, p1 = e1 / l;
    float o = 0.f;
    for (int j = 0; j < 128; ++j) {
        const float pj = __shfl(j < 64 ? p0 : p1, j & 63);
        if (t - 127 + j >= 0) o += pj * bf2f(P[(size_t)(tok - 127 + j) * INC + 640 + hk * 64 + lane]);
    }
    ATT[(size_t)tok * ATTW + h * 64 + lane] = o;
}
__global__ __launch_bounds__(256) void n_mix(const bf16_t* P, const float* ATT, const float* convw, bf16_t* MIX) {
    __shared__ float red[4];
    const int tok = blockIdx.x, tid = threadIdx.x, t = tok % SEQ;
    const float a0 = ATT[(size_t)tok * ATTW + tid], a1 = ATT[(size_t)tok * ATTW + 256 + tid];
    const float ssa = block_sum256(a0 * a0 + a1 * a1, red);
    const float ra = rsqrtf(ssa * (1.f / ATTW) + EPS);
    MIX[(size_t)tok * DM + tid] = f2bf(a0 * ra); MIX[(size_t)tok * DM + 256 + tid] = f2bf(a1 * ra);
    float y[2];
#pragma unroll
    for (int i = 0; i < 2; ++i) {
        const int c = tid + 256 * i;
        float acc = 0.f;
#pragma unroll
        for (int dt = 0; dt < 3; ++dt) {
            const int tt = t - 2 + dt;
            if (tt >= 0) { const bf16_t* pr = P + (size_t)(tok - 2 + dt) * INC; acc += convw[dt * CONVW + c] * (bf2f(pr[1280 + c]) * bf2f(pr[1792 + c])); }
        }
        y[i] = bf2f(P[(size_t)tok * INC + 768 + c]) * acc;
    }
    const float ssc = block_sum256(y[0] * y[0] + y[1] * y[1], red);
    const float rc = rsqrtf(ssc * (1.f / CONVW) + EPS);
    MIX[(size_t)tok * DM + 512 + tid] = f2bf(y[0] * rc); MIX[(size_t)tok * DM + 768 + tid] = f2bf(y[1] * rc);
}
__global__ __launch_bounds__(256) void n_router(const float* X1, const float* WR, const float* br, bf16_t* H2, unsigned* cnt, int* list, int* TE, int* TP, float* TG) {
    __shared__ float red[4]; __shared__ float xs[DM]; __shared__ float part[8][32]; __shared__ float lg[32];
    const int tok = blockIdx.x, tid = threadIdx.x;
    const f32x4 v = *(const f32x4*)(X1 + (size_t)tok * DM + 4 * tid);
    const float ss = block_sum256(v.x * v.x + v.y * v.y + v.z * v.z + v.w * v.w, red);
    const float rstd = rsqrtf(ss * (1.f / DM) + EPS);
    bf16_t* o = H2 + (size_t)tok * DM + 4 * tid;
    o[0] = f2bf(v.x * rstd); o[1] = f2bf(v.y * rstd); o[2] = f2bf(v.z * rstd); o[3] = f2bf(v.w * rstd);
    xs[4 * tid] = v.x; xs[4 * tid + 1] = v.y; xs[4 * tid + 2] = v.z; xs[4 * tid + 3] = v.w;
    __syncthreads();
    const int e = tid & 31, pt = tid >> 5;
    float acc = 0.f;
    for (int k = pt * 128; k < pt * 128 + 128; ++k) acc += xs[k] * WR[k * NE + e];
    part[pt][e] = acc;
    __syncthreads();
    if (tid < 32) { float sum = 0.f; for (int p = 0; p < 8; ++p) sum += part[p][tid]; lg[tid] = sum * rstd + br[tid]; }
    __syncthreads();
    if (tid == 0) {
        int idx[4]; float val[4]; unsigned used = 0u;
        for (int k = 0; k < 4; ++k) { float best = -INFINITY; int bi = 0; for (int j = 0; j < 32; ++j) if (!((used >> j) & 1u) && lg[j] > best) { best = lg[j]; bi = j; } used |= 1u << bi; idx[k] = bi; val[k] = best; }
        float es[4], sum = 0.f; for (int k = 0; k < 4; ++k) { es[k] = expf(val[k] - val[0]); sum += es[k]; }
        for (int k = 0; k < 4; ++k) {
            const unsigned pos = atomicAdd(&cnt[idx[k]], 1u);
            list[idx[k] * NTOK + pos] = tok; TE[tok * 4 + k] = idx[k]; TP[tok * 4 + k] = (int)pos; TG[tok * 4 + k] = es[k] / sum;
        }
    }
}
__global__ void n_tables(const unsigned* cnt, int* tab) {
    if (threadIdx.x == 0) { int s = 0; for (int e = 0; e < NE; ++e) { tab[e] = s; const int nt = ((int)cnt[e] + 255) >> 8; for (int i = 0; i < nt; ++i) tab[64 + s + i] = e; s += nt; } tab[32] = s; }
}
__global__ __launch_bounds__(256) void n_combine(const float* X1, const bf16_t* Y, const int* TE, const int* TP, const float* TG, const int* tab, const float* gf, float* out) {
    __shared__ float red[4];
    const int tok = blockIdx.x, tid = threadIdx.x;
    f32x4 v = *(const f32x4*)(X1 + (size_t)tok * DM + 4 * tid);
#pragma unroll
    for (int k = 0; k < 4; ++k) {
        const int e = TE[tok * 4 + k]; const size_t slot = (size_t)256 * tab[e] + TP[tok * 4 + k]; const float g = TG[tok * 4 + k];
        const bf16_t* yr = Y + slot * DM + 4 * tid;
        v.x += g * bf2f(yr[0]); v.y += g * bf2f(yr[1]); v.z += g * bf2f(yr[2]); v.w += g * bf2f(yr[3]);
    }
    const float ss = block_sum256(v.x * v.x + v.y * v.y + v.z * v.z + v.w * v.w, red);
    const float rstd = rsqrtf(ss * (1.f / DM) + EPS);
    const f32x4 g4 = *(const f32x4*)(gf + 4 * tid);
    *(f32x4*)(out + (size_t)tok * DM + 4 * tid) = (f32x4){v.x * rstd * g4.x, v.y * rstd * g4.y, v.z * rstd * g4.z, v.w * rstd * g4.w};
}


#define LAS __attribute__((address_space(3)))
#define GAS __attribute__((address_space(1)))
typedef unsigned u32x4 __attribute__((ext_vector_type(4)));
typedef unsigned u32x2 __attribute__((ext_vector_type(2)));
typedef float f32x16 __attribute__((ext_vector_type(16)));
typedef float f32x2 __attribute__((ext_vector_type(2)));
typedef short s16x4 __attribute__((ext_vector_type(4)));
typedef __bf16 bf16x2_t __attribute__((ext_vector_type(2)));
typedef GAS unsigned gu32;
#define RLX_AGENT __ATOMIC_RELAXED, __HIP_MEMORY_SCOPE_AGENT
#define LDS_WAIT() asm volatile("s_waitcnt lgkmcnt(0)" ::: "memory")
#define VM_WAIT() asm volatile("s_waitcnt vmcnt(0)" ::: "memory")

constexpr int NWAVES = 8, NTHREADS = 512;
constexpr int RING_OFF = 0, RING_BYTES = 131072;
constexpr int IDTAB_OFF = RING_BYTES, IDTAB_UNITS = 17, IDTAB_BYTES = IDTAB_UNITS * 1024;
constexpr int TILEE_OFF = IDTAB_OFF + IDTAB_BYTES;
constexpr int TSTART_OFF = TILEE_OFF + 2304;
constexpr int CNT_OFF = TSTART_OFF + 256;
constexpr int MISC_OFF = CNT_OFF + 128;
constexpr int BIAS_OFF = MISC_OFF + 128;
constexpr int LDS_BYTES = 155648;
static_assert(BIAS_OFF % 16 == 0 && BIAS_OFF + 1024 <= LDS_BYTES, "LDS map");
constexpr int CW_BAR = 4096;

__device__ __forceinline__ unsigned cvtpk(float lo, float hi) { f32x2 v = {lo, hi}; bf16x2_t b = __builtin_convertvector(v, bf16x2_t); return __builtin_bit_cast(unsigned, b); }

__device__ __forceinline__ int tid_of(int wave) { unsigned z = 0u; asm volatile("" : "+v"(z)); const int l = (int)__builtin_amdgcn_mbcnt_hi(~0u, __builtin_amdgcn_mbcnt_lo(~0u, z)); return wave * 64 + l; }

namespace pg8 {
constexpr int BM = 256, BK = 64, HALF = 128, HTB = HALF * BK * 2, NXCD = 8, WGM = 8, KD = 1024;
typedef int i32x8 __attribute__((ext_vector_type(8)));
typedef int i32x4 __attribute__((ext_vector_type(4)));
__host__ __device__ __forceinline__ int lds_byte(int r, int c) { return r * 128 + ((((c >> 3) ^ (r >> 1)) & 7) << 4) + (c & 7) * 2; }
__host__ __device__ __forceinline__ void stage_rc(int b, int& R, int& C) { R = b >> 7; C = ((((b >> 4) & 7) ^ ((R >> 1) & 7)) << 3); }
__host__ __device__ __forceinline__ int perm32(int rho) { const int n = rho >> 4, i = rho & 15; return 8 * (i >> 2) + 4 * n + (i & 3); }
struct Unit { int pm, pn, e; };
__device__ __forceinline__ bool order_next(int i, int G, int c, int nM, int nN, Unit& u) {
    const int nwg = nM * nN; const long L = (long)i * G + c; if (L >= nwg) return false;
    int wgid = (int)L; { const int q = nwg / NXCD, r = nwg % NXCD, xcd = wgid % NXCD, off = wgid / NXCD; wgid = (xcd < r ? xcd * (q + 1) : r * (q + 1) + (xcd - r) * q) + off; }
    const int nig = WGM * nN, gid = wgid / nig, fm = gid * WGM, gsz = (nM - fm) < WGM ? (nM - fm) : WGM;
    u.pm = fm + ((wgid % nig) % gsz); u.pn = (wgid % nig) / gsz; u.e = 0; return true;
}
struct ProbDense {
    static constexpr int KB = KD * 2; static constexpr bool F8 = false;
    static constexpr size_t HSTEPB = (size_t)HALF * KD * 2;
    const bf16_t* A; const bf16_t* Bt; int nM, nN, G, c; unsigned char* dummy;
    __device__ __forceinline__ bool next(int i, Unit& u) const { return order_next(i, G, c, nM, nN, u); }
    __device__ __forceinline__ const char* a_base(const Unit& u) const { return (const char*)A + (size_t)u.pm * BM * KD * 2; }
    __device__ __forceinline__ const char* b_base(const Unit& u) const { return (const char*)Bt + (size_t)u.pn * BM * KD * 2; }
    __device__ __forceinline__ void a_offs(int, const Unit&, const int (&Rr)[2], const int (&Cb)[2], unsigned (&va)[2][2]) const {
#pragma unroll
        for (int h = 0; h < 2; ++h)
#pragma unroll
            for (int i = 0; i < 2; ++i) va[h][i] = (unsigned)((Rr[i] + HALF * h) * KD * 2 + Cb[i]);
    }
};
template <bool F8_> struct ProbG1 {
    static constexpr int KB = F8_ ? KD : KD * 2; static constexpr bool F8 = F8_;
    static constexpr size_t HSTEPB = (size_t)1024 * KB;
    const unsigned char* H2; const unsigned char* W1t; int nM, G, c; const LAS int* tile_e; const LAS unsigned* idtab; unsigned char* dummy;
    __device__ __forceinline__ bool next(int i, Unit& u) const { if (!order_next(i, G, c, nM, 8, u)) return false; u.e = __builtin_amdgcn_readfirstlane(tile_e[u.pm]); return true; }
    __device__ __forceinline__ const char* a_base(const Unit&) const { return (const char*)H2; }
    __device__ __forceinline__ const char* b_base(const Unit& u) const { return (const char*)W1t + ((size_t)u.e * 2048 + (size_t)u.pn * 128) * KB; }
    __device__ __forceinline__ void a_offs(int ui, const Unit&, const int (&Rr)[2], const int (&Cb)[2], unsigned (&va)[2][2]) const {
        const int uu = ui < IDTAB_UNITS ? ui : IDTAB_UNITS - 1;
#pragma unroll
        for (int h = 0; h < 2; ++h)
#pragma unroll
            for (int i = 0; i < 2; ++i) va[h][i] = idtab[uu * 256 + h * HALF + Rr[i]] + (unsigned)Cb[i];
    }
};
template <bool F8_> struct ProbG2 {
    static constexpr int KB = F8_ ? KD : KD * 2; static constexpr bool F8 = F8_;
    static constexpr size_t HSTEPB = (size_t)HALF * KB;
    const unsigned char* ACT; const unsigned char* W2t; int nM, G, c; const LAS int* tile_e; unsigned char* dummy;
    __device__ __forceinline__ bool next(int i, Unit& u) const { if (!order_next(i, G, c, nM, 4, u)) return false; u.e = __builtin_amdgcn_readfirstlane(tile_e[u.pm]); return true; }
    __device__ __forceinline__ const char* a_base(const Unit& u) const { return (const char*)ACT + (size_t)u.pm * BM * KB; }
    __device__ __forceinline__ const char* b_base(const Unit& u) const { return (const char*)W2t + ((size_t)u.e * 1024 + (size_t)u.pn * 256) * KB; }
    __device__ __forceinline__ void a_offs(int, const Unit&, const int (&Rr)[2], const int (&Cb)[2], unsigned (&va)[2][2]) const {
#pragma unroll
        for (int h = 0; h < 2; ++h)
#pragma unroll
            for (int i = 0; i < 2; ++i) va[h][i] = (unsigned)((Rr[i] + HALF * h) * KB + Cb[i]);
    }
};

__device__ __forceinline__ void store_rows16(LAS unsigned char* scr, int fr, int fq, int lane, u32x4 c0, u32x4 c1, bf16_t* gbase  , size_t ld) {
    LAS unsigned char* wp = scr + (fr >> 3) * 8192 + (fr & 7) * 128;
    *(LAS u32x4*)(wp + (((2 * fq) ^ (fr & 7)) * 16)) = c0;
    *(LAS u32x4*)(wp + (((2 * fq + 1) ^ (fr & 7)) * 16)) = c1;
#pragma unroll
    for (int k = 0; k < 2; ++k) {
        const int rl = lane >> 3, ch = lane & 7;
        const u32x4 v = *(const LAS u32x4*)(scr + k * 8192 + rl * 128 + ((ch ^ rl) * 16));
        *(u32x4*)(gbase + (size_t)(8 * k + rl) * ld + ch * 8) = v;
    }
}
struct EpiP {
    static constexpr int PERM = 2; static constexpr bool HAS_BIAS = false; static constexpr bool MIDSCALE = false; static constexpr int NST = 16; bf16_t* O;
    __device__ __forceinline__ const char* bias_src(const Unit&, int) const { return nullptr; }
    __device__ __forceinline__ void operator()(const f32x4 (&acc)[2][2][4][2], const Unit& u, int wr, int wc, int fr, int fq, LAS unsigned char* scr) const {
        const int lane = fr + 16 * fq;
        if (u.pn >= 5) {
            bf16_t* ub = O + (size_t)(u.pm * BM + wr * 64 + fr) * INCP + 1280 + (u.pn - 5) * 128 + (4 * wc + fq) * 8;
#pragma unroll
            for (int ai = 0; ai < 2; ++ai)
#pragma unroll
                for (int m = 0; m < 4; ++m) {
                    const f32x4 p0 = acc[ai][0][m][0] * acc[ai][1][m][0], p1 = acc[ai][0][m][1] * acc[ai][1][m][1];
                    u32x2 w0, w1; w0.x = cvtpk(p0[0], p0[1]); w0.y = cvtpk(p0[2], p0[3]); w1.x = cvtpk(p1[0], p1[1]); w1.y = cvtpk(p1[2], p1[3]);
                    u32x2* dst = (u32x2*)(ub + (size_t)(ai * HALF + m * 16) * INCP);
                    dst[0] = w0; dst[1] = w1;
                }
            return;
        }
        const float sc = u.pn < 2 ? C2 : 1.f;
        bf16_t* base = O + (size_t)(u.pm * BM + wr * 64) * INCP + u.pn * BM + wc * 64;
#pragma unroll
        for (int ai = 0; ai < 2; ++ai)
#pragma unroll
            for (int m = 0; m < 4; ++m) {
                u32x4 c[2];
#pragma unroll
                for (int bj = 0; bj < 2; ++bj) { const f32x4 v0 = acc[ai][bj][m][0] * sc, v1 = acc[ai][bj][m][1] * sc;
                    c[bj].x = cvtpk(v0[0], v0[1]); c[bj].y = cvtpk(v0[2], v0[3]); c[bj].z = cvtpk(v1[0], v1[1]); c[bj].w = cvtpk(v1[2], v1[3]); }
                store_rows16(scr, fr, fq, lane, c[0], c[1], base + (size_t)(ai * HALF + m * 16) * INCP, INCP);
            }
    }
};
struct EpiMo {
    static constexpr int PERM = 2; static constexpr bool HAS_BIAS = false; static constexpr bool MIDSCALE = true; static constexpr int NST = 16; bf16_t* O; const float* RS;
    __device__ __forceinline__ const char* bias_src(const Unit&, int) const { return nullptr; }
    __device__ __forceinline__ const char* scale_src(const Unit& u, int lane) const { return (const char*)(RS + (size_t)u.pm * BM + lane * 4); }
    __device__ __forceinline__ void operator()(const f32x4 (&acc)[2][2][4][2], const Unit& u, int wr, int wc, int fr, int fq, LAS unsigned char* scr) const {
        const int lane = fr + 16 * fq;
        bf16_t* base = O + (size_t)(u.pm * BM + wr * 64) * DM + u.pn * BM + wc * 64;
#pragma unroll
        for (int ai = 0; ai < 2; ++ai)
#pragma unroll
            for (int m = 0; m < 4; ++m) {
                u32x4 c[2];
#pragma unroll
                for (int bj = 0; bj < 2; ++bj) { const f32x4 v0 = acc[ai][bj][m][0], v1 = acc[ai][bj][m][1];
                    c[bj].x = cvtpk(v0[0], v0[1]); c[bj].y = cvtpk(v0[2], v0[3]); c[bj].z = cvtpk(v1[0], v1[1]); c[bj].w = cvtpk(v1[2], v1[3]); }
                store_rows16(scr, fr, fq, lane, c[0], c[1], base + (size_t)(ai * HALF + m * 16) * DM, DM);
            }
    }
};
struct EpiX1 {
    static constexpr int PERM = 0; static constexpr bool HAS_BIAS = false; static constexpr bool MIDSCALE = false; static constexpr int NST = 0; const float* X; float* O;
    __device__ __forceinline__ const char* bias_src(const Unit&, int) const { return nullptr; }
    __device__ __forceinline__ void operator()(const f32x4 (&acc)[2][2][4][2], const Unit& u, int wr, int wc, int fr, int fq, LAS unsigned char* scr) const {
        const int row0 = u.pm * BM + wr * 64 + fr, col0 = u.pn * BM + wc * 32 + 4 * fq;
#pragma unroll
        for (int ai = 0; ai < 2; ++ai)
#pragma unroll
            for (int m = 0; m < 4; ++m) { const size_t off = (size_t)(row0 + ai * HALF + m * 16) * DM + col0;
#pragma unroll
                for (int bj = 0; bj < 2; ++bj)
#pragma unroll
                    for (int n = 0; n < 2; ++n) { const f32x4 xr = *(const f32x4*)(X + off + bj * HALF + n * 16); *(f32x4*)(O + off + bj * HALF + n * 16) = xr + acc[ai][bj][m][n]; } }
    }
};
struct EpiAct {
    static constexpr int PERM = 1; static constexpr bool HAS_BIAS = false; static constexpr bool MIDSCALE = false; static constexpr int NST = 0; bf16_t* O; const float* b1;
    __device__ __forceinline__ const char* bias_src(const Unit&, int) const { return nullptr; }
    __device__ __forceinline__ void operator()(const f32x4 (&acc)[2][2][4][2], const Unit& u, int wr, int wc, int fr, int fq, LAS unsigned char* scr) const {
        const int row0 = u.pm * BM + wr * 64 + fr, col0 = u.pn * 128 + wc * 32 + 8 * fq;
        const float* bp = b1 + (size_t)u.e * 2048 + col0;
        const f32x4 bg0 = *(const f32x4*)(bp), bg1 = *(const f32x4*)(bp + 4), bl0 = *(const f32x4*)(bp + 1024), bl1 = *(const f32x4*)(bp + 1028);
#pragma unroll
        for (int ai = 0; ai < 2; ++ai)
#pragma unroll
            for (int m = 0; m < 4; ++m) {
                const f32x4 g0 = acc[ai][0][m][0] + bg0, g1 = acc[ai][0][m][1] + bg1, l0 = acc[ai][1][m][0] + bl0, l1 = acc[ai][1][m][1] + bl1;
                u32x4 w; w.x = cvtpk(swiglu(g0[0], l0[0]), swiglu(g0[1], l0[1])); w.y = cvtpk(swiglu(g0[2], l0[2]), swiglu(g0[3], l0[3]));
                w.z = cvtpk(swiglu(g1[0], l1[0]), swiglu(g1[1], l1[1])); w.w = cvtpk(swiglu(g1[2], l1[2]), swiglu(g1[3], l1[3]));
                *(u32x4*)(O + (size_t)(row0 + ai * HALF + m * 16) * DM + col0) = w; }
    }
};
__device__ __forceinline__ unsigned pack4_fp8(float a, float b, float c, float d) {
    a = fminf(fmaxf(a, -448.f), 448.f); b = fminf(fmaxf(b, -448.f), 448.f); c = fminf(fmaxf(c, -448.f), 448.f); d = fminf(fmaxf(d, -448.f), 448.f);
    int p = __builtin_amdgcn_cvt_pk_fp8_f32(a, b, 0, false); p = __builtin_amdgcn_cvt_pk_fp8_f32(c, d, p, true); return (unsigned)p;
}
__device__ __forceinline__ unsigned pack4_fp8_nc(float a, float b, float c, float d) {
    int p = __builtin_amdgcn_cvt_pk_fp8_f32(a, b, 0, false); p = __builtin_amdgcn_cvt_pk_fp8_f32(c, d, p, true); return (unsigned)p;
}
struct EpiAct8 {
    static constexpr int PERM = 1; static constexpr bool HAS_BIAS = true; static constexpr bool MIDSCALE = false; static constexpr int NST = 8; unsigned char* O; const float* b1; const LAS float* bl;
    __device__ __forceinline__ const char* bias_src(const Unit& u, int lane) const { return (const char*)(b1 + (size_t)u.e * 2048 + (size_t)u.pn * 128 + (lane >> 5) * 1024) + (lane & 31) * 16; }
    __device__ __forceinline__ void operator()(const f32x4 (&acc)[2][2][4][2], const Unit& u, int wr, int wc, int fr, int fq, LAS unsigned char* scr) const {
        const int row0 = u.pm * BM + wr * 64 + fr, cl = wc * 32 + 8 * fq, col0 = u.pn * 128 + cl;
        const f32x4 bg0 = *(const LAS f32x4*)(bl + cl), bg1 = *(const LAS f32x4*)(bl + cl + 4), bl0 = *(const LAS f32x4*)(bl + 128 + cl), bl1 = *(const LAS f32x4*)(bl + 128 + cl + 4);
#pragma unroll
        for (int ai = 0; ai < 2; ++ai)
#pragma unroll
            for (int m = 0; m < 4; ++m) {
                const f32x4 g0 = acc[ai][0][m][0] + bg0, g1 = acc[ai][0][m][1] + bg1, l0 = acc[ai][1][m][0] + bl0, l1 = acc[ai][1][m][1] + bl1;
                const f32x2v s0 = swiglu_pk((f32x2v){g0[0], g0[1]}, (f32x2v){l0[0], l0[1]}), s1 = swiglu_pk((f32x2v){g0[2], g0[3]}, (f32x2v){l0[2], l0[3]});
                const f32x2v s2 = swiglu_pk((f32x2v){g1[0], g1[1]}, (f32x2v){l1[0], l1[1]}), s3 = swiglu_pk((f32x2v){g1[2], g1[3]}, (f32x2v){l1[2], l1[3]});
                u32x2 w; w.x = pack4_fp8_nc(s0.x, s0.y, s1.x, s1.y); w.y = pack4_fp8_nc(s2.x, s2.y, s3.x, s3.y);
                *(u32x2*)(O + (size_t)(row0 + ai * HALF + m * 16) * DM + col0) = w; }
    }
};
struct EpiY {
    static constexpr int PERM = 2; static constexpr bool HAS_BIAS = true; static constexpr bool MIDSCALE = false; static constexpr int NST = 16; bf16_t* O; const float* b2; const LAS float* bl;
    __device__ __forceinline__ const char* bias_src(const Unit& u, int lane) const { return (const char*)(b2 + (size_t)u.e * 1024 + (size_t)u.pn * 256) + lane * 16; }
    __device__ __forceinline__ void operator()(const f32x4 (&acc)[2][2][4][2], const Unit& u, int wr, int wc, int fr, int fq, LAS unsigned char* scr) const {
        const int lane = fr + 16 * fq, cl = wc * 64 + 16 * fq;
        f32x4 bv[2][2];
#pragma unroll
        for (int bj = 0; bj < 2; ++bj)
#pragma unroll
            for (int n = 0; n < 2; ++n) bv[bj][n] = *(const LAS f32x4*)(bl + cl + 8 * bj + 4 * n);
        bf16_t* base = O + (size_t)(u.pm * BM + wr * 64) * DM + u.pn * BM + wc * 64;
#pragma unroll
        for (int ai = 0; ai < 2; ++ai)
#pragma unroll
            for (int m = 0; m < 4; ++m) {
                u32x4 c[2];
#pragma unroll
                for (int bj = 0; bj < 2; ++bj) { const f32x4 v0 = acc[ai][bj][m][0] + bv[bj][0], v1 = acc[ai][bj][m][1] + bv[bj][1];
                    c[bj].x = cvtpk(v0[0], v0[1]); c[bj].y = cvtpk(v0[2], v0[3]); c[bj].z = cvtpk(v1[0], v1[1]); c[bj].w = cvtpk(v1[2], v1[3]); }
                store_rows16(scr, fr, fq, lane, c[0], c[1], base + (size_t)(ai * HALF + m * 16) * DM, DM);
            }
    }
};

struct EpiY8 {
    static constexpr int PERM = 2; static constexpr bool HAS_BIAS = true; static constexpr bool MIDSCALE = false; static constexpr int NST = 8; unsigned char* O; const float* b2; const LAS float* bl;
    __device__ __forceinline__ const char* bias_src(const Unit& u, int lane) const { return (const char*)(b2 + (size_t)u.e * 1024 + (size_t)u.pn * 256) + lane * 16; }
    __device__ __forceinline__ void operator()(const f32x4 (&acc)[2][2][4][2], const Unit& u, int wr, int wc, int fr, int fq, LAS unsigned char* scr) const {
        const int lane = fr + 16 * fq, cl = wc * 64 + 16 * fq;
        f32x4 bv[2][2];
#pragma unroll
        for (int bj = 0; bj < 2; ++bj)
#pragma unroll
            for (int n = 0; n < 2; ++n) bv[bj][n] = *(const LAS f32x4*)(bl + cl + 8 * bj + 4 * n);
        unsigned char* base = O + (size_t)(u.pm * BM + wr * 64) * DM + u.pn * BM + wc * 64;
        const int rrow = lane >> 2, rch = lane & 3;
#pragma unroll
        for (int ai = 0; ai < 2; ++ai)
#pragma unroll
            for (int mp = 0; mp < 2; ++mp) {
#pragma unroll
                for (int j = 0; j < 2; ++j) { const int m = 2 * mp + j;
                    const f32x4 a0 = acc[ai][0][m][0] + bv[0][0], a1 = acc[ai][0][m][1] + bv[0][1], a2 = acc[ai][1][m][0] + bv[1][0], a3 = acc[ai][1][m][1] + bv[1][1];
                    u32x4 w; w.x = pack4_fp8(a0[0], a0[1], a0[2], a0[3]); w.y = pack4_fp8(a1[0], a1[1], a1[2], a1[3]); w.z = pack4_fp8(a2[0], a2[1], a2[2], a2[3]); w.w = pack4_fp8(a3[0], a3[1], a3[2], a3[3]);
                    *(LAS u32x4*)(scr + j * 8192 + fr * 64 + ((fq ^ ((fr >> 1) & 3)) * 16)) = w; }
#pragma unroll
                for (int j = 0; j < 2; ++j) {
                    const u32x4 v = *(const LAS u32x4*)(scr + j * 8192 + rrow * 64 + ((rch ^ ((rrow >> 1) & 3)) * 16));
                    __builtin_nontemporal_store(v, (u32x4*)(base + (size_t)(ai * HALF + (2 * mp + j) * 16 + rrow) * DM + rch * 16)); }
            }
    }
};

template <class Prob, class Epi, bool ALIGN_EPI>
__device__ __forceinline__ void gemm_phase(LAS unsigned char* lds, const Prob& S, const Epi& E, int wave_) {
    const int tid = tid_of(wave_), wid = wave_, lane = tid & 63, wr = wid >> 2, wc = wid & 3, fr = lane & 15, fq = lane >> 4;
    constexpr int KB = Prob::KB, nt = KB / 128; constexpr bool F8 = Prob::F8;
    unsigned voffB[2]; int Rr[2], Cb[2];
#pragma unroll
    for (int i = 0; i < 2; ++i) { int R, C; stage_rc(tid * 16 + i * 8192, R, C);
        const int Rb = (Epi::PERM == 2) ? (64 * (R >> 5) + 16 * ((R & 15) >> 2) + 4 * ((R >> 4) & 1) + (R & 3)) : (Epi::PERM == 1) ? ((R & ~31) + perm32(R & 31)) : R;
        voffB[i] = (unsigned)(Rb * KB + C * 2); Rr[i] = R; Cb[i] = C * 2; }
    constexpr size_t kstep = (size_t)(BK * 2);
    constexpr size_t hstepB = (Epi::PERM == 2) ? (size_t)8 * KB : Prob::HSTEPB;
    const unsigned ldsw = (unsigned)wid * 1024u;
    const int aoff = lds_byte(wr * 64 + fr, fq * 8), boff = lds_byte(wc * 32 + fr, fq * 8), aoff1 = lds_byte(wr * 64 + fr, 32 + fq * 8), boff1 = lds_byte(wc * 32 + fr, 32 + fq * 8);
#define PG8_SA(b, h) (((b) * 2 + (h)) * HTB)
#define PG8_SB(b, h) ((4 + (b) * 2 + (h)) * HTB)
#define PG8_STAGE(bufoff, gbase, voff) do { _Pragma("unroll") for (int _i = 0; _i < 2; ++_i) \
        __builtin_amdgcn_global_load_lds((const unsigned*)((const char*)(gbase) + (voff)[_i]), (LAS unsigned*)(lds + (bufoff) + ldsw + _i * 8192), 16, 0, 0); } while (0)
#define PG8_LDA(dst, b, h) do { _Pragma("unroll") for (int m = 0; m < 4; ++m) { const i32x4 x0_ = *(const LAS i32x4*)(lds + PG8_SA(b, h) + aoff + m * 2048), x1_ = *(const LAS i32x4*)(lds + PG8_SA(b, h) + aoff1 + m * 2048); dst[m] = __builtin_shufflevector(x0_, x1_, 0, 1, 2, 3, 4, 5, 6, 7); } } while (0)
#define PG8_LDB(dst, b, h) do { _Pragma("unroll") for (int n = 0; n < 2; ++n) { const i32x4 x0_ = *(const LAS i32x4*)(lds + PG8_SB(b, h) + boff + n * 2048), x1_ = *(const LAS i32x4*)(lds + PG8_SB(b, h) + boff1 + n * 2048); dst[n] = __builtin_shufflevector(x0_, x1_, 0, 1, 2, 3, 4, 5, 6, 7); } } while (0)
#define PG8_MMA(ai, bj, At, Bt) do { __builtin_amdgcn_s_setprio(1); _Pragma("unroll") for (int m = 0; m < 4; ++m) _Pragma("unroll") for (int n = 0; n < 2; ++n) { \
        if constexpr (F8) asm volatile("s_nop 1\n\tv_mfma_scale_f32_16x16x128_f8f6f4 %0, %1, %2, %0, %3, %4 op_sel_hi:[0,0,0]" : "+v"(acc[ai][bj][m][n]) : "v"(Bt[n]), "v"(At[m]), "v"(scw), "v"(sca)); \
        else { acc[ai][bj][m][n] = __builtin_amdgcn_mfma_f32_16x16x32_bf16(__builtin_bit_cast(bf16x8, (i32x4)__builtin_shufflevector(Bt[n], Bt[n], 0, 1, 2, 3)), __builtin_bit_cast(bf16x8, (i32x4)__builtin_shufflevector(At[m], At[m], 0, 1, 2, 3)), acc[ai][bj][m][n], 0, 0, 0); \
               acc[ai][bj][m][n] = __builtin_amdgcn_mfma_f32_16x16x32_bf16(__builtin_bit_cast(bf16x8, (i32x4)__builtin_shufflevector(Bt[n], Bt[n], 4, 5, 6, 7)), __builtin_bit_cast(bf16x8, (i32x4)__builtin_shufflevector(At[m], At[m], 4, 5, 6, 7)), acc[ai][bj][m][n], 0, 0, 0); } } \
        __builtin_amdgcn_s_setprio(0); } while (0)
#define PG8_WAIT_V(n) asm volatile("s_waitcnt vmcnt(" #n ")" ::: "memory")
#define PG8_WAIT_L(n) asm volatile("s_waitcnt lgkmcnt(" #n ")" ::: "memory")
#define PG8_WAIT_VN(n) asm volatile("s_waitcnt vmcnt(%0)" :: "n"(n) : "memory")
#define PG8_BAR __builtin_amdgcn_s_barrier()
#define PG8_SCHED __builtin_amdgcn_sched_barrier(0)
    Unit cur, nxt; int ui = 0;
    if (!S.next(0, cur)) return;
    unsigned vaC[2][2], vaN[2][2];
    S.a_offs(0, cur, Rr, Cb, vaC);
    f32x4 acc[2][2][4][2];
#pragma unroll
    for (int a = 0; a < 2; ++a)
#pragma unroll
        for (int b = 0; b < 2; ++b)
#pragma unroll
            for (int m = 0; m < 4; ++m)
#pragma unroll
                for (int n = 0; n < 2; ++n) acc[a][b][m][n] = (f32x4){0.f, 0.f, 0.f, 0.f};
    i32x8 At[4], B0[2], B1[2];
    int scw = W8_SCALE_E8M0, sca = 127; asm volatile("" : "+v"(scw), "+v"(sca));
    const char* cA = S.a_base(cur); const char* cB = S.b_base(cur);
    PG8_STAGE(PG8_SB(0, 0), cB, voffB); PG8_STAGE(PG8_SB(0, 1), cB + hstepB, voffB); PG8_STAGE(PG8_SA(0, 0), cA, vaC[0]); PG8_STAGE(PG8_SA(0, 1), cA, vaC[1]);
    if (wr == 1) PG8_BAR;
    PG8_WAIT_V(2); PG8_BAR;
#if SCHED44
    PG8_STAGE(PG8_SB(1, 0), cB + kstep, voffB); PG8_STAGE(PG8_SA(1, 0), cA + kstep, vaC[0]);
#else
    PG8_STAGE(PG8_SB(1, 0), cB + kstep, voffB); PG8_STAGE(PG8_SA(1, 0), cA + kstep, vaC[0]); PG8_STAGE(PG8_SB(1, 1), cB + hstepB + kstep, voffB);
#endif
    PG8_WAIT_V(6); PG8_BAR;
#ifdef KREP
    int krep_ = 0;
#endif
    for (;;) {
        bool has_next = S.next(ui + 1, nxt);
#ifdef KREP
        const bool real_next_ = has_next; if (krep_ == 0) has_next = false;
#endif
        const char* nA = has_next ? S.a_base(nxt) : cA; const char* nB = has_next ? S.b_base(nxt) : cB;
        if (has_next) S.a_offs(ui + 1, nxt, Rr, Cb, vaN);
        else {
#pragma unroll
            for (int h = 0; h < 2; ++h)
#pragma unroll
                for (int i = 0; i < 2; ++i) vaN[h][i] = vaC[h][i]; }
#pragma unroll 1
        for (int t = 0; t < nt; t += 2) {
            const bool last = (t == nt - 2);
            const char* a1 = cA + (size_t)(t + 1) * kstep;
            const char* a2 = last ? nA : cA + (size_t)(t + 2) * kstep; const char* b2 = last ? nB : cB + (size_t)(t + 2) * kstep;
            const char* a3 = a2 + kstep; const char* b3 = b2 + kstep;
            unsigned v2[2][2];
#pragma unroll
            for (int h = 0; h < 2; ++h)
#pragma unroll
                for (int i = 0; i < 2; ++i) v2[h][i] = last ? vaN[h][i] : vaC[h][i];
            if constexpr (Epi::HAS_BIAS) { if (last) __builtin_amdgcn_global_load_lds((const unsigned*)E.bias_src(cur, lane), (LAS unsigned*)(lds + (BIAS_OFF - RING_OFF)), 16, 0, 0); }
            if constexpr (Epi::MIDSCALE) {
                if (t == 0) __builtin_amdgcn_global_load_lds((const unsigned*)E.scale_src(cur, lane), (LAS unsigned*)(lds + (BIAS_OFF - RING_OFF)), 16, 0, 0);
                if (t == nt / 2) {
                    const LAS float* sc_ = (const LAS float*)(lds + (BIAS_OFF - RING_OFF)) + wr * 64 + fr;
#pragma unroll
                    for (int a_ = 0; a_ < 2; ++a_)
#pragma unroll
                        for (int m_ = 0; m_ < 4; ++m_) { const float f_ = sc_[a_ * HALF + m_ * 16];
#pragma unroll
                            for (int b_ = 0; b_ < 2; ++b_)
#pragma unroll
                                for (int n_ = 0; n_ < 2; ++n_) acc[a_][b_][m_][n_] *= f_; }
                }
            }
#ifdef KREP
            const bool stq = (Epi::NST > 0) && (t == 0) && (ui > 0) && (krep_ == 0);
#else
            const bool stq = (Epi::NST > 0) && (t == 0) && (ui > 0);
#endif
#if SCHED44
            const char* b1h = cB + hstepB + (size_t)(t + 1) * kstep;
            PG8_LDB(B0, 0, 0); PG8_LDB(B1, 0, 1); PG8_SCHED; PG8_LDA(At, 0, 0); PG8_STAGE(PG8_SB(1, 1), b1h, voffB); PG8_STAGE(PG8_SA(1, 1), a1, vaC[1]);
            if (stq) PG8_WAIT_VN(8 + Epi::NST); else PG8_WAIT_V(8);
            PG8_WAIT_L(0); PG8_BAR; PG8_MMA(0, 0, At, B0); PG8_MMA(0, 1, At, B1); PG8_BAR; PG8_SCHED;
            PG8_LDA(At, 0, 1); PG8_STAGE(PG8_SB(0, 0), b2, voffB); PG8_STAGE(PG8_SA(0, 0), a2, v2[0]);
            PG8_WAIT_V(6); PG8_WAIT_L(0); PG8_BAR; PG8_MMA(1, 0, At, B0); PG8_MMA(1, 1, At, B1); PG8_BAR; PG8_SCHED;
            PG8_LDB(B0, 1, 0); PG8_LDB(B1, 1, 1); PG8_SCHED; PG8_LDA(At, 1, 0); PG8_STAGE(PG8_SB(0, 1), b2 + hstepB, voffB); PG8_STAGE(PG8_SA(0, 1), a2, v2[1]);
            PG8_WAIT_V(8); PG8_WAIT_L(0); PG8_BAR; PG8_MMA(0, 0, At, B0); PG8_MMA(0, 1, At, B1); PG8_BAR; PG8_SCHED;
            PG8_LDA(At, 1, 1); PG8_STAGE(PG8_SB(1, 0), b3, voffB); PG8_STAGE(PG8_SA(1, 0), a3, v2[0]);
            PG8_WAIT_V(6); PG8_WAIT_L(0); PG8_BAR; PG8_MMA(1, 0, At, B0); PG8_MMA(1, 1, At, B1); PG8_BAR; PG8_SCHED;
#else
            PG8_LDB(B0, 0, 0); PG8_LDB(B1, 0, 1); PG8_SCHED; PG8_LDA(At, 0, 0); PG8_STAGE(PG8_SA(1, 1), a1, vaC[1]);
            if (stq) PG8_WAIT_VN(8 + Epi::NST); else PG8_WAIT_V(8);
            PG8_WAIT_L(0); PG8_BAR; PG8_MMA(0, 0, At, B0); PG8_MMA(0, 1, At, B1); PG8_BAR; PG8_SCHED;
            PG8_LDA(At, 0, 1); PG8_STAGE(PG8_SB(0, 0), b2, voffB); PG8_STAGE(PG8_SB(0, 1), b2 + hstepB, voffB); PG8_STAGE(PG8_SA(0, 0), a2, v2[0]);
            if (stq) PG8_WAIT_VN(8 + Epi::NST); else PG8_WAIT_V(8);
            PG8_WAIT_L(0); PG8_BAR; PG8_MMA(1, 0, At, B0); PG8_MMA(1, 1, At, B1); PG8_BAR; PG8_SCHED;
            PG8_LDB(B0, 1, 0); PG8_LDB(B1, 1, 1); PG8_SCHED; PG8_LDA(At, 1, 0); PG8_STAGE(PG8_SA(0, 1), a2, v2[1]);
            PG8_WAIT_V(8); PG8_WAIT_L(0); PG8_BAR; PG8_MMA(0, 0, At, B0); PG8_MMA(0, 1, At, B1); PG8_BAR; PG8_SCHED;
            PG8_LDA(At, 1, 1); PG8_STAGE(PG8_SB(1, 0), b3, voffB); PG8_STAGE(PG8_SB(1, 1), b3 + hstepB, voffB); PG8_STAGE(PG8_SA(1, 0), a3, v2[0]);
            PG8_WAIT_V(8); PG8_WAIT_L(0); PG8_BAR; PG8_MMA(1, 0, At, B0); PG8_MMA(1, 1, At, B1); PG8_BAR; PG8_SCHED;
#endif
        }
#ifdef KREP
        if (krep_ == 0) { krep_ = 1;
            _Pragma("unroll") for (int a = 0; a < 2; ++a) _Pragma("unroll") for (int b = 0; b < 2; ++b) _Pragma("unroll") for (int m = 0; m < 4; ++m) _Pragma("unroll") for (int n = 0; n < 2; ++n) acc[a][b][m][n] = (f32x4){0.f, 0.f, 0.f, 0.f};
            continue; }
        krep_ = 0; has_next = real_next_;
#endif
        if constexpr (ALIGN_EPI) { if (wr == 0) PG8_BAR; }
        if constexpr (F8) asm volatile("s_nop 15\n\ts_nop 15" ::: "memory");
        E(acc, cur, wr, wc, fr, fq, lds + PG8_SA(1, 1) + ldsw);
#ifdef EPI_TWICE
        asm volatile("" ::: "memory"); E(acc, cur, wr, wc, fr, fq, lds + PG8_SA(1, 1) + ldsw);
#endif
#ifdef EPI_DUMMY
        { asm volatile("" ::: "memory"); unsigned char* dp = S.dummy + ((size_t)(blockIdx.x * 8 + wid) * 16) * 1024 + lane * 16;
          const u32x4 w_ = __builtin_bit_cast(u32x4, acc[0][0][0][0]);
          _Pragma("unroll") for (int q_ = 0; q_ < 16; ++q_) { *(volatile u32x4*)(dp + q_ * 1024) = w_; } }
#endif
        if (!has_next) break;
#pragma unroll
        for (int a = 0; a < 2; ++a)
#pragma unroll
            for (int b = 0; b < 2; ++b)
#pragma unroll
                for (int m = 0; m < 4; ++m)
#pragma unroll
                    for (int n = 0; n < 2; ++n) acc[a][b][m][n] = (f32x4){0.f, 0.f, 0.f, 0.f};
        cur = nxt; cA = nA; cB = nB; ++ui;
#pragma unroll
        for (int h = 0; h < 2; ++h)
#pragma unroll
            for (int i = 0; i < 2; ++i) vaC[h][i] = vaN[h][i];
        if constexpr (ALIGN_EPI) { if (wr == 1) PG8_BAR; }
    }
    PG8_WAIT_V(0);
    if constexpr (!ALIGN_EPI) { if (wr == 0) PG8_BAR; }
    PG8_BAR;
#undef PG8_SA
#undef PG8_SB
#undef PG8_STAGE
#undef PG8_LDA
#undef PG8_LDB
#undef PG8_MMA
#undef PG8_WAIT_V
#undef PG8_WAIT_L
#undef PG8_WAIT_VN
#undef PG8_BAR
#undef PG8_SCHED
}
}

#define XB_TMO      128
#define XB_XCNT(j)  (256  + 64 * (j))
#define XB_XSUB(j)  (1280 + 64 * (j))
#define XB_XGEN(j)  (2304 + 64 * (j))
#define XB_TOP      3328
#define XB_TOPGEN   3392
#define XCD_BAR_WORDS 3456
#define XB_SPIN_CAP (1u << 18)
__device__ __forceinline__ unsigned xb_ld(unsigned* p)              { return __hip_atomic_load(p, __ATOMIC_RELAXED, __HIP_MEMORY_SCOPE_AGENT); }
__device__ __forceinline__ unsigned xb_add(unsigned* p, unsigned v) { return __hip_atomic_fetch_add(p, v, __ATOMIC_RELAXED, __HIP_MEMORY_SCOPE_AGENT); }
__device__ __forceinline__ unsigned xb_xcc_id() { return (unsigned)__builtin_amdgcn_s_getreg((3 << 11) | 20) & 0xFu; }
#define XB_SPIN(cond, bar) do { unsigned _sp = 0; while (cond) { __builtin_amdgcn_s_sleep(1); \
    if ((++_sp & 255u) == 0u) { if (xb_ld(&(bar)[XB_TMO])) break; if (_sp > XB_SPIN_CAP) { atomicAdd(&(bar)[XB_TMO], 1u); break; } } } } while (0)
struct XcdBarrier { unsigned* bar; unsigned x; volatile LAS unsigned* st; int wave; };
__device__ __forceinline__ XcdBarrier xcd_barrier_post(unsigned* bar, volatile LAS unsigned* st, int wave) {
    XcdBarrier b; b.bar = bar; b.x = xb_xcc_id(); b.st = st; b.wave = wave;
    if (tid_of(wave) == 0) (void)xb_add(&bar[XB_XCNT(b.x)], 1u);
    return b;
}
__device__ __forceinline__ void xcd_barrier_complete(unsigned* bar, unsigned x, unsigned& nloc, unsigned& nx) {
    const unsigned G = gridDim.x * gridDim.y * gridDim.z;
    unsigned sum, cnt, mine, sp = 0u;
    for (;;) {
        sum = 0u; cnt = 0u; mine = 0u;
#pragma unroll
        for (unsigned j = 0; j < 16; ++j) { const unsigned c = xb_ld(&bar[XB_XCNT(j)]); sum += c; cnt += (c > 0u) ? 1u : 0u; mine = (j == x) ? c : mine; }
        if (sum == G) break;
        __builtin_amdgcn_s_sleep(1);
        if ((++sp & 255u) == 0u) { if (xb_ld(&bar[XB_TMO])) break; if (sp > XB_SPIN_CAP) { atomicAdd(&bar[XB_TMO], 1u); break; } }
    }
    nloc = mine > 0u ? mine : 1u; nx = cnt > 0u ? cnt : 1u;
}
__device__ __forceinline__ void xcd_barrier(const XcdBarrier& b) {
    asm volatile("s_waitcnt vmcnt(0)" ::: "memory");
    __syncthreads();
    if (tid_of(b.wave) == 0) {
        unsigned* bar = b.bar;
        __builtin_amdgcn_s_waitcnt(0);
        unsigned nloc = b.st[0], nx = b.st[1];
        if (nloc == 0u) { xcd_barrier_complete(bar, b.x, nloc, nx); b.st[0] = nloc; b.st[1] = nx; }
        const unsigned old = xb_add(&bar[XB_XSUB(b.x)], 1u);
        const unsigned gen = old / nloc;
        if (old + 1u == (gen + 1u) * nloc) {
            __builtin_amdgcn_fence(__ATOMIC_RELEASE, "agent");
            asm volatile("s_waitcnt vmcnt(0)" ::: "memory");
            const unsigned og = xb_add(&bar[XB_TOP], 1u);
            const unsigned tg = og / nx;
            if (og + 1u == (tg + 1u) * nx) xb_add(&bar[XB_TOPGEN], 1u);
            else XB_SPIN(xb_ld(&bar[XB_TOPGEN]) == tg, bar);
            __builtin_amdgcn_fence(__ATOMIC_ACQUIRE, "agent");
            xb_add(&bar[XB_XGEN(b.x)], 1u);
            asm volatile("s_waitcnt vmcnt(0)" ::: "memory");
        } else {
            XB_SPIN(xb_ld(&bar[XB_XGEN(b.x)]) == gen, bar);
            __builtin_amdgcn_fence(__ATOMIC_ACQUIRE, "agent");
            asm volatile("s_waitcnt vmcnt(0)" ::: "memory");
        }
    }
    __syncthreads();
}

struct MkArgs {
    const float *x, *g_mix, *w_in, *conv_w, *sinks, *g_ao, *g_co, *w_out, *g_ffn, *w_router, *b_router, *w1, *b1, *w2, *b2, *g_final;
    float* out; unsigned char* ws; int ph_lo, ph_hi;
};
struct Frame {
    LAS unsigned char* lds; int tid, lane, wave, G, bx;
};

__device__ __forceinline__ void phase_stagger(const Frame& F, int nwg, unsigned half_unit_ticks) {
    const int rem = nwg % F.G;
    if (rem != 0 && F.bx >= rem && half_unit_ticks != 0u) {
        const unsigned long long t0 = __builtin_amdgcn_s_memrealtime();
        while (__builtin_amdgcn_s_memrealtime() - t0 < (unsigned long long)half_unit_ticks) __builtin_amdgcn_s_sleep(32);
    }
    __syncthreads();
}
__device__ __forceinline__ int win_srccol(int n) {
    if (n < 1280) return n;
    const int t = (n - 1280) >> 8, c = (n - 1280) & 255, g16 = c >> 4, w = c & 15, bj = w >> 3, k8 = w & 7;
    return (bj ? 1792 : 1280) + t * 128 + g16 * 8 + k8;
}
__device__ __forceinline__ void p0_transpose_item(const float* W, int K, int N, bf16_t* WT, const float* g0, const float* g1, int split, LAS unsigned char* scr, int item, int lane, bool cperm = false) {
    const int nblk = N / 64, kb = item / nblk, nb = item % nblk, k0 = 64 * kb, n = cperm ? win_srccol(64 * nb + lane) : 64 * nb + lane;
    const float* src = W + (size_t)k0 * N + n;
    float v[64];
#pragma unroll
    for (int i = 0; i < 64; ++i) v[i] = __builtin_nontemporal_load(src + (size_t)i * N);
#pragma unroll
    for (int q = 0; q < 8; ++q) {
        float w[8];
#pragma unroll
        for (int i = 0; i < 8; ++i) { const int k = k0 + 8 * q + i; const float gg = g0 ? (k < split ? g0[k] : g1[k - split]) : 1.f; w[i] = v[8 * q + i] * gg; }
        u32x4 o; o.x = cvtpk(w[0], w[1]); o.y = cvtpk(w[2], w[3]); o.z = cvtpk(w[4], w[5]); o.w = cvtpk(w[6], w[7]);
        *(LAS u32x4*)(scr + lane * 128 + ((q ^ (lane & 7)) * 16)) = o;
    }
    LDS_WAIT(); asm volatile("" ::: "memory");
#pragma unroll
    for (int j = 0; j < 8; ++j) {
        const int nl = 8 * j + (lane >> 3), ch = lane & 7;
        const u32x4 o = *(const LAS u32x4*)(scr + nl * 128 + ((ch ^ (nl & 7)) * 16));
        *(u32x4*)(WT + (size_t)(64 * nb + nl) * K + k0 + 8 * ch) = o;
    }
    LDS_WAIT(); asm volatile("" ::: "memory");
}
__device__ __forceinline__ void p0_transpose_item8(const float* W, int K, int N, unsigned char* WT, const float* g0, LAS unsigned char* scr, int item, int lane) {
    const int nblk = N / 64, kb = item / nblk, nb = item % nblk, k0 = 128 * kb, n = 64 * nb + lane;
    const float* src = W + (size_t)k0 * N + n;
    float v[128];
#pragma unroll
    for (int i = 0; i < 128; ++i) v[i] = __builtin_nontemporal_load(src + (size_t)i * N);
    constexpr float SC = (float)(1 << W8_SHIFT);
#pragma unroll
    for (int q = 0; q < 8; ++q) {
        float w[16];
#pragma unroll
        for (int i = 0; i < 16; ++i) { const int k = k0 + 16 * q + i; const float gg = g0 ? g0[k] * SC : SC; w[i] = v[16 * q + i] * gg; }
        u32x4 o; o.x = pg8::pack4_fp8(w[0], w[1], w[2], w[3]); o.y = pg8::pack4_fp8(w[4], w[5], w[6], w[7]); o.z = pg8::pack4_fp8(w[8], w[9], w[10], w[11]); o.w = pg8::pack4_fp8(w[12], w[13], w[14], w[15]);
        *(LAS u32x4*)(scr + lane * 128 + ((q ^ (lane & 7)) * 16)) = o;
    }
    LDS_WAIT(); asm volatile("" ::: "memory");
#pragma unroll
    for (int j = 0; j < 8; ++j) {
        const int nl = 8 * j + (lane >> 3), ch = lane & 7;
        const u32x4 o = *(const LAS u32x4*)(scr + nl * 128 + ((ch ^ (nl & 7)) * 16));
        __builtin_nontemporal_store(o, (u32x4*)(WT + (size_t)(64 * nb + nl) * K + k0 + 16 * ch));
    }
    LDS_WAIT(); asm volatile("" ::: "memory");
}
__device__ __forceinline__ void p0_prologue(const Frame& F, const MkArgs& a, int item_lo, int item_hi, int gw, int NGW, bool rows) {
    unsigned char* ws = a.ws;
    bf16_t* Win_t = (bf16_t*)(ws + WS_WIN); bf16_t* Wout_t = (bf16_t*)(ws + WS_WOUT); float* WR = (float*)(ws + WS_WR);
    bf16_t* W1_t = (bf16_t*)(ws + WS_W1); bf16_t* W2_t = (bf16_t*)(ws + WS_W2); bf16_t* XN = (bf16_t*)(ws + WS_XN);
    LAS unsigned char* scr = F.lds + RING_OFF + F.wave * 8192;
    constexpr int I_IN = (DM / 64) * (INC / 64), I_OUT = (DM / 64) * (DM / 64), I_W1E = (DM / (MOE_FP8 ? 128 : 64)) * (2048 / 64), I_W2E = (DFF / (MOE_FP8 ? 128 : 64)) * (DM / 64);
    constexpr int NITEMS = I_IN + I_OUT + NE * I_W1E + NE * I_W2E;
    if (item_hi > NITEMS) item_hi = NITEMS;
    for (int it = item_lo + gw; it < item_hi; it += NGW) {
        int r = it;
        if (r < I_IN) { p0_transpose_item(a.w_in, DM, INC, Win_t, a.g_mix, a.g_mix, DM, scr, r, F.lane, true); continue; } r -= I_IN;
        if (r < I_OUT) { p0_transpose_item(a.w_out, DM, DM, Wout_t, a.g_ao, a.g_co, 512, scr, r, F.lane); continue; } r -= I_OUT;
#if MOE_FP8
        if (r < NE * I_W1E) { const int e = r / I_W1E; p0_transpose_item8(a.w1 + (size_t)e * DM * 2048, DM, 2048, (unsigned char*)W1_t + (size_t)e * 2048 * DM, a.g_ffn, scr, r % I_W1E, F.lane); continue; } r -= NE * I_W1E;
        { const int e = r / I_W2E; p0_transpose_item8(a.w2 + (size_t)e * DFF * DM, DFF, DM, (unsigned char*)W2_t + (size_t)e * DM * DFF, nullptr, scr, r % I_W2E, F.lane); }
#else
        if (r < NE * I_W1E) { const int e = r / I_W1E; p0_transpose_item(a.w1 + (size_t)e * DM * 2048, DM, 2048, W1_t + (size_t)e * 2048 * DM, a.g_ffn, a.g_ffn, DM, scr, r % I_W1E, F.lane); continue; } r -= NE * I_W1E;
        { const int e = r / I_W2E; p0_transpose_item(a.w2 + (size_t)e * DFF * DM, DFF, DM, W2_t + (size_t)e * DM * DFF, nullptr, nullptr, 0, scr, r % I_W2E, F.lane); }
#endif
    }
    if (!rows) return;
    for (int i = (F.bx * NTHREADS + F.tid); i < DM * NE; i += F.G * NTHREADS) WR[i] = a.w_router[i] * a.g_ffn[i >> 5];
    for (int m0 = 8 * gw; m0 < NTOK; m0 += 8 * NGW) {
        f32x4 v[8][4];
#pragma unroll
        for (int r = 0; r < 8; ++r) { const f32x4* xr = (const f32x4*)(a.x + (size_t)(m0 + r) * DM) + F.lane;
#pragma unroll
            for (int j = 0; j < 4; ++j) v[r][j] = __builtin_nontemporal_load(xr + 64 * j); }
#pragma unroll
        for (int r = 0; r < 8; ++r) {
            float s2 = 0.f;
#pragma unroll
            for (int j = 0; j < 4; ++j) s2 += (v[r][j].x * v[r][j].x + v[r][j].y * v[r][j].y) + (v[r][j].z * v[r][j].z + v[r][j].w * v[r][j].w);
            const float rstd = rsqrtf(wave_sum(s2) * (1.f / DM) + EPS);
            u32x2* o8 = (u32x2*)(XN + (size_t)(m0 + r) * DM) + F.lane;
#pragma unroll
            for (int j = 0; j < 4; ++j) { u32x2 w; w.x = cvtpk(v[r][j].x * rstd, v[r][j].y * rstd); w.y = cvtpk(v[r][j].z * rstd, v[r][j].w * rstd); o8[64 * j] = w; }
        }
    }
}

constexpr int A_KOFF = 0, A_VOFF = 32768, A_HK = 65536, A_WSF = 131072, A_OST = A_WSF + 2048, A_SSQ = A_OST + 16384;
static_assert(A_SSQ + 1024 <= MISC_OFF, "P2 LDS map");
__device__ __forceinline__ int crow(int r, int hi) { return (r & 3) + 8 * (r >> 2) + 4 * hi; }
typedef short v4i16_t __attribute__((ext_vector_type(4)));
__device__ __forceinline__ s16x4 vtr(const LAS unsigned char* p) { return __builtin_bit_cast(s16x4, __builtin_amdgcn_ds_read_tr16_b64_v4i16((LAS v4i16_t*)p)); }

__device__ __forceinline__ void attn_core(const Frame& F, bf16x8 (&qr)[4], const bf16_t* qnext, int nb, int hk, int qt, float slope2, float sink2, f32x16 (&o)[2], float& l_out) {
    LAS unsigned char* L = F.lds;
    const int lane = F.lane, r32 = lane & 31, hi = lane >> 5;
    f32x16 p[5];
    const LAS unsigned char* kb = L + hk * A_HK + A_KOFF + hi * 4096 + r32 * 16 + qt * 512;
#pragma unroll
    for (int j = 0; j < 5; ++j) {
#pragma unroll
        for (int r = 0; r < 16; ++r) p[j][r] = 0.f;
#pragma unroll
        for (int d0 = 0; d0 < 4; ++d0) { const bf16x8 kf = *(const LAS bf16x8*)(kb + d0 * 8192 + j * 512); p[j] = __builtin_amdgcn_mfma_f32_32x32x16_bf16(kf, qr[d0], p[j], 0, 0, 0); }
        __builtin_amdgcn_sched_barrier(0);
    }
#pragma unroll
    for (int d0 = 0; d0 < 4; ++d0) qr[d0] = *(const bf16x8*)(qnext + d0 * 16);
    __builtin_amdgcn_sched_barrier(0);
    int dl = r32 - 4 * hi; asm volatile("" : "+v"(dl));
    const float basef = slope2 * (float)dl;
    float mx = sink2;
#pragma unroll
    for (int j = 0; j < 5; ++j) {
        const bool dead = (nb == 0) && (qt + j < 4);
#pragma unroll
        for (int r = 0; r < 16; ++r) {
            const int cc = (r & 3) + 8 * (r >> 2);
            bool ok = (j == 0) ? (dl < cc) : ((j == 4) ? (cc <= dl) : true);
            ok = ok && !dead;
            const float v = ok ? ((p[j][r] - basef) - slope2 * (float)(128 - 32 * j - cc)) : -INFINITY;
            p[j][r] = v; mx = fmaxf(mx, v);
        }
    }
    mx = fmaxf(mx, __shfl_xor(mx, 32));
    float sum = 0.f;
    u32x4 pk[5][2];
#pragma unroll
    for (int j = 0; j < 5; ++j) {
#pragma unroll
        for (int s = 0; s < 2; ++s) {
            float e[8];
#pragma unroll
            for (int i = 0; i < 8; ++i) { e[i] = __builtin_amdgcn_exp2f(p[j][8 * s + i] - mx); sum += e[i]; }
            pk[j][s].x = cvtpk(e[0], e[1]); pk[j][s].y = cvtpk(e[2], e[3]); pk[j][s].z = cvtpk(e[4], e[5]); pk[j][s].w = cvtpk(e[6], e[7]);
        }
        __builtin_amdgcn_sched_barrier(0);
    }
    sum += __shfl_xor(sum, 32);
    const float l = sum + __builtin_amdgcn_exp2f(sink2 - mx);
#pragma unroll
    for (int r = 0; r < 16; ++r) { o[0][r] = 0.f; o[1][r] = 0.f; }
    const LAS unsigned char* vb = L + hk * A_HK + A_VOFF + ((lane >> 4) & 1) * 32 + (lane & 3) * 8 + (4 * hi + ((lane & 15) >> 2)) * 64 + qt * 2048;
#pragma unroll
    for (int j = 0; j < 5; ++j)
#pragma unroll
        for (int s = 0; s < 2; ++s) {
            const bf16x8 pa = __builtin_bit_cast(bf16x8, pk[j][s]);
#pragma unroll
            for (int d0 = 0; d0 < 2; ++d0) {
                const LAS unsigned char* ap = vb + d0 * 16384 + (2 * j + s) * 1024;
                const s16x4 lo = vtr(ap), hh = vtr(ap + 512);
                const bf16x8 vf = (bf16x8){lo[0], lo[1], lo[2], lo[3], hh[0], hh[1], hh[2], hh[3]};
                o[d0] = __builtin_amdgcn_mfma_f32_32x32x16_bf16(pa, vf, o[d0], 0, 0, 0);
            }
            if (s == 1) __builtin_amdgcn_sched_barrier(0);
        }
    l_out = l;
}
__device__ __forceinline__ void attn_store(const Frame& F, const f32x16 (&o)[2], float l, bf16_t* MIX, int row0, int h, int qt, float (&sq)[4]) {
    LAS unsigned char* L = F.lds;
    const int lane = F.lane, r32 = lane & 31, hi = lane >> 5;
    LAS float* wsf = (LAS float*)(L + A_WSF) + F.wave * 64;
    if (hi == 0) wsf[r32] = l;
    LDS_WAIT();
    LAS bf16_t* stg = (LAS bf16_t*)(L + A_OST) + F.wave * 1024;
#pragma unroll
    for (int R = 0; R < 2; ++R) {
#pragma unroll
        for (int rr = 0; rr < 8; ++rr) { const int r = 8 * R + rr, c = crow(r, hi); const float rl = __builtin_amdgcn_rcpf(wsf[c]); const int cl = (rr & 3) + 8 * (rr >> 2) + 4 * hi;
            stg[cl * 64 + r32] = f2bf(o[0][r] * rl); stg[cl * 64 + 32 + r32] = f2bf(o[1][r] * rl); }
        LDS_WAIT();
#pragma unroll
        for (int i = 0; i < 2; ++i) {
            const int row = i * 8 + (lane >> 3), ch = lane & 7;
            const u32x4 v = *(const LAS u32x4*)(stg + row * 64 + ch * 8);
            *(u32x4*)(MIX + (size_t)(row0 + qt * 32 + 16 * R + row) * DM + h * 64 + ch * 8) = v;
            float s2 = 0.f;
#pragma unroll
            for (int q = 0; q < 4; ++q) { const float a = __uint_as_float(v[q] << 16), b = __uint_as_float(v[q] & 0xffff0000u); s2 += a * a + b * b; }
            s2 += __shfl_xor(s2, 1); s2 += __shfl_xor(s2, 2); s2 += __shfl_xor(s2, 4);
            sq[2 * R + i] += s2;
        }
        LDS_WAIT();
    }
}

struct ConvRegs { u32x4 uu[4], bb[4]; };
struct ConvHalo { u32x4 uu[2]; f32x4 w[3][2]; };
__device__ __forceinline__ void conv_issue(ConvRegs& R, const bf16_t* P, int row0, int rl0, int lane) {
    const int c0 = lane * 8;
    const bf16_t* pr = P + (size_t)(row0 + rl0) * INCP;
#pragma unroll
    for (int i = 0; i < 4; ++i) { const bf16_t* q = pr + (size_t)i * INCP;
        R.bb[i] = __builtin_nontemporal_load((const u32x4*)(q + 768 + c0));
        if (i < 2) R.uu[i] = __builtin_nontemporal_load((const u32x4*)(q + 1280 + c0));
        else R.uu[i] = *(const u32x4*)(q + 1280 + c0); }
}
__device__ __forceinline__ void conv_halo(ConvHalo& H, const MkArgs& a, const bf16_t* P, int row0, int nb, int rl0, int lane) {
    const int c0 = lane * 8;
    const float* cwp = a.conv_w; asm volatile("" : "+s"(cwp));
    const bf16_t* pr = P + (size_t)(row0 + rl0 - 2) * INCP;
    const bool halo = (nb > 0) || (rl0 > 0);
#pragma unroll
    for (int i = 0; i < 2; ++i) { H.uu[i] = (u32x4){0u, 0u, 0u, 0u};
        if (halo) H.uu[i] = *(const u32x4*)(pr + (size_t)i * INCP + 1280 + c0); }
#pragma unroll
    for (int d = 0; d < 3; ++d) { H.w[d][0] = *(const f32x4*)(cwp + d * CONVW + c0); H.w[d][1] = *(const f32x4*)(cwp + d * CONVW + c0 + 4); }
}
__device__ __forceinline__ void conv_finish(const ConvRegs& R, const ConvHalo& H, bf16_t* MIX, int row0, int rl0, int lane) {
    const int c0 = lane * 8;
    float cw[3][8];
#pragma unroll
    for (int d = 0; d < 3; ++d) { const f32x4 w0 = H.w[d][0], w1 = H.w[d][1];
        cw[d][0] = w0.x; cw[d][1] = w0.y; cw[d][2] = w0.z; cw[d][3] = w0.w; cw[d][4] = w1.x; cw[d][5] = w1.y; cw[d][6] = w1.z; cw[d][7] = w1.w; }
    float u2[8], u1[8];
#pragma unroll
    for (int q = 0; q < 4; ++q) { u2[2 * q] = __uint_as_float(H.uu[0][q] << 16); u2[2 * q + 1] = __uint_as_float(H.uu[0][q] & 0xffff0000u);
        u1[2 * q] = __uint_as_float(H.uu[1][q] << 16); u1[2 * q + 1] = __uint_as_float(H.uu[1][q] & 0xffff0000u); }
#pragma unroll
    for (int r = 0; r < 4; ++r) {
        float y[8], u0[8], s2 = 0.f;
#pragma unroll
        for (int q = 0; q < 4; ++q) {
            u0[2 * q] = __uint_as_float(R.uu[r][q] << 16); u0[2 * q + 1] = __uint_as_float(R.uu[r][q] & 0xffff0000u);
            y[2 * q] = __uint_as_float(R.bb[r][q] << 16) * (cw[0][2 * q] * u2[2 * q] + cw[1][2 * q] * u1[2 * q] + cw[2][2 * q] * u0[2 * q]);
            y[2 * q + 1] = __uint_as_float(R.bb[r][q] & 0xffff0000u) * (cw[0][2 * q + 1] * u2[2 * q + 1] + cw[1][2 * q + 1] * u1[2 * q + 1] + cw[2][2 * q + 1] * u0[2 * q + 1]);
            s2 += y[2 * q] * y[2 * q] + y[2 * q + 1] * y[2 * q + 1];
        }
        const float rc = rsqrtf(wave_sum(s2) * (1.f / CONVW) + EPS);
        u32x4 w; w.x = cvtpk(y[0] * rc, y[1] * rc); w.y = cvtpk(y[2] * rc, y[3] * rc); w.z = cvtpk(y[4] * rc, y[5] * rc); w.w = cvtpk(y[6] * rc, y[7] * rc);
        *(u32x4*)(MIX + (size_t)(row0 + rl0 + r) * DM + 512 + c0) = w;
#pragma unroll
        for (int q = 0; q < 8; ++q) { u2[q] = u1[q]; u1[q] = u0[q]; }
    }
}

__device__ __forceinline__ void p2_attn_conv(const Frame& F, const MkArgs& a) {
    const bf16_t* P = (const bf16_t*)(a.ws + WS_P); bf16_t* MIX = (bf16_t*)(a.ws + WS_MIX);
    LAS unsigned char* L = F.lds;
    const int wave = F.wave;
    for (int unit = F.bx; unit < NTOK / 128; unit += F.G) {
        const int tid = tid_of(wave);
        const int lane = tid & 63;
        Frame Fl = F; Fl.tid = tid; Fl.lane = lane;
        const int b = unit >> 7, nb = unit & 127, row0 = b * SEQ + nb * 128;
        __syncthreads();
#pragma unroll
        for (int i = 0; i < 8; ++i) {
            const int idx = tid + 512 * i, hk = idx >> 11, key = (idx >> 3) & 255, ch = idx & 7;
            u32x4 kv = (u32x4){0u, 0u, 0u, 0u}, vv = (u32x4){0u, 0u, 0u, 0u};
            if (nb > 0 || key >= 128) { const bf16_t* src = P + (size_t)(row0 - 128 + key) * INCP + 512 + hk * 64 + ch * 8; kv = *(const u32x4*)src; vv = *(const u32x4*)(src + 128); }
            *(LAS u32x4*)(L + hk * A_HK + A_KOFF + ch * 4096 + key * 16) = kv;
            *(LAS u32x4*)(L + hk * A_HK + A_VOFF + (ch >> 2) * 16384 + (key >> 4) * 1024 + (key & 15) * 64 + (ch & 3) * 16) = vv;
        }
        __syncthreads();
        {
            const int qt = wave & 3, gw = wave >> 2, r32 = lane & 31, hi = lane >> 5;
            const bf16_t* Qp = P + (size_t)(row0 + qt * 32 + r32) * INCP + hi * 8;
            float sq[4] = {0.f, 0.f, 0.f, 0.f};
            bf16x8 qc[4];
#pragma unroll
            for (int d0 = 0; d0 < 4; ++d0) qc[d0] = *(const bf16x8*)(Qp + gw * 64 + d0 * 16);
            ConvRegs CR;
            conv_issue(CR, P, row0, wave * 16, lane);
#pragma unroll 1
            for (int s = 0; s < 4; ++s) {
                const int hk = s >> 1, g = gw + 2 * (s & 1), h = hk * 4 + g;
                const float slope2 = __builtin_amdgcn_exp2f(-(float)(h + 1)) * LOG2E, sink2 = a.sinks[h] * LOG2E;
                f32x16 o[2]; float l;
                const int sn = s < 3 ? s + 1 : 3, hn = (sn >> 1) * 4 + gw + 2 * (sn & 1);
                attn_core(Fl, qc, Qp + hn * 64, nb, hk, qt, slope2, sink2, o, l);
                __builtin_amdgcn_sched_barrier(0);
                ConvHalo CH; conv_halo(CH, a, P, row0, nb, wave * 16 + s * 4, lane);
                __builtin_amdgcn_sched_barrier(0);
                attn_store(Fl, o, l, MIX, row0, h, qt, sq);
                conv_finish(CR, CH, MIX, row0, wave * 16 + s * 4, lane);
                if (s < 3) conv_issue(CR, P, row0, wave * 16 + (s + 1) * 4, lane);
            }
            const int l2 = tid_of(wave) & 63;
            if ((l2 & 7) == 0) {
                LAS float* part = (LAS float*)(L + A_SSQ) + wave * 32 + (l2 >> 3);
#pragma unroll
                for (int i = 0; i < 4; ++i) part[i * 8] = sq[i];
            }
        }
        __syncthreads();
        if (tid < 128) { const LAS float* part = (const LAS float*)(L + A_SSQ); const int qt = tid >> 5, r = tid & 31;
            const float s = part[qt * 32 + r] + part[(qt + 4) * 32 + r];
            ((float*)(a.ws + WS_RSA))[row0 + tid] = rsqrtf(s * (1.f / ATTW) + EPS); }
    }
    __syncthreads();
}

constexpr int R_XT = 0, R_PITCH = 4112, R_PART = 32 * R_PITCH, R_RSTD = R_PART + 128 * 33 * 4, R_HIST = R_RSTD + 512, R_BASE = R_HIST + 128;
static_assert(R_BASE + 128 <= MISC_OFF, "P4 LDS map");
__device__ __forceinline__ void p4_router(const Frame& F, const MkArgs& a, bool dummy) {
    const float* X = a.x; const bf16_t* MO = (const bf16_t*)(a.ws + WS_MO); bf16_t* X1B = (bf16_t*)(a.ws + WS_X1B); const float* WR = (const float*)(a.ws + WS_WR); bf16_t* H2 = (bf16_t*)(a.ws + WS_XN);
    unsigned* gcnt = (unsigned*)(a.ws + WS_CTL) + CW_CNT + (dummy ? 64 : 0); int* list = (int*)(a.ws + (dummy ? WS_DUMMY : WS_LIST));
    int* TE = (int*)(a.ws + (dummy ? WS_DUMMY + 8 * MiB : WS_TE)); int* TP = (int*)(a.ws + (dummy ? WS_DUMMY + 9 * MiB : WS_TP)); float* TG = (float*)(a.ws + (dummy ? WS_DUMMY + 10 * MiB : WS_TG));
    LAS unsigned char* L = F.lds;
    LAS float* part = (LAS float*)(L + R_PART); LAS float* rsl = (LAS float*)(L + R_RSTD); LAS unsigned* hist = (LAS unsigned*)(L + R_HIST); LAS unsigned* gb = (LAS unsigned*)(L + R_BASE);
    const int tid = F.tid, lane = F.lane, wave = F.wave;
    float wreg[16][4];
    { const float* wrp = WR + (size_t)(128 * wave + 4 * (lane >> 5)) * NE + (lane & 31);
#pragma unroll
      for (int it = 0; it < 16; ++it)
#pragma unroll
          for (int e = 0; e < 4; ++e) wreg[it][e] = wrp[(8 * it + e) * NE]; }
    for (int chunk = F.bx; chunk < NTOK / 128; chunk += F.G) {
        const int rowbase = chunk * 128;
        __syncthreads();
        if (tid < 32) hist[tid] = 0u;
        f32x4 v[4][4]; u32x2 mo[4][4];
#define P4_LOADROWS(t_) do { _Pragma("unroll") for (int r = 0; r < 4; ++r) { const size_t row_ = (size_t)(rowbase + 32 * (t_) + wave * 4 + r); \
            const f32x4* xr_ = (const f32x4*)(X + row_ * DM) + lane; const u32x2* mr_ = (const u32x2*)(MO + row_ * DM) + lane; \
            _Pragma("unroll") for (int j = 0; j < 4; ++j) { v[r][j] = xr_[64 * j]; mo[r][j] = mr_[64 * j]; } } } while (0)
        P4_LOADROWS(0);
#pragma unroll 1
        for (int t = 0; t < 4; ++t) {
#pragma unroll
            for (int r = 0; r < 4; ++r) {
                const int rl = 32 * t + wave * 4 + r; float s2 = 0.f;
                u32x2* xb = (u32x2*)(X1B + (size_t)(rowbase + rl) * DM) + lane;
#pragma unroll
                for (int j = 0; j < 4; ++j) {
                    v[r][j].x += __uint_as_float(mo[r][j].x << 16); v[r][j].y += __uint_as_float(mo[r][j].x & 0xffff0000u); v[r][j].z += __uint_as_float(mo[r][j].y << 16); v[r][j].w += __uint_as_float(mo[r][j].y & 0xffff0000u);
                    u32x2 w; w.x = cvtpk(v[r][j].x, v[r][j].y); w.y = cvtpk(v[r][j].z, v[r][j].w); __builtin_nontemporal_store(w, xb + 64 * j);
                    s2 += (v[r][j].x * v[r][j].x + v[r][j].y * v[r][j].y) + (v[r][j].z * v[r][j].z + v[r][j].w * v[r][j].w); }
                const float rstd = rsqrtf(wave_sum(s2) * (1.f / DM) + EPS);
#if MOE_FP8
                unsigned* o4 = (unsigned*)((unsigned char*)H2 + (size_t)(rowbase + rl) * DM) + lane;
#pragma unroll
                for (int j = 0; j < 4; ++j) o4[64 * j] = pg8::pack4_fp8(v[r][j].x * rstd, v[r][j].y * rstd, v[r][j].z * rstd, v[r][j].w * rstd);
#else
                u32x2* o8 = (u32x2*)(H2 + (size_t)(rowbase + rl) * DM) + lane;
#pragma unroll
                for (int j = 0; j < 4; ++j) { u32x2 w; w.x = cvtpk(v[r][j].x * rstd, v[r][j].y * rstd); w.y = cvtpk(v[r][j].z * rstd, v[r][j].w * rstd); o8[64 * j] = w; }
#endif
                if (lane == 0) rsl[rl] = rstd;
            }
            __syncthreads();
#pragma unroll
            for (int r = 0; r < 4; ++r)
#pragma unroll
                for (int j = 0; j < 4; ++j) *(LAS f32x4*)(L + R_XT + (wave * 4 + r) * R_PITCH + (256 * j + 4 * lane) * 4) = v[r][j];
            __syncthreads();
            if (t < 3) P4_LOADROWS(t + 1);
            {
                const int i = lane & 31, h = lane >> 5;
                const LAS unsigned char* xp = L + R_XT + i * R_PITCH + (128 * wave + 4 * h) * 4;
                f32x16 acc;
#pragma unroll
                for (int r = 0; r < 16; ++r) acc[r] = 0.f;
#pragma unroll
                for (int it = 0; it < 16; ++it) {
                    const f32x4 xa = *(const LAS f32x4*)(xp + it * 32);
                    acc = __builtin_amdgcn_mfma_f32_32x32x2f32(xa.x, wreg[it][0], acc, 0, 0, 0); acc = __builtin_amdgcn_mfma_f32_32x32x2f32(xa.y, wreg[it][1], acc, 0, 0, 0);
                    acc = __builtin_amdgcn_mfma_f32_32x32x2f32(xa.z, wreg[it][2], acc, 0, 0, 0); acc = __builtin_amdgcn_mfma_f32_32x32x2f32(xa.w, wreg[it][3], acc, 0, 0, 0);
                }
                __syncthreads();
                LAS float* slot = (LAS float*)(L + R_XT) + wave * (32 * 33);
#pragma unroll
                for (int r = 0; r < 16; ++r) slot[crow(r, h) * 33 + (lane & 31)] = acc[r];
                __syncthreads();
#pragma unroll
                for (int q = 0; q < 2; ++q) { const int idx = tid + 512 * q, row = idx >> 5, ex = idx & 31; float sum = 0.f;
#pragma unroll
                    for (int w8 = 0; w8 < 8; ++w8) sum += ((const LAS float*)(L + R_XT))[w8 * (32 * 33) + row * 33 + ex];
                    part[(32 * t + row) * 33 + ex] = sum; }
            }
        }
#undef P4_LOADROWS
        __syncthreads();
        int ek[4] = {0, 0, 0, 0}; unsigned lp[4] = {0u, 0u, 0u, 0u}; float gk[4] = {0.f, 0.f, 0.f, 0.f};
        if (tid < 128) {
            float lg[32]; const float rstd = rsl[tid];
#pragma unroll
            for (int e = 0; e < 32; ++e) lg[e] = part[tid * 33 + e] * rstd + a.b_router[e];
            unsigned used = 0u; float val[4];
#pragma unroll
            for (int k = 0; k < 4; ++k) { float best = -INFINITY; int bi = 0;
#pragma unroll
                for (int j = 0; j < 32; ++j) { const bool take = !((used >> j) & 1u) && lg[j] > best; best = take ? lg[j] : best; bi = take ? j : bi; }
                used |= 1u << bi; ek[k] = bi; val[k] = best; }
            float es[4], sum = 0.f;
#pragma unroll
            for (int k = 0; k < 4; ++k) { es[k] = __expf(val[k] - val[0]); sum += es[k]; }
            const float inv = 1.f / sum;
#pragma unroll
            for (int k = 0; k < 4; ++k) { gk[k] = es[k] * inv; lp[k] = atomicAdd((unsigned*)&hist[ek[k]], 1u); }
        }
        __syncthreads();
        if (tid < 32) { const unsigned n = hist[tid]; gb[tid] = n ? atomicAdd(&gcnt[tid], n) : 0u; }
        __syncthreads();
        if (tid < 128) {
            const int tok = rowbase + tid;
#pragma unroll
            for (int k = 0; k < 4; ++k) { const unsigned pos = gb[ek[k]] + lp[k]; list[(size_t)ek[k] * NTOK + pos] = tok; TE[tok * 4 + k] = ek[k]; TP[tok * 4 + k] = (int)pos; TG[tok * 4 + k] = gk[k]; }
        }
    }
    __syncthreads();
}

__device__ __forceinline__ int moe_tables(const Frame& F, const MkArgs& a) {
    LAS int* cnt = (LAS int*)(F.lds + CNT_OFF); LAS int* ts = (LAS int*)(F.lds + TSTART_OFF); LAS int* te = (LAS int*)(F.lds + TILEE_OFF);
    const unsigned* gcnt = (const unsigned*)(a.ws + WS_CTL) + CW_CNT;
    __syncthreads();
    if (F.tid < 32) cnt[F.tid] = (int)__hip_atomic_load(gcnt + F.tid, RLX_AGENT);
    __syncthreads();
    if (F.tid == 0) { int s = 0; for (int e = 0; e < NE; ++e) { ts[e] = s; s += (cnt[e] + 255) >> 8; } ts[32] = s; }
    __syncthreads();
    const int total = ts[32];
    for (int t = F.tid; t < total && t < MAXTILES; t += NTHREADS) { int e = 0;
#pragma unroll 1
        for (int q = 1; q < NE; ++q) e += (ts[q] <= t) ? 1 : 0;
        te[t] = e; }
    __syncthreads();
    return total < MAXTILES ? total : MAXTILES;
}

__device__ __forceinline__ void p7_combine(const Frame& F, const MkArgs& a, bool dummy) {
    float* const dst = dummy ? (float*)(a.ws + WS_DUMMY) : a.out;
    const bf16_t* Y = (const bf16_t*)(a.ws + WS_Y); const int* TE = (const int*)(a.ws + WS_TE); const int* TP = (const int*)(a.ws + WS_TP); const float* TG = (const float*)(a.ws + WS_TG);
    LAS int* ts = (LAS int*)(F.lds + TSTART_OFF);
    const int gw = F.bx * NWAVES + F.wave, NGW = F.G * NWAVES, lane = F.lane, l7 = lane & 7;
    f32x4 gf[2][2];
#pragma unroll
    for (int j = 0; j < 2; ++j) { gf[j][0] = *(const f32x4*)(a.g_final + 512 * j + 8 * lane); gf[j][1] = *(const f32x4*)(a.g_final + 512 * j + 8 * lane + 4); }
    int t0 = 2 * gw;
    int e_c = 0, p_c = 0; float g_c = 0.f;
    if (t0 < NTOK) { e_c = TE[t0 * 4 + l7]; p_c = TP[t0 * 4 + l7]; g_c = TG[t0 * 4 + l7]; }
    for (; t0 < NTOK; t0 += 2 * NGW) {
        const int slot_l = 256 * ts[e_c & 31] + p_c; const float g_l = g_c;
        const int tn = t0 + 2 * NGW;
        if (tn < NTOK) { e_c = TE[tn * 4 + l7]; p_c = TP[tn * 4 + l7]; g_c = TG[tn * 4 + l7]; }
#if MOE_FP8
        f32x4 v[2][2][2]; u32x2 y[2][4][2]; float gk[2][4];
#else
        f32x4 v[2][2][2]; u32x4 y[2][4][2]; float gk[2][4];
#endif
#pragma unroll
        for (int tt = 0; tt < 2; ++tt) {
            const bf16_t* xr = (const bf16_t*)(a.ws + WS_X1B) + (size_t)(t0 + tt) * DM + 8 * lane;
#pragma unroll
            for (int j = 0; j < 2; ++j) { const u32x4 xb = *(const u32x4*)(xr + 512 * j);
                v[tt][j][0] = (f32x4){__uint_as_float(xb.x << 16), __uint_as_float(xb.x & 0xffff0000u), __uint_as_float(xb.y << 16), __uint_as_float(xb.y & 0xffff0000u)};
                v[tt][j][1] = (f32x4){__uint_as_float(xb.z << 16), __uint_as_float(xb.z & 0xffff0000u), __uint_as_float(xb.w << 16), __uint_as_float(xb.w & 0xffff0000u)}; }
#pragma unroll
            for (int k = 0; k < 4; ++k) {
                const int slot = __builtin_amdgcn_readlane(slot_l, tt * 4 + k);
                gk[tt][k] = __uint_as_float(__builtin_amdgcn_readlane(__float_as_uint(g_l), tt * 4 + k));
#if MOE_FP8
                const unsigned char* yr = (const unsigned char*)Y + (size_t)slot * DM + 8 * lane;
                y[tt][k][0] = *(const u32x2*)(yr); y[tt][k][1] = *(const u32x2*)(yr + 512);
#else
                const bf16_t* yr = Y + (size_t)slot * DM + 8 * lane;
                y[tt][k][0] = *(const u32x4*)(yr); y[tt][k][1] = *(const u32x4*)(yr + 512);
#endif
            }
        }
#pragma unroll
        for (int tt = 0; tt < 2; ++tt) {
#pragma unroll
            for (int k = 0; k < 4; ++k) { const float g = gk[tt][k];
#pragma unroll
#if MOE_FP8
                for (int j = 0; j < 2; ++j) { const u32x2 yy = y[tt][k][j];
                    const f32x2 a0 = __builtin_amdgcn_cvt_pk_f32_fp8((int)yy.x, false), a1 = __builtin_amdgcn_cvt_pk_f32_fp8((int)yy.x, true), a2 = __builtin_amdgcn_cvt_pk_f32_fp8((int)yy.y, false), a3 = __builtin_amdgcn_cvt_pk_f32_fp8((int)yy.y, true);
                    v[tt][j][0].x += g * a0.x; v[tt][j][0].y += g * a0.y; v[tt][j][0].z += g * a1.x; v[tt][j][0].w += g * a1.y;
                    v[tt][j][1].x += g * a2.x; v[tt][j][1].y += g * a2.y; v[tt][j][1].z += g * a3.x; v[tt][j][1].w += g * a3.y; } }
#else
                for (int j = 0; j < 2; ++j) { const u32x4 yy = y[tt][k][j];
                    v[tt][j][0].x += g * __uint_as_float(yy.x << 16); v[tt][j][0].y += g * __uint_as_float(yy.x & 0xffff0000u); v[tt][j][0].z += g * __uint_as_float(yy.y << 16); v[tt][j][0].w += g * __uint_as_float(yy.y & 0xffff0000u);
                    v[tt][j][1].x += g * __uint_as_float(yy.z << 16); v[tt][j][1].y += g * __uint_as_float(yy.z & 0xffff0000u); v[tt][j][1].z += g * __uint_as_float(yy.w << 16); v[tt][j][1].w += g * __uint_as_float(yy.w & 0xffff0000u); } }
#endif
            float s2 = 0.f;
#pragma unroll
            for (int j = 0; j < 2; ++j)
#pragma unroll
                for (int q = 0; q < 2; ++q) s2 += (v[tt][j][q].x * v[tt][j][q].x + v[tt][j][q].y * v[tt][j][q].y) + (v[tt][j][q].z * v[tt][j][q].z + v[tt][j][q].w * v[tt][j][q].w);
            const float rstd = rsqrtf(wave_sum(s2) * (1.f / DM) + EPS);
            float* xr = dst + (size_t)(t0 + tt) * DM + 8 * lane;
#pragma unroll
            for (int j = 0; j < 2; ++j)
#pragma unroll
                for (int q = 0; q < 2; ++q) *(f32x4*)(xr + 512 * j + 4 * q) = v[tt][j][q] * rstd * gf[j][q];
        }
    }
}

__global__ void __launch_bounds__(NTHREADS, 2) mk_fwd(MkArgs args) {
    extern __shared__ __attribute__((aligned(16))) unsigned char lds_raw[];
    Frame F;
    F.lds = (LAS unsigned char*)lds_raw;
    F.tid = threadIdx.x; F.lane = F.tid & 63; F.wave = __builtin_amdgcn_readfirstlane(F.tid >> 6); F.G = gridDim.x; F.bx = blockIdx.x;
    volatile LAS unsigned* MISC = (volatile LAS unsigned*)(F.lds + MISC_OFF);
    if (F.tid < 32) MISC[F.tid] = 0u;
    __syncthreads();
    const int lo = args.ph_lo, hi = args.ph_hi;
    unsigned* ctl = (unsigned*)(args.ws + WS_CTL);
    XcdBarrier bar; bar.bar = ctl + CW_BAR; bar.x = 0; bar.st = nullptr; bar.wave = F.wave;
    if (hi - lo > 1) bar = xcd_barrier_post(ctl + CW_BAR, MISC + 8, F.wave);
#ifndef PHASE_SEL
#define PHASE_SEL 0xFF
#endif
#define IN(k) (((PHASE_SEL >> (k)) & 1) && lo <= (k) && (k) < hi)
#define SEAM(k) do { if (IN(k) && IN((k) + 1)) xcd_barrier(bar); F.tid = tid_of(F.wave); F.lane = F.tid & 63; } while (0)
#ifndef REP_MASK
#define REP_MASK 0
#endif
#define REPS(k) for (int rep_ = 0; rep_ < (((REP_MASK >> (k)) & 1) ? 2 : 1); ++rep_)
    unsigned char* ws = args.ws;
    F.tid = tid_of(F.wave); F.lane = F.tid & 63;
    constexpr int P0_SMALL = (DM / 64) * (INC / 64) + (DM / 64) * (DM / 64);
    const bool split = (F.G == 256) && SPLIT_CONV;
    const int p0_hi = split ? P0_SMALL + CONV_IN_P0 : 0x7fffffff;
    if (IN(0)) REPS(0) { p0_prologue(F, args, 0, p0_hi, F.bx * NWAVES + F.wave, F.G * NWAVES, true); }
    SEAM(0);
    if (IN(1)) REPS(1) {
        const int grp = F.bx >> 3;
        if (split && (grp & 3) == 3) {
            const int rank = (grp >> 2) * 8 + (F.bx & 7);
            p0_prologue(F, args, p0_hi, 0x7fffffff, rank * NWAVES + F.wave, 64 * NWAVES, false);
        } else {
            const int Gg = split ? 192 : F.G, cg = split ? (grp - (grp >> 2)) * 8 + (F.bx & 7) : F.bx;
            pg8::ProbDense S{(const bf16_t*)(ws + WS_XN), (const bf16_t*)(ws + WS_WIN), NTOK / 256, INC / 256, Gg, cg, ws + WS_DUMMY};
            pg8::EpiP E{(bf16_t*)(ws + WS_P)};
            pg8::gemm_phase<pg8::ProbDense, pg8::EpiP, true>(F.lds + RING_OFF, S, E, F.wave);
        }
    }
    SEAM(1);
    if (IN(2)) REPS(2) { p2_attn_conv(F, args); }
    SEAM(2);
    if (IN(3)) REPS(3) {
        pg8::ProbDense S{(const bf16_t*)(ws + WS_MIX), (const bf16_t*)(ws + WS_WOUT), NTOK / 256, DM / 256, F.G, F.bx, ws + WS_DUMMY};
        pg8::EpiMo E{(bf16_t*)(ws + WS_MO), (const float*)(ws + WS_RSA)};
        pg8::gemm_phase<pg8::ProbDense, pg8::EpiMo, true>(F.lds + RING_OFF, S, E, F.wave);
    }
    SEAM(3);
    if (IN(4)) REPS(4) { p4_router(F, args, ((REP_MASK >> 4) & 1) && rep_ == 0); }
    SEAM(4);
    int nM_keep = -1;
    if (IN(5)) REPS(5) {
        const int nM = moe_tables(F, args); nM_keep = nM;
        LAS int* te = (LAS int*)(F.lds + TILEE_OFF); LAS int* ts = (LAS int*)(F.lds + TSTART_OFF); LAS int* cnt = (LAS int*)(F.lds + CNT_OFF); LAS unsigned* idtab = (LAS unsigned*)(F.lds + IDTAB_OFF);
        pg8::ProbG1<MOE_FP8 != 0> S{(const unsigned char*)(ws + WS_XN), (const unsigned char*)(ws + WS_W1), nM, F.G, F.bx, te, idtab, ws + WS_DUMMY};
        const int* list = (const int*)(ws + WS_LIST);
        pg8::Unit u;
        if (F.tid < 256) {
            int tokv[IDTAB_UNITS];
#pragma unroll
            for (int i = 0; i < IDTAB_UNITS; ++i) { tokv[i] = 0;
                if (S.next(i, u)) { const int rie = (u.pm - ts[u.e]) * 256 + F.tid; if (rie < cnt[u.e]) tokv[i] = list[(size_t)u.e * NTOK + rie]; } }
#pragma unroll
            for (int i = 0; i < IDTAB_UNITS; ++i) idtab[i * 256 + F.tid] = (unsigned)tokv[i] * (unsigned)(pg8::ProbG1<MOE_FP8 != 0>::KB);
        }
        __syncthreads();
        phase_stagger(F, nM * 8, STG5);
#if MOE_FP8
        pg8::EpiAct8 E{(unsigned char*)(ws + WS_ACT), args.b1, (const LAS float*)(F.lds + BIAS_OFF)};
        pg8::gemm_phase<pg8::ProbG1<true>, pg8::EpiAct8, true>(F.lds + RING_OFF, S, E, F.wave);
#else
        pg8::EpiAct E{(bf16_t*)(ws + WS_ACT), args.b1};
        pg8::gemm_phase<pg8::ProbG1<false>, pg8::EpiAct, true>(F.lds + RING_OFF, S, E, F.wave);
#endif
    }
    SEAM(5);
    if (IN(6)) REPS(6) {
        const int nM = (nM_keep >= 0) ? nM_keep : moe_tables(F, args);
        LAS int* te = (LAS int*)(F.lds + TILEE_OFF);
        pg8::ProbG2<MOE_FP8 != 0> S{(const unsigned char*)(ws + WS_ACT), (const unsigned char*)(ws + WS_W2), nM, F.G, F.bx, te, ws + WS_DUMMY};
#if MOE_FP8
        pg8::EpiY8 E{(unsigned char*)(ws + WS_Y), args.b2, (const LAS float*)(F.lds + BIAS_OFF)};
        pg8::gemm_phase<pg8::ProbG2<true>, pg8::EpiY8, true>(F.lds + RING_OFF, S, E, F.wave);
#else
        pg8::EpiY E{(bf16_t*)(ws + WS_Y), args.b2, (const LAS float*)(F.lds + BIAS_OFF)};
        pg8::gemm_phase<pg8::ProbG2<false>, pg8::EpiY, true>(F.lds + RING_OFF, S, E, F.wave);
#endif
    }
    SEAM(6);
    if (IN(7)) REPS(7) { if (nM_keep < 0) (void)moe_tables(F, args); p7_combine(F, args, ((REP_MASK >> 7) & 1) && rep_ == 0); }
#undef IN
#undef SEAM
}

#ifndef MK_MASK
#define MK_MASK 0xFF
#endif
#ifndef MK_ONE
#define MK_ONE 1
#endif

extern "C" void kernel_launch(void* const* d_in, const int* in_sizes, int n_in, void* d_out, int out_size, void* d_ws, size_t ws_size, hipStream_t stream) {
    if (n_in != 16 || out_size != NTOK * DM || ws_size < WS_END) { fprintf(stderr, "kernel_launch: unexpected shapes (n_in %d out %d ws %zu)\n", n_in, out_size, ws_size); return; }
    const float* x = (const float*)d_in[0]; const float* g_mix = (const float*)d_in[1]; const float* w_in = (const float*)d_in[2]; const float* conv_w = (const float*)d_in[3];
    const float* sinks = (const float*)d_in[4]; const float* g_ao = (const float*)d_in[5]; const float* g_co = (const float*)d_in[6]; const float* w_out = (const float*)d_in[7];
    const float* g_ffn = (const float*)d_in[8]; const float* w_router = (const float*)d_in[9]; const float* b_router = (const float*)d_in[10]; const float* w1 = (const float*)d_in[11];
    const float* b1 = (const float*)d_in[12]; const float* w2 = (const float*)d_in[13]; const float* b2 = (const float*)d_in[14]; const float* g_final = (const float*)d_in[15];
    unsigned char* ws = (unsigned char*)d_ws; float* out = (float*)d_out;
    static int grid = 0;
    if (grid == 0) {
        int dev = 0, cus = 0, per_cu = 0;
        if (hipGetDevice(&dev) != hipSuccess || hipDeviceGetAttribute(&cus, hipDeviceAttributeMultiprocessorCount, dev) != hipSuccess) { fprintf(stderr, "kernel_launch: device query failed\n"); grid = -1; return; }
        if (hipFuncSetAttribute((const void*)mk_fwd, hipFuncAttributeMaxDynamicSharedMemorySize, LDS_BYTES) != hipSuccess) { fprintf(stderr, "kernel_launch: hipFuncSetAttribute failed\n"); grid = -1; return; }
        if (hipOccupancyMaxActiveBlocksPerMultiprocessor(&per_cu, (const void*)mk_fwd, NTHREADS, LDS_BYTES) != hipSuccess || per_cu < 1) { fprintf(stderr, "kernel_launch: occupancy query says %d blocks per CU\n", per_cu); per_cu = 1; }
        (void)hipGetLastError();
        grid = cus;
    }
    if (grid < 0) return;
    (void)hipMemsetAsync(ws + WS_CTL, 0, CTL_BYTES, stream);
    MkArgs a{};
    a.x = x; a.g_mix = g_mix; a.w_in = w_in; a.conv_w = conv_w; a.sinks = sinks; a.g_ao = g_ao; a.g_co = g_co; a.w_out = w_out; a.g_ffn = g_ffn; a.w_router = w_router; a.b_router = b_router;
    a.w1 = w1; a.b1 = b1; a.w2 = w2; a.b2 = b2; a.g_final = g_final; a.out = out; a.ws = ws;
#if MK_ONE
    a.ph_lo = 0; a.ph_hi = 8;
    hipLaunchKernelGGL(mk_fwd, dim3(grid), dim3(NTHREADS), LDS_BYTES, stream, a);
#else
    unsigned* ctl = (unsigned*)(ws + WS_CTL);
    bf16_t* Win_t = (bf16_t*)(ws + WS_WIN); bf16_t* Wout_t = (bf16_t*)(ws + WS_WOUT); float* WR = (float*)(ws + WS_WR); int* list = (int*)(ws + WS_LIST);
    int* TE = (int*)(ws + WS_TE); int* TP = (int*)(ws + WS_TP); float* TG = (float*)(ws + WS_TG); int* tab = (int*)(ws + WS_TAB); float* gcat = (float*)(ws + WS_TAB + 16384);
    bf16_t* W1_t = (bf16_t*)(ws + WS_W1); bf16_t* W2_t = (bf16_t*)(ws + WS_W2); bf16_t* XN = (bf16_t*)(ws + WS_XN); bf16_t* P = (bf16_t*)(ws + WS_P);
    bf16_t* MIX = (bf16_t*)(ws + WS_MIX); bf16_t* ACT = (bf16_t*)(ws + WS_ACT); bf16_t* Y = (bf16_t*)(ws + WS_Y); float* ATT = (float*)(ws + WS_ATT);
    for (int p = 0; p < 8; ++p) {
        if ((MK_MASK >> p) & 1) { a.ph_lo = p; a.ph_hi = p + 1; hipLaunchKernelGGL(mk_fwd, dim3(grid), dim3(NTHREADS), LDS_BYTES, stream, a); continue; }
        switch (p) {
        case 0:
            n_gcat<<<4, 256, 0, stream>>>(g_ao, g_co, gcat);
            n_transpose<<<dim3(DM / 32, INC / 32, 1), dim3(32, 8), 0, stream>>>(w_in, Win_t, DM, INC, g_mix);
            n_transpose<<<dim3(DM / 32, DM / 32, 1), dim3(32, 8), 0, stream>>>(w_out, Wout_t, DM, DM, gcat);
            n_transpose<<<dim3(DM / 32, 2048 / 32, NE), dim3(32, 8), 0, stream>>>(w1, W1_t, DM, 2048, g_ffn);
            n_transpose<<<dim3(DFF / 32, DM / 32, NE), dim3(32, 8), 0, stream>>>(w2, W2_t, DFF, DM, nullptr);
            n_wr<<<DM * NE / 256, 256, 0, stream>>>(w_router, g_ffn, WR);
            n_xn<<<NTOK, 256, 0, stream>>>(x, XN); break;
        case 1: { NG g{}; g.A = XN; g.Bt = Win_t; g.Ob = P; n_gemm<0><<<dim3(NTOK / 128, INC / 128), 256, 0, stream>>>(g); } break;
        case 2: n_attn<<<NTOK * NQH / 4, 256, 0, stream>>>(P, sinks, ATT); n_mix<<<NTOK, 256, 0, stream>>>(P, ATT, conv_w, MIX); break;
        case 3: { NG g{}; g.A = MIX; g.Bt = Wout_t; g.Of = out; g.X = x; n_gemm<1><<<dim3(NTOK / 128, DM / 128), 256, 0, stream>>>(g); } break;
        case 4: n_router<<<NTOK, 256, 0, stream>>>(out, WR, b_router, XN, ctl + CW_CNT, list, TE, TP, TG); break;
        case 5: n_tables<<<1, 64, 0, stream>>>(ctl + CW_CNT, tab);
            { NG g{}; g.A = XN; g.Bt = W1_t; g.Ob = ACT; g.bias = b1; g.list = list; g.cnt = ctl + CW_CNT; g.tab = tab; n_gemm<2><<<dim3(PADROWS / 128, DFF / 128), 256, 0, stream>>>(g); } break;
        case 6: n_tables<<<1, 64, 0, stream>>>(ctl + CW_CNT, tab);
            { NG g{}; g.A = ACT; g.Bt = W2_t; g.Ob = Y; g.bias = b2; g.list = list; g.cnt = ctl + CW_CNT; g.tab = tab; n_gemm<3><<<dim3(PADROWS / 128, DM / 128), 256, 0, stream>>>(g); } break;
        case 7: n_tables<<<1, 64, 0, stream>>>(ctl + CW_CNT, tab); n_combine<<<NTOK, 256, 0, stream>>>(out, Y, TE, TP, TG, tab, g_final, out); break;
        }
    }
#endif
}
```

```cpp
#include <hip/hip_runtime.h>
#include <cstdint>
#include <cstdio>
#ifndef PAD1
#define PAD1 0
#define PAD3 27
#define PAD5 28
#define PAD6 0
#endif
#ifndef SCHED44
#define SCHED44 0
#endif
#ifndef SPLIT_CONV
#define SPLIT_CONV 0
#define CONV_IN_P0 0
#endif
#ifndef STG1
#define STG1 0
#define STG3 0
#define STG5 0
#define STG6 0
#endif

typedef unsigned short bf16_t;
typedef short bf16x8 __attribute__((ext_vector_type(8)));
typedef float f32x4 __attribute__((ext_vector_type(4)));

constexpr int BATCH = 2, SEQ = 16384, DM = 1024, NTOK = BATCH * SEQ;
constexpr int NQH = 8, HD = 64, ATTW = 512, CONVW = 512, INC = 2304;
constexpr int INCP = 1792;
constexpr int NE = 32, DFF = 1024;
constexpr int MAXTILES = 544, PADROWS = MAXTILES * 256;
constexpr float EPS = 1e-5f;
constexpr float LOG2E = 1.4426950408889634f;
constexpr float C2 = 0.125f * LOG2E;
constexpr int W8_SHIFT = 5;
constexpr int W8_SCALE_E8M0 = 127 - W8_SHIFT;
#ifndef MOE_FP8
#define MOE_FP8 1
#endif

constexpr size_t MiB = 1u << 20;
constexpr size_t WS_CTL = 0, CTL_BYTES = 64 * 1024;
constexpr size_t WS_WIN = 1 * MiB, WS_WOUT = 6 * MiB, WS_WR = 8 * MiB, WS_LIST = 9 * MiB;
constexpr size_t WS_TE = 13 * MiB, WS_TP = 13 * MiB + 512 * 1024, WS_TG = 14 * MiB, WS_TAB = 14 * MiB + 512 * 1024;
constexpr size_t WS_RSA = 15 * MiB;
constexpr size_t WS_W1 = 16 * MiB, WS_W2 = 144 * MiB, WS_XN = 208 * MiB, WS_P = 272 * MiB, WS_MIX = 416 * MiB;
constexpr size_t WS_RSXI = 15 * MiB + 256 * 1024;
constexpr size_t WS_H2 = 880 * MiB;
constexpr size_t WS_MO = 272 * MiB  , WS_X1B = 816 * MiB  ;
constexpr size_t WS_ACT = 272 * MiB, WS_Y = 544 * MiB, WS_ATT = 816 * MiB, WS_DUMMY = 880 * MiB, WS_END = 1016 * MiB;
constexpr int CW_CNT = 0;

__device__ __forceinline__ float bf2f(bf16_t v) { return __uint_as_float((unsigned)v << 16); }
__device__ __forceinline__ bf16_t f2bf(float f) { unsigned u = __float_as_uint(f); return (bf16_t)((u + 0x7fffu + ((u >> 16) & 1u)) >> 16); }

__device__ __forceinline__ float wave_sum(float v) {
    v += __int_as_float(__builtin_amdgcn_update_dpp(0, __float_as_int(v), 0xB1, 0xF, 0xF, true));
    v += __int_as_float(__builtin_amdgcn_update_dpp(0, __float_as_int(v), 0x4E, 0xF, 0xF, true));
    v += __int_as_float(__builtin_amdgcn_update_dpp(0, __float_as_int(v), 0x141, 0xF, 0xF, true));
    v += __int_as_float(__builtin_amdgcn_update_dpp(0, __float_as_int(v), 0x140, 0xF, 0xF, true));
    const float s0 = __int_as_float(__builtin_amdgcn_readlane(__float_as_int(v), 0)), s1 = __int_as_float(__builtin_amdgcn_readlane(__float_as_int(v), 16));
    const float s2 = __int_as_float(__builtin_amdgcn_readlane(__float_as_int(v), 32)), s3 = __int_as_float(__builtin_amdgcn_readlane(__float_as_int(v), 48));
    return (s0 + s1) + (s2 + s3);
}
__device__ __forceinline__ void wave_halves(float v, float& lo, float& hi) {
    const auto r = __builtin_amdgcn_permlane32_swap(__float_as_uint(v), __float_as_uint(v), false, false);
    lo = __uint_as_float(r[0]); hi = __uint_as_float(r[1]);
}
__device__ __forceinline__ float sum8(float v) {
    v += __int_as_float(__builtin_amdgcn_update_dpp(0, __float_as_int(v), 0xB1, 0xF, 0xF, true));
    v += __int_as_float(__builtin_amdgcn_update_dpp(0, __float_as_int(v), 0x4E, 0xF, 0xF, true));
    v += __int_as_float(__builtin_amdgcn_update_dpp(0, __float_as_int(v), 0x141, 0xF, 0xF, true));
    return v;
}
__device__ __forceinline__ float wave_max(float v) {
#pragma unroll
    for (int o = 1; o < 64; o <<= 1) v = fmaxf(v, __shfl_xor(v, o));
    return v;
}
__device__ __forceinline__ float block_sum256(float v, float* red) {
    v = wave_sum(v);
    __syncthreads();
    if ((threadIdx.x & 63) == 0) red[threadIdx.x >> 6] = v;
    __syncthreads();
    return red[0] + red[1] + red[2] + red[3];
}

__global__ void n_transpose(const float* W, bf16_t* WT, int K, int N, const float* g) {
    __shared__ float tile[32][33];
    const size_t zoff = (size_t)blockIdx.z * K * N;
    const int k0 = blockIdx.x * 32, n0 = blockIdx.y * 32, tx = threadIdx.x, ty = threadIdx.y;
#pragma unroll
    for (int i = 0; i < 4; ++i) { const int kk = ty + 8 * i; tile[kk][tx] = W[zoff + (size_t)(k0 + kk) * N + n0 + tx] * (g ? g[k0 + kk] : 1.f); }
    __syncthreads();
#pragma unroll
    for (int i = 0; i < 4; ++i) { const int nn = ty + 8 * i; WT[zoff + (size_t)(n0 + nn) * K + k0 + tx] = f2bf(tile[tx][nn]); }
}
__global__ void n_wr(const float* wr, const float* g, float* out) {
    const int i = blockIdx.x * 256 + threadIdx.x; if (i < DM * NE) out[i] = wr[i] * g[i >> 5];
}
__global__ void n_gcat(const float* ga, const float* gc, float* out) { const int i = blockIdx.x * 256 + threadIdx.x; if (i < DM) out[i] = i < 512 ? ga[i] : gc[i - 512]; }
__global__ __launch_bounds__(256) void n_xn(const float* x, bf16_t* XN) {
    __shared__ float red[4];
    const int row = blockIdx.x, t = threadIdx.x;
    const f32x4 v = *(const f32x4*)(x + (size_t)row * DM + 4 * t);
    const float ss = block_sum256(v.x * v.x + v.y * v.y + v.z * v.z + v.w * v.w, red);
    const float rstd = rsqrtf(ss * (1.f / DM) + EPS);
    bf16_t* o = XN + (size_t)row * DM + 4 * t;
    o[0] = f2bf(v.x * rstd); o[1] = f2bf(v.y * rstd); o[2] = f2bf(v.z * rstd); o[3] = f2bf(v.w * rstd);
}

struct NG {
    const bf16_t* A; const bf16_t* Bt; bf16_t* Ob; float* Of; const float* X; const float* bias;
    const int* list; const unsigned* cnt; const int* tab;
};
__device__ __forceinline__ float swiglu(float g, float l) {
    g = fminf(g, 7.f); l = fminf(fmaxf(l, -7.f), 7.f);
    const float s = __builtin_amdgcn_rcpf(1.f + __builtin_amdgcn_exp2f(-1.702f * LOG2E * g));
    const float a = g * s;
    return __builtin_fmaf(a, l, a);
}
typedef float f32x2v __attribute__((ext_vector_type(2)));
__device__ __forceinline__ f32x2v swiglu_pk(f32x2v g, f32x2v l) {
    g.x = __builtin_amdgcn_fmed3f(g.x, -24.f, 7.f); g.y = __builtin_amdgcn_fmed3f(g.y, -24.f, 7.f);
    l.x = __builtin_amdgcn_fmed3f(l.x, -7.f, 7.f); l.y = __builtin_amdgcn_fmed3f(l.y, -7.f, 7.f);
    const f32x2v t = g * (-1.702f * LOG2E);
    f32x2v e; e.x = __builtin_amdgcn_exp2f(t.x); e.y = __builtin_amdgcn_exp2f(t.y);
    const f32x2v d = e + 1.0f;
    const float rr = __builtin_amdgcn_rcpf(d.x * d.y);
    const f32x2v ds = {d.y, d.x};
    const f32x2v a = g * (ds * rr);
    return a * l + a;
}
template <int MODE> __global__ __launch_bounds__(256) void n_gemm(NG a) {
    const int lane = threadIdx.x & 63, w = threadIdx.x >> 6, row = lane & 15, quad = lane >> 4;
    const int m0 = blockIdx.x * 128 + (w >> 1) * 64, n0 = blockIdx.y * 128 + (w & 1) * 64;
    int e = 0, rbase = 0, cnt = 0;
    if (MODE >= 2) {
        const int pm = (blockIdx.x * 128) >> 8;
        if (pm >= a.tab[32]) return;
        e = a.tab[64 + pm]; rbase = m0 - 256 * a.tab[e]; cnt = (int)a.cnt[e];
    }
    const bf16_t* ar[4]; const bf16_t* br[4]; const bf16_t* br2[4];
#pragma unroll
    for (int i = 0; i < 4; ++i) {
        const int m = m0 + 16 * i + row;
        if (MODE == 2) { const int rr = rbase + 16 * i + row; const int tok = rr < cnt ? a.list[e * NTOK + rr] : 0; ar[i] = a.A + (size_t)tok * DM; }
        else ar[i] = a.A + (size_t)m * DM;
        const int n = n0 + 16 * i + row;
        if (MODE == 2) { br[i] = a.Bt + ((size_t)e * 2048 + n) * DM; br2[i] = br[i] + (size_t)1024 * DM; }
        else if (MODE == 3) { br[i] = a.Bt + ((size_t)e * 1024 + n) * DM; br2[i] = br[i]; }
        else { br[i] = a.Bt + (size_t)n * DM; br2[i] = br[i]; }
    }
    f32x4 acc[4][4], acc2[4][4];
#pragma unroll
    for (int i = 0; i < 4; ++i)
#pragma unroll
        for (int j = 0; j < 4; ++j) { acc[i][j] = (f32x4){0.f, 0.f, 0.f, 0.f}; acc2[i][j] = (f32x4){0.f, 0.f, 0.f, 0.f}; }
    for (int k0 = 0; k0 < DM; k0 += 32) {
        bf16x8 fa[4], fb[4], fb2[4];
#pragma unroll
        for (int i = 0; i < 4; ++i) { fa[i] = *(const bf16x8*)(ar[i] + k0 + quad * 8); fb[i] = *(const bf16x8*)(br[i] + k0 + quad * 8); if (MODE == 2) fb2[i] = *(const bf16x8*)(br2[i] + k0 + quad * 8); }
#pragma unroll
        for (int i = 0; i < 4; ++i)
#pragma unroll
            for (int j = 0; j < 4; ++j) {
                acc[i][j] = __builtin_amdgcn_mfma_f32_16x16x32_bf16(fa[i], fb[j], acc[i][j], 0, 0, 0);
                if (MODE == 2) acc2[i][j] = __builtin_amdgcn_mfma_f32_16x16x32_bf16(fa[i], fb2[j], acc2[i][j], 0, 0, 0);
            }
    }
#pragma unroll
    for (int i = 0; i < 4; ++i)
#pragma unroll
        for (int j = 0; j < 4; ++j)
#pragma unroll
            for (int r = 0; r < 4; ++r) {
                const int m = m0 + 16 * i + quad * 4 + r, n = n0 + 16 * j + row;
                const float v = acc[i][j][r];
                if (MODE == 0) a.Ob[(size_t)m * INC + n] = f2bf(n < 512 ? v * C2 : v);
                else if (MODE == 1) a.Of[(size_t)m * DM + n] = a.X[(size_t)m * DM + n] + v;
                else if (MODE == 2) a.Ob[(size_t)m * DM + n] = f2bf(swiglu(v + a.bias[e * 2048 + n], acc2[i][j][r] + a.bias[e * 2048 + 1024 + n]));
                else a.Ob[(size_t)m * DM + n] = f2bf(v + a.bias[e * 1024 + n]);
            }
}

__global__ __launch_bounds__(256) void n_attn(const bf16_t* P, const float* sinks, float* ATT) {
    const int gw = blockIdx.x * 4 + (threadIdx.x >> 6), lane = threadIdx.x & 63;
    const int tok = gw >> 3, h = gw & 7, hk = h >> 2, t = tok % SEQ;
    const float slope2 = exp2f(-(float)(h + 1)) * LOG2E, sink2 = sinks[h] * LOG2E;
    float q[64];
    const bf16_t* qp = P + (size_t)tok * INC + h * 64;
#pragma unroll
    for (int d = 0; d < 64; ++d) q[d] = bf2f(qp[d]);
    float s[2];
#pragma unroll
    for (int jj = 0; jj < 2; ++jj) {
        const int j = lane + 64 * jj, kp = t - 127 + j;
        float acc = -INFINITY;
        if (kp >= 0) {
            const bf16_t* kr = P + (size_t)(tok - 127 + j) * INC + 512 + hk * 64;
            acc = 0.f;
#pragma unroll
            for (int d = 0; d < 64; ++d) acc += q[d] * bf2f(kr[d]);
            acc -= slope2 * (float)(127 - j);
        }
        s[jj] = acc;
    }
    const float m = fmaxf(wave_max(fmaxf(s[0], s[1])), sink2);
    const float e0 = exp2f(s[0] - m), e1 = exp2f(s[1] - m);
    const float l = wave_sum(e0 + e1) + exp2f(sink2 - m);
    const float p0 = e0 / l, p1 = e1 / l;
    float o = 0.f;
    for (int j = 0; j < 128; ++j) {
        const float pj = __shfl(j < 64 ? p0 : p1, j & 63);
        if (t - 127 + j >= 0) o += pj * bf2f(P[(size_t)(tok - 127 + j) * INC + 640 + hk * 64 + lane]);
    }
    ATT[(size_t)tok * ATTW + h * 64 + lane] = o;
}
__global__ __launch_bounds__(256) void n_mix(const bf16_t* P, const float* ATT, const float* convw, bf16_t* MIX) {
    __shared__ float red[4];
    const int tok = blockIdx.x, tid = threadIdx.x, t = tok % SEQ;
    const float a0 = ATT[(size_t)tok * ATTW + tid], a1 = ATT[(size_t)tok * ATTW + 256 + tid];
    const float ssa = block_sum256(a0 * a0 + a1 * a1, red);
    const float ra = rsqrtf(ssa * (1.f / ATTW) + EPS);
    MIX[(size_t)tok * DM + tid] = f2bf(a0 * ra); MIX[(size_t)tok * DM + 256 + tid] = f2bf(a1 * ra);
    float y[2];
#pragma unroll
    for (int i = 0; i < 2; ++i) {
        const int c = tid + 256 * i;
        float acc = 0.f;
#pragma unroll
        for (int dt = 0; dt < 3; ++dt) {
            const int tt = t - 2 + dt;
            if (tt >= 0) { const bf16_t* pr = P + (size_t)(tok - 2 + dt) * INC; acc += convw[dt * CONVW + c] * (bf2f(pr[1280 + c]) * bf2f(pr[1792 + c])); }
        }
        y[i] = bf2f(P[(size_t)tok * INC + 768 + c]) * acc;
    }
    const float ssc = block_sum256(y[0] * y[0] + y[1] * y[1], red);
    const float rc = rsqrtf(ssc * (1.f / CONVW) + EPS);
    MIX[(size_t)tok * DM + 512 + tid] = f2bf(y[0] * rc); MIX[(size_t)tok * DM + 768 + tid] = f2bf(y[1] * rc);
}
__global__ __launch_bounds__(256) void n_router(const float* X1, const float* WR, const float* br, bf16_t* H2, unsigned* cnt, int* list, int* TE, int* TP, float* TG) {
    __shared__ float red[4]; __shared__ float xs[DM]; __shared__ float part[8][32]; __shared__ float lg[32];
    const int tok = blockIdx.x, tid = threadIdx.x;
    const f32x4 v = *(const f32x4*)(X1 + (size_t)tok * DM + 4 * tid);
    const float ss = block_sum256(v.x * v.x + v.y * v.y + v.z * v.z + v.w * v.w, red);
    const float rstd = rsqrtf(ss * (1.f / DM) + EPS);
    bf16_t* o = H2 + (size_t)tok * DM + 4 * tid;
    o[0] = f2bf(v.x * rstd); o[1] = f2bf(v.y * rstd); o[2] = f2bf(v.z * rstd); o[3] = f2bf(v.w * rstd);
    xs[4 * tid] = v.x; xs[4 * tid + 1] = v.y; xs[4 * tid + 2] = v.z; xs[4 * tid + 3] = v.w;
    __syncthreads();
    const int e = tid & 31, pt = tid >> 5;
    float acc = 0.f;
    for (int k = pt * 128; k < pt * 128 + 128; ++k) acc += xs[k] * WR[k * NE + e];
    part[pt][e] = acc;
    __syncthreads();
    if (tid < 32) { float sum = 0.f; for (int p = 0; p < 8; ++p) sum += part[p][tid]; lg[tid] = sum * rstd + br[tid]; }
    __syncthreads();
    if (tid == 0) {
        int idx[4]; float val[4]; unsigned used = 0u;
        for (int k = 0; k < 4; ++k) { float best = -INFINITY; int bi = 0; for (int j = 0; j < 32; ++j) if (!((used >> j) & 1u) && lg[j] > best) { best = lg[j]; bi = j; } used |= 1u << bi; idx[k] = bi; val[k] = best; }
        float es[4], sum = 0.f; for (int k = 0; k < 4; ++k) { es[k] = expf(val[k] - val[0]); sum += es[k]; }
        for (int k = 0; k < 4; ++k) {
            const unsigned pos = atomicAdd(&cnt[idx[k]], 1u);
            list[idx[k] * NTOK + pos] = tok; TE[tok * 4 + k] = idx[k]; TP[tok * 4 + k] = (int)pos; TG[tok * 4 + k] = es[k] / sum;
        }
    }
}
__global__ void n_tables(const unsigned* cnt, int* tab) {
    if (threadIdx.x == 0) { int s = 0; for (int e = 0; e < NE; ++e) { tab[e] = s; const int nt = ((int)cnt[e] + 255) >> 8; for (int i = 0; i < nt; ++i) tab[64 + s + i] = e; s += nt; } tab[32] = s; }
}
__global__ __launch_bounds__(256) void n_combine(const float* X1, const bf16_t* Y, const int* TE, const int* TP, const float* TG, const int* tab, const float* gf, float* out) {
    __shared__ float red[4];
    const int tok = blockIdx.x, tid = threadIdx.x;
    f32x4 v = *(const f32x4*)(X1 + (size_t)tok * DM + 4 * tid);
#pragma unroll
    for (int k = 0; k < 4; ++k) {
        const int e = TE[tok * 4 + k]; const size_t slot = (size_t)256 * tab[e] + TP[tok * 4 + k]; const float g = TG[tok * 4 + k];
        const bf16_t* yr = Y + slot * DM + 4 * tid;
        v.x += g * bf2f(yr[0]); v.y += g * bf2f(yr[1]); v.z += g * bf2f(yr[2]); v.w += g * bf2f(yr[3]);
    }
    const float ss = block_sum256(v.x * v.x + v.y * v.y + v.z * v.z + v.w * v.w, red);
    const float rstd = rsqrtf(ss * (1.f / DM) + EPS);
    const f32x4 g4 = *(const f32x4*)(gf + 4 * tid);
    *(f32x4*)(out + (size_t)tok * DM + 4 * tid) = (f32x4){v.x * rstd * g4.x, v.y * rstd * g4.y, v.z * rstd * g4.z, v.w * rstd * g4.w};
}


#define LAS __attribute__((address_space(3)))
#define GAS __attribute__((address_space(1)))
typedef unsigned u32x4 __attribute__((ext_vector_type(4)));
typedef unsigned u32x2 __attribute__((ext_vector_type(2)));
typedef float f32x16 __attribute__((ext_vector_type(16)));
typedef float f32x2 __attribute__((ext_vector_type(2)));
typedef short s16x4 __attribute__((ext_vector_type(4)));
typedef __bf16 bf16x2_t __attribute__((ext_vector_type(2)));
typedef GAS unsigned gu32;
#define RLX_AGENT __ATOMIC_RELAXED, __HIP_MEMORY_SCOPE_AGENT
#define LDS_WAIT() asm volatile("s_waitcnt lgkmcnt(0)" ::: "memory")
#define VM_WAIT() asm volatile("s_waitcnt vmcnt(0)" ::: "memory")

constexpr int NWAVES = 8, NTHREADS = 512;
constexpr int RING_OFF = 0, RING_BYTES = 131072;
constexpr int IDTAB_OFF = RING_BYTES, IDTAB_UNITS = 17, IDTAB_BYTES = IDTAB_UNITS * 1024;
constexpr int TILEE_OFF = IDTAB_OFF + IDTAB_BYTES;
constexpr int TSTART_OFF = TILEE_OFF + 2304;
constexpr int CNT_OFF = TSTART_OFF + 256;
constexpr int MISC_OFF = CNT_OFF + 128;
constexpr int BIAS_OFF = MISC_OFF + 128;
constexpr int LDS_BYTES = 155648;
static_assert(BIAS_OFF % 16 == 0 && BIAS_OFF + 1024 <= LDS_BYTES, "LDS map");
constexpr int CW_BAR = 4096;

__device__ __forceinline__ unsigned cvtpk(float lo, float hi) { f32x2 v = {lo, hi}; bf16x2_t b = __builtin_convertvector(v, bf16x2_t); return __builtin_bit_cast(unsigned, b); }

__device__ __forceinline__ int tid_of(int wave) { unsigned z = 0u; asm volatile("" : "+v"(z)); const int l = (int)__builtin_amdgcn_mbcnt_hi(~0u, __builtin_amdgcn_mbcnt_lo(~0u, z)); return wave * 64 + l; }

namespace pg8 {
constexpr int BM = 256, BK = 64, HALF = 128, HTB = HALF * BK * 2, NXCD = 8, WGM = 8, KD = 1024;
typedef int i32x8 __attribute__((ext_vector_type(8)));
typedef int i32x4 __attribute__((ext_vector_type(4)));
__host__ __device__ __forceinline__ int lds_byte(int r, int c) { return r * 128 + ((((c >> 3) ^ (r >> 1)) & 7) << 4) + (c & 7) * 2; }
__host__ __device__ __forceinline__ void stage_rc(int b, int& R, int& C) { R = b >> 7; C = ((((b >> 4) & 7) ^ ((R >> 1) & 7)) << 3); }
__host__ __device__ __forceinline__ int perm32(int rho) { const int n = rho >> 4, i = rho & 15; return 8 * (i >> 2) + 4 * n + (i & 3); }
struct Unit { int pm, pn, e; };
__device__ __forceinline__ bool order_next(int i, int G, int c, int nM, int nN, Unit& u) {
    const int nwg = nM * nN; const long L = (long)i * G + c; if (L >= nwg) return false;
    int wgid = (int)L; { const int q = nwg / NXCD, r = nwg % NXCD, xcd = wgid % NXCD, off = wgid / NXCD; wgid = (xcd < r ? xcd * (q + 1) : r * (q + 1) + (xcd - r) * q) + off; }
    const int nig = WGM * nN, gid = wgid / nig, fm = gid * WGM, gsz = (nM - fm) < WGM ? (nM - fm) : WGM;
    u.pm = fm + ((wgid % nig) % gsz); u.pn = (wgid % nig) / gsz; u.e = 0; return true;
}
struct ProbDense {
    static constexpr int KB = KD * 2; static constexpr bool F8 = false;
    static constexpr size_t HSTEPB = (size_t)HALF * KD * 2;
    const bf16_t* A; const bf16_t* Bt; int nM, nN, G, c; unsigned char* dummy;
    __device__ __forceinline__ bool next(int i, Unit& u) const { return order_next(i, G, c, nM, nN, u); }
    __device__ __forceinline__ const char* a_base(const Unit& u) const { return (const char*)A + (size_t)u.pm * BM * KD * 2; }
    __device__ __forceinline__ const char* b_base(const Unit& u) const { return (const char*)Bt + (size_t)u.pn * BM * KD * 2; }
    __device__ __forceinline__ void a_offs(int, const Unit&, const int (&Rr)[2], const int (&Cb)[2], unsigned (&va)[2][2]) const {
#pragma unroll
        for (int h = 0; h < 2; ++h)
#pragma unroll
            for (int i = 0; i < 2; ++i) va[h][i] = (unsigned)((Rr[i] + HALF * h) * KD * 2 + Cb[i]);
    }
};
template <bool F8_> struct ProbG1 {
    static constexpr int KB = F8_ ? KD : KD * 2; static constexpr bool F8 = F8_;
    static constexpr size_t HSTEPB = (size_t)1024 * KB;
    const unsigned char* H2; const unsigned char* W1t; int nM, G, c; const LAS int* tile_e; const LAS unsigned* idtab; unsigned char* dummy;
    __device__ __forceinline__ bool next(int i, Unit& u) const { if (!order_next(i, G, c, nM, 8, u)) return false; u.e = __builtin_amdgcn_readfirstlane(tile_e[u.pm]); return true; }
    __device__ __forceinline__ const char* a_base(const Unit&) const { return (const char*)H2; }
    __device__ __forceinline__ const char* b_base(const Unit& u) const { return (const char*)W1t + ((size_t)u.e * 2048 + (size_t)u.pn * 128) * KB; }
    __device__ __forceinline__ void a_offs(int ui, const Unit&, const int (&Rr)[2], const int (&Cb)[2], unsigned (&va)[2][2]) const {
        const int uu = ui < IDTAB_UNITS ? ui : IDTAB_UNITS - 1;
#pragma unroll
        for (int h = 0; h < 2; ++h)
#pragma unroll
            for (int i = 0; i < 2; ++i) va[h][i] = idtab[uu * 256 + h * HALF + Rr[i]] + (unsigned)Cb[i];
    }
};
template <bool F8_> struct ProbG2 {
    static constexpr int KB = F8_ ? KD : KD * 2; static constexpr bool F8 = F8_;
    static constexpr size_t HSTEPB = (size_t)HALF * KB;
    const unsigned char* ACT; const unsigned char* W2t; int nM, G, c; const LAS int* tile_e; unsigned char* dummy;
    __device__ __forceinline__ bool next(int i, Unit& u) const { if (!order_next(i, G, c, nM, 4, u)) return false; u.e = __builtin_amdgcn_readfirstlane(tile_e[u.pm]); return true; }
    __device__ __forceinline__ const char* a_base(const Unit& u) const { return (const char*)ACT + (size_t)u.pm * BM * KB; }
    __device__ __forceinline__ const char* b_base(const Unit& u) const { return (const char*)W2t + ((size_t)u.e * 1024 + (size_t)u.pn * 256) * KB; }
    __device__ __forceinline__ void a_offs(int, const Unit&, const int (&Rr)[2], const int (&Cb)[2], unsigned (&va)[2][2]) const {
#pragma unroll
        for (int h = 0; h < 2; ++h)
#pragma unroll
            for (int i = 0; i < 2; ++i) va[h][i] = (unsigned)((Rr[i] + HALF * h) * KB + Cb[i]);
    }
};

__device__ __forceinline__ void store_rows16(LAS unsigned char* scr, int fr, int fq, int lane, u32x4 c0, u32x4 c1, bf16_t* gbase  , size_t ld) {
    LAS unsigned char* wp = scr + (fr >> 3) * 8192 + (fr & 7) * 128;
    *(LAS u32x4*)(wp + (((2 * fq) ^ (fr & 7)) * 16)) = c0;
    *(LAS u32x4*)(wp + (((2 * fq + 1) ^ (fr & 7)) * 16)) = c1;
#pragma unroll
    for (int k = 0; k < 2; ++k) {
        const int rl = lane >> 3, ch = lane & 7;
        const u32x4 v = *(const LAS u32x4*)(scr + k * 8192 + rl * 128 + ((ch ^ rl) * 16));
        *(u32x4*)(gbase + (size_t)(8 * k + rl) * ld + ch * 8) = v;
    }
}
struct EpiP {
    static constexpr int PERM = 2; static constexpr bool HAS_BIAS = false; static constexpr bool MIDSCALE = false; static constexpr int NST = 16; bf16_t* O;
    __device__ __forceinline__ const char* bias_src(const Unit&, int) const { return nullptr; }
    __device__ __forceinline__ void operator()(const f32x4 (&acc)[2][2][4][2], const Unit& u, int wr, int wc, int fr, int fq, LAS unsigned char* scr) const {
        const int lane = fr + 16 * fq;
        if (u.pn >= 5) {
            bf16_t* ub = O + (size_t)(u.pm * BM + wr * 64 + fr) * INCP + 1280 + (u.pn - 5) * 128 + (4 * wc + fq) * 8;
#pragma unroll
            for (int ai = 0; ai < 2; ++ai)
#pragma unroll
                for (int m = 0; m < 4; ++m) {
                    const f32x4 p0 = acc[ai][0][m][0] * acc[ai][1][m][0], p1 = acc[ai][0][m][1] * acc[ai][1][m][1];
                    u32x2 w0, w1; w0.x = cvtpk(p0[0], p0[1]); w0.y = cvtpk(p0[2], p0[3]); w1.x = cvtpk(p1[0], p1[1]); w1.y = cvtpk(p1[2], p1[3]);
                    u32x2* dst = (u32x2*)(ub + (size_t)(ai * HALF + m * 16) * INCP);
                    dst[0] = w0; dst[1] = w1;
                }
            return;
        }
        const float sc = u.pn < 2 ? C2 : 1.f;
        bf16_t* base = O + (size_t)(u.pm * BM + wr * 64) * INCP + u.pn * BM + wc * 64;
#pragma unroll
        for (int ai = 0; ai < 2; ++ai)
#pragma unroll
            for (int m = 0; m < 4; ++m) {
                u32x4 c[2];
#pragma unroll
                for (int bj = 0; bj < 2; ++bj) { const f32x4 v0 = acc[ai][bj][m][0] * sc, v1 = acc[ai][bj][m][1] * sc;
                    c[bj].x = cvtpk(v0[0], v0[1]); c[bj].y = cvtpk(v0[2], v0[3]); c[bj].z = cvtpk(v1[0], v1[1]); c[bj].w = cvtpk(v1[2], v1[3]); }
                store_rows16(scr, fr, fq, lane, c[0], c[1], base + (size_t)(ai * HALF + m * 16) * INCP, INCP);
            }
    }
};
struct EpiMo {
    static constexpr int PERM = 2; static constexpr bool HAS_BIAS = false; static constexpr bool MIDSCALE = true; static constexpr int NST = 16; bf16_t* O; const float* RS;
    __device__ __forceinline__ const char* bias_src(const Unit&, int) const { return nullptr; }
    __device__ __forceinline__ const char* scale_src(const Unit& u, int lane) const { return (const char*)(RS + (size_t)u.pm * BM + lane * 4); }
    __device__ __forceinline__ void operator()(const f32x4 (&acc)[2][2][4][2], const Unit& u, int wr, int wc, int fr, int fq, LAS unsigned char* scr) const {
        const int lane = fr + 16 * fq;
        bf16_t* base = O + (size_t)(u.pm * BM + wr * 64) * DM + u.pn * BM + wc * 64;
#pragma unroll
        for (int ai = 0; ai < 2; ++ai)
#pragma unroll
            for (int m = 0; m < 4; ++m) {
                u32x4 c[2];
#pragma unroll
                for (int bj = 0; bj < 2; ++bj) { const f32x4 v0 = acc[ai][bj][m][0], v1 = acc[ai][bj][m][1];
                    c[bj].x = cvtpk(v0[0], v0[1]); c[bj].y = cvtpk(v0[2], v0[3]); c[bj].z = cvtpk(v1[0], v1[1]); c[bj].w = cvtpk(v1[2], v1[3]); }
                store_rows16(scr, fr, fq, lane, c[0], c[1], base + (size_t)(ai * HALF + m * 16) * DM, DM);
            }
    }
};
struct EpiX1 {
    static constexpr int PERM = 0; static constexpr bool HAS_BIAS = false; static constexpr bool MIDSCALE = false; static constexpr int NST = 0; const float* X; float* O;
    __device__ __forceinline__ const char* bias_src(const Unit&, int) const { return nullptr; }
    __device__ __forceinline__ void operator()(const f32x4 (&acc)[2][2][4][2], const Unit& u, int wr, int wc, int fr, int fq, LAS unsigned char* scr) const {
        const int row0 = u.pm * BM + wr * 64 + fr, col0 = u.pn * BM + wc * 32 + 4 * fq;
#pragma unroll
        for (int ai = 0; ai < 2; ++ai)
#pragma unroll
            for (int m = 0; m < 4; ++m) { const size_t off = (size_t)(row0 + ai * HALF + m * 16) * DM + col0;
#pragma unroll
                for (int bj = 0; bj < 2; ++bj)
#pragma unroll
                    for (int n = 0; n < 2; ++n) { const f32x4 xr = *(const f32x4*)(X + off + bj * HALF + n * 16); *(f32x4*)(O + off + bj * HALF + n * 16) = xr + acc[ai][bj][m][n]; } }
    }
};
struct EpiAct {
    static constexpr int PERM = 1; static constexpr bool HAS_BIAS = false; static constexpr bool MIDSCALE = false; static constexpr int NST = 0; bf16_t* O; const float* b1;
    __device__ __forceinline__ const char* bias_src(const Unit&, int) const { return nullptr; }
    __device__ __forceinline__ void operator()(const f32x4 (&acc)[2][2][4][2], const Unit& u, int wr, int wc, int fr, int fq, LAS unsigned char* scr) const {
        const int row0 = u.pm * BM + wr * 64 + fr, col0 = u.pn * 128 + wc * 32 + 8 * fq;
        const float* bp = b1 + (size_t)u.e * 2048 + col0;
        const f32x4 bg0 = *(const f32x4*)(bp), bg1 = *(const f32x4*)(bp + 4), bl0 = *(const f32x4*)(bp + 1024), bl1 = *(const f32x4*)(bp + 1028);
#pragma unroll
        for (int ai = 0; ai < 2; ++ai)
#pragma unroll
            for (int m = 0; m < 4; ++m) {
                const f32x4 g0 = acc[ai][0][m][0] + bg0, g1 = acc[ai][0][m][1] + bg1, l0 = acc[ai][1][m][0] + bl0, l1 = acc[ai][1][m][1] + bl1;
                u32x4 w; w.x = cvtpk(swiglu(g0[0], l0[0]), swiglu(g0[1], l0[1])); w.y = cvtpk(swiglu(g0[2], l0[2]), swiglu(g0[3], l0[3]));
                w.z = cvtpk(swiglu(g1[0], l1[0]), swiglu(g1[1], l1[1])); w.w = cvtpk(swiglu(g1[2], l1[2]), swiglu(g1[3], l1[3]));
                *(u32x4*)(O + (size_t)(row0 + ai * HALF + m * 16) * DM + col0) = w; }
    }
};
__device__ __forceinline__ unsigned pack4_fp8(float a, float b, float c, float d) {
    a = fminf(fmaxf(a, -448.f), 448.f); b = fminf(fmaxf(b, -448.f), 448.f); c = fminf(fmaxf(c, -448.f), 448.f); d = fminf(fmaxf(d, -448.f), 448.f);
    int p = __builtin_amdgcn_cvt_pk_fp8_f32(a, b, 0, false); p = __builtin_amdgcn_cvt_pk_fp8_f32(c, d, p, true); return (unsigned)p;
}
__device__ __forceinline__ unsigned pack4_fp8_nc(float a, float b, float c, float d) {
    int p = __builtin_amdgcn_cvt_pk_fp8_f32(a, b, 0, false); p = __builtin_amdgcn_cvt_pk_fp8_f32(c, d, p, true); return (unsigned)p;
}
struct EpiAct8 {
    static constexpr int PERM = 1; static constexpr bool HAS_BIAS = true; static constexpr bool MIDSCALE = false; static constexpr int NST = 8; unsigned char* O; const float* b1; const LAS float* bl;
    __device__ __forceinline__ const char* bias_src(const Unit& u, int lane) const { return (const char*)(b1 + (size_t)u.e * 2048 + (size_t)u.pn * 128 + (lane >> 5) * 1024) + (lane & 31) * 16; }
    __device__ __forceinline__ void operator()(const f32x4 (&acc)[2][2][4][2], const Unit& u, int wr, int wc, int fr, int fq, LAS unsigned char* scr) const {
        const int row0 = u.pm * BM + wr * 64 + fr, cl = wc * 32 + 8 * fq, col0 = u.pn * 128 + cl;
        const f32x4 bg0 = *(const LAS f32x4*)(bl + cl), bg1 = *(const LAS f32x4*)(bl + cl + 4), bl0 = *(const LAS f32x4*)(bl + 128 + cl), bl1 = *(const LAS f32x4*)(bl + 128 + cl + 4);
#pragma unroll
        for (int ai = 0; ai < 2; ++ai)
#pragma unroll
            for (int m = 0; m < 4; ++m) {
                const f32x4 g0 = acc[ai][0][m][0] + bg0, g1 = acc[ai][0][m][1] + bg1, l0 = acc[ai][1][m][0] + bl0, l1 = acc[ai][1][m][1] + bl1;
                const f32x2v s0 = swiglu_pk((f32x2v){g0[0], g0[1]}, (f32x2v){l0[0], l0[1]}), s1 = swiglu_pk((f32x2v){g0[2], g0[3]}, (f32x2v){l0[2], l0[3]});
                const f32x2v s2 = swiglu_pk((f32x2v){g1[0], g1[1]}, (f32x2v){l1[0], l1[1]}), s3 = swiglu_pk((f32x2v){g1[2], g1[3]}, (f32x2v){l1[2], l1[3]});
                u32x2 w; w.x = pack4_fp8_nc(s0.x, s0.y, s1.x, s1.y); w.y = pack4_fp8_nc(s2.x, s2.y, s3.x, s3.y);
                *(u32x2*)(O + (size_t)(row0 + ai * HALF + m * 16) * DM + col0) = w; }
    }
};
struct EpiY {
    static constexpr int PERM = 2; static constexpr bool HAS_BIAS = true; static constexpr bool MIDSCALE = false; static constexpr int NST = 16; bf16_t* O; const float* b2; const LAS float* bl;
    __device__ __forceinline__ const char* bias_src(const Unit& u, int lane) const { return (const char*)(b2 + (size_t)u.e * 1024 + (size_t)u.pn * 256) + lane * 16; }
    __device__ __forceinline__ void operator()(const f32x4 (&acc)[2][2][4][2], const Unit& u, int wr, int wc, int fr, int fq, LAS unsigned char* scr) const {
        const int lane = fr + 16 * fq, cl = wc * 64 + 16 * fq;
        f32x4 bv[2][2];
#pragma unroll
        for (int bj = 0; bj < 2; ++bj)
#pragma unroll
            for (int n = 0; n < 2; ++n) bv[bj][n] = *(const LAS f32x4*)(bl + cl + 8 * bj + 4 * n);
        bf16_t* base = O + (size_t)(u.pm * BM + wr * 64) * DM + u.pn * BM + wc * 64;
#pragma unroll
        for (int ai = 0; ai < 2; ++ai)
#pragma unroll
            for (int m = 0; m < 4; ++m) {
                u32x4 c[2];
#pragma unroll
                for (int bj = 0; bj < 2; ++bj) { const f32x4 v0 = acc[ai][bj][m][0] + bv[bj][0], v1 = acc[ai][bj][m][1] + bv[bj][1];
                    c[bj].x = cvtpk(v0[0], v0[1]); c[bj].y = cvtpk(v0[2], v0[3]); c[bj].z = cvtpk(v1[0], v1[1]); c[bj].w = cvtpk(v1[2], v1[3]); }
                store_rows16(scr, fr, fq, lane, c[0], c[1], base + (size_t)(ai * HALF + m * 16) * DM, DM);
            }
    }
};

struct EpiY8 {
    static constexpr int PERM = 2; static constexpr bool HAS_BIAS = true; static constexpr bool MIDSCALE = false; static constexpr int NST = 8; unsigned char* O; const float* b2; const LAS float* bl;
    __device__ __forceinline__ const char* bias_src(const Unit& u, int lane) const { return (const char*)(b2 + (size_t)u.e * 1024 + (size_t)u.pn * 256) + lane * 16; }
    __device__ __forceinline__ void operator()(const f32x4 (&acc)[2][2][4][2], const Unit& u, int wr, int wc, int fr, int fq, LAS unsigned char* scr) const {
        const int lane = fr + 16 * fq, cl = wc * 64 + 16 * fq;
        f32x4 bv[2][2];
#pragma unroll
        for (int bj = 0; bj < 2; ++bj)
#pragma unroll
            for (int n = 0; n < 2; ++n) bv[bj][n] = *(const LAS f32x4*)(bl + cl + 8 * bj + 4 * n);
        unsigned char* base = O + (size_t)(u.pm * BM + wr * 64) * DM + u.pn * BM + wc * 64;
        const int rrow = lane >> 2, rch = lane & 3;
#pragma unroll
        for (int ai = 0; ai < 2; ++ai)
#pragma unroll
            for (int mp = 0; mp < 2; ++mp) {
#pragma unroll
                for (int j = 0; j < 2; ++j) { const int m = 2 * mp + j;
                    const f32x4 a0 = acc[ai][0][m][0] + bv[0][0], a1 = acc[ai][0][m][1] + bv[0][1], a2 = acc[ai][1][m][0] + bv[1][0], a3 = acc[ai][1][m][1] + bv[1][1];
                    u32x4 w; w.x = pack4_fp8(a0[0], a0[1], a0[2], a0[3]); w.y = pack4_fp8(a1[0], a1[1], a1[2], a1[3]); w.z = pack4_fp8(a2[0], a2[1], a2[2], a2[3]); w.w = pack4_fp8(a3[0], a3[1], a3[2], a3[3]);
                    *(LAS u32x4*)(scr + j * 8192 + fr * 64 + ((fq ^ ((fr >> 1) & 3)) * 16)) = w; }
#pragma unroll
                for (int j = 0; j < 2; ++j) {
                    const u32x4 v = *(const LAS u32x4*)(scr + j * 8192 + rrow * 64 + ((rch ^ ((rrow >> 1) & 3)) * 16));
                    __builtin_nontemporal_store(v, (u32x4*)(base + (size_t)(ai * HALF + (2 * mp + j) * 16 + rrow) * DM + rch * 16)); }
            }
    }
};

template <class Prob, class Epi, bool ALIGN_EPI>
__device__ __forceinline__ void gemm_phase(LAS unsigned char* lds, const Prob& S, const Epi& E, int wave_) {
    const int tid = tid_of(wave_), wid = wave_, lane = tid & 63, wr = wid >> 2, wc = wid & 3, fr = lane & 15, fq = lane >> 4;
    constexpr int KB = Prob::KB, nt = KB / 128; constexpr bool F8 = Prob::F8;
    unsigned voffB[2]; int Rr[2], Cb[2];
#pragma unroll
    for (int i = 0; i < 2; ++i) { int R, C; stage_rc(tid * 16 + i * 8192, R, C);
        const int Rb = (Epi::PERM == 2) ? (64 * (R >> 5) + 16 * ((R & 15) >> 2) + 4 * ((R >> 4) & 1) + (R & 3)) : (Epi::PERM == 1) ? ((R & ~31) + perm32(R & 31)) : R;
        voffB[i] = (unsigned)(Rb * KB + C * 2); Rr[i] = R; Cb[i] = C * 2; }
    constexpr size_t kstep = (size_t)(BK * 2);
    constexpr size_t hstepB = (Epi::PERM == 2) ? (size_t)8 * KB : Prob::HSTEPB;
    const unsigned ldsw = (unsigned)wid * 1024u;
    const int aoff = lds_byte(wr * 64 + fr, fq * 8), boff = lds_byte(wc * 32 + fr, fq * 8), aoff1 = lds_byte(wr * 64 + fr, 32 + fq * 8), boff1 = lds_byte(wc * 32 + fr, 32 + fq * 8);
#define PG8_SA(b, h) (((b) * 2 + (h)) * HTB)
#define PG8_SB(b, h) ((4 + (b) * 2 + (h)) * HTB)
#define PG8_STAGE(bufoff, gbase, voff) do { _Pragma("unroll") for (int _i = 0; _i < 2; ++_i) \
        __builtin_amdgcn_global_load_lds((const unsigned*)((const char*)(gbase) + (voff)[_i]), (LAS unsigned*)(lds + (bufoff) + ldsw + _i * 8192), 16, 0, 0); } while (0)
#define PG8_LDA(dst, b, h) do { _Pragma("unroll") for (int m = 0; m < 4; ++m) { const i32x4 x0_ = *(const LAS i32x4*)(lds + PG8_SA(b, h) + aoff + m * 2048), x1_ = *(const LAS i32x4*)(lds + PG8_SA(b, h) + aoff1 + m * 2048); dst[m] = __builtin_shufflevector(x0_, x1_, 0, 1, 2, 3, 4, 5, 6, 7); } } while (0)
#define PG8_LDB(dst, b, h) do { _Pragma("unroll") for (int n = 0; n < 2; ++n) { const i32x4 x0_ = *(const LAS i32x4*)(lds + PG8_SB(b, h) + boff + n * 2048), x1_ = *(const LAS i32x4*)(lds + PG8_SB(b, h) + boff1 + n * 2048); dst[n] = __builtin_shufflevector(x0_, x1_, 0, 1, 2, 3, 4, 5, 6, 7); } } while (0)
#define PG8_MMA(ai, bj, At, Bt) do { __builtin_amdgcn_s_setprio(1); _Pragma("unroll") for (int m = 0; m < 4; ++m) _Pragma("unroll") for (int n = 0; n < 2; ++n) { \
        if constexpr (F8) asm volatile("s_nop 1\n\tv_mfma_scale_f32_16x16x128_f8f6f4 %0, %1, %2, %0, %3, %4 op_sel_hi:[0,0,0]" : "+v"(acc[ai][bj][m][n]) : "v"(Bt[n]), "v"(At[m]), "v"(scw), "v"(sca)); \
        else { acc[ai][bj][m][n] = __builtin_amdgcn_mfma_f32_16x16x32_bf16(__builtin_bit_cast(bf16x8, (i32x4)__builtin_shufflevector(Bt[n], Bt[n], 0, 1, 2, 3)), __builtin_bit_cast(bf16x8, (i32x4)__builtin_shufflevector(At[m], At[m], 0, 1, 2, 3)), acc[ai][bj][m][n], 0, 0, 0); \
               acc[ai][bj][m][n] = __builtin_amdgcn_mfma_f32_16x16x32_bf16(__builtin_bit_cast(bf16x8, (i32x4)__builtin_shufflevector(Bt[n], Bt[n], 4, 5, 6, 7)), __builtin_bit_cast(bf16x8, (i32x4)__builtin_shufflevector(At[m], At[m], 4, 5, 6, 7)), acc[ai][bj][m][n], 0, 0, 0); } } \
        __builtin_amdgcn_s_setprio(0); } while (0)
#define PG8_WAIT_V(n) asm volatile("s_waitcnt vmcnt(" #n ")" ::: "memory")
#define PG8_WAIT_L(n) asm volatile("s_waitcnt lgkmcnt(" #n ")" ::: "memory")
#define PG8_WAIT_VN(n) asm volatile("s_waitcnt vmcnt(%0)" :: "n"(n) : "memory")
#define PG8_BAR __builtin_amdgcn_s_barrier()
#define PG8_SCHED __builtin_amdgcn_sched_barrier(0)
    Unit cur, nxt; int ui = 0;
    if (!S.next(0, cur)) return;
    unsigned vaC[2][2], vaN[2][2];
    S.a_offs(0, cur, Rr, Cb, vaC);
    f32x4 acc[2][2][4][2];
#pragma unroll
    for (int a = 0; a < 2; ++a)
#pragma unroll
        for (int b = 0; b < 2; ++b)
#pragma unroll
            for (int m = 0; m < 4; ++m)
#pragma unroll
                for (int n = 0; n < 2; ++n) acc[a][b][m][n] = (f32x4){0.f, 0.f, 0.f, 0.f};
    i32x8 At[4], B0[2], B1[2];
    int scw = W8_SCALE_E8M0, sca = 127; asm volatile("" : "+v"(scw), "+v"(sca));
    const char* cA = S.a_base(cur); const char* cB = S.b_base(cur);
    PG8_STAGE(PG8_SB(0, 0), cB, voffB); PG8_STAGE(PG8_SB(0, 1), cB + hstepB, voffB); PG8_STAGE(PG8_SA(0, 0), cA, vaC[0]); PG8_STAGE(PG8_SA(0, 1), cA, vaC[1]);
    if (wr == 1) PG8_BAR;
    PG8_WAIT_V(2); PG8_BAR;
#if SCHED44
    PG8_STAGE(PG8_SB(1, 0), cB + kstep, voffB); PG8_STAGE(PG8_SA(1, 0), cA + kstep, vaC[0]);
#else
    PG8_STAGE(PG8_SB(1, 0), cB + kstep, voffB); PG8_STAGE(PG8_SA(1, 0), cA + kstep, vaC[0]); PG8_STAGE(PG8_SB(1, 1), cB + hstepB + kstep, voffB);
#endif
    PG8_WAIT_V(6); PG8_BAR;
#ifdef KREP
    int krep_ = 0;
#endif
    for (;;) {
        bool has_next = S.next(ui + 1, nxt);
#ifdef KREP
        const bool real_next_ = has_next; if (krep_ == 0) has_next = false;
#endif
        const char* nA = has_next ? S.a_base(nxt) : cA; const char* nB = has_next ? S.b_base(nxt) : cB;
        if (has_next) S.a_offs(ui + 1, nxt, Rr, Cb, vaN);
        else {
#pragma unroll
            for (int h = 0; h < 2; ++h)
#pragma unroll
                for (int i = 0; i < 2; ++i) vaN[h][i] = vaC[h][i]; }
#pragma unroll 1
        for (int t = 0; t < nt; t += 2) {
            const bool last = (t == nt - 2);
            const char* a1 = cA + (size_t)(t + 1) * kstep;
            const char* a2 = last ? nA : cA + (size_t)(t + 2) * kstep; const char* b2 = last ? nB : cB + (size_t)(t + 2) * kstep;
            const char* a3 = a2 + kstep; const char* b3 = b2 + kstep;
            unsigned v2[2][2];
#pragma unroll
            for (int h = 0; h < 2; ++h)
#pragma unroll
                for (int i = 0; i < 2; ++i) v2[h][i] = last ? vaN[h][i] : vaC[h][i];
            if constexpr (Epi::HAS_BIAS) { if (last) __builtin_amdgcn_global_load_lds((const unsigned*)E.bias_src(cur, lane), (LAS unsigned*)(lds + (BIAS_OFF - RING_OFF)), 16, 0, 0); }
            if constexpr (Epi::MIDSCALE) {
                if (t == 0) __builtin_amdgcn_global_load_lds((const unsigned*)E.scale_src(cur, lane), (LAS unsigned*)(lds + (BIAS_OFF - RING_OFF)), 16, 0, 0);
                if (t == nt / 2) {
                    const LAS float* sc_ = (const LAS float*)(lds + (BIAS_OFF - RING_OFF)) + wr * 64 + fr;
#pragma unroll
                    for (int a_ = 0; a_ < 2; ++a_)
#pragma unroll
                        for (int m_ = 0; m_ < 4; ++m_) { const float f_ = sc_[a_ * HALF + m_ * 16];
#pragma unroll
                            for (int b_ = 0; b_ < 2; ++b_)
#pragma unroll
                                for (int n_ = 0; n_ < 2; ++n_) acc[a_][b_][m_][n_] *= f_; }
                }
            }
#ifdef KREP
            const bool stq = (Epi::NST > 0) && (t == 0) && (ui > 0) && (krep_ == 0);
#else
            const bool stq = (Epi::NST > 0) && (t == 0) && (ui > 0);
#endif
#if SCHED44
            const char* b1h = cB + hstepB + (size_t)(t + 1) * kstep;
            PG8_LDB(B0, 0, 0); PG8_LDB(B1, 0, 1); PG8_SCHED; PG8_LDA(At, 0, 0); PG8_STAGE(PG8_SB(1, 1), b1h, voffB); PG8_STAGE(PG8_SA(1, 1), a1, vaC[1]);
            if (stq) PG8_WAIT_VN(8 + Epi::NST); else PG8_WAIT_V(8);
            PG8_WAIT_L(0); PG8_BAR; PG8_MMA(0, 0, At, B0); PG8_MMA(0, 1, At, B1); PG8_BAR; PG8_SCHED;
            PG8_LDA(At, 0, 1); PG8_STAGE(PG8_SB(0, 0), b2, voffB); PG8_STAGE(PG8_SA(0, 0), a2, v2[0]);
            PG8_WAIT_V(6); PG8_WAIT_L(0); PG8_BAR; PG8_MMA(1, 0, At, B0); PG8_MMA(1, 1, At, B1); PG8_BAR; PG8_SCHED;
            PG8_LDB(B0, 1, 0); PG8_LDB(B1, 1, 1); PG8_SCHED; PG8_LDA(At, 1, 0); PG8_STAGE(PG8_SB(0, 1), b2 + hstepB, voffB); PG8_STAGE(PG8_SA(0, 1), a2, v2[1]);
            PG8_WAIT_V(8); PG8_WAIT_L(0); PG8_BAR; PG8_MMA(0, 0, At, B0); PG8_MMA(0, 1, At, B1); PG8_BAR; PG8_SCHED;
            PG8_LDA(At, 1, 1); PG8_STAGE(PG8_SB(1, 0), b3, voffB); PG8_STAGE(PG8_SA(1, 0), a3, v2[0]);
            PG8_WAIT_V(6); PG8_WAIT_L(0); PG8_BAR; PG8_MMA(1, 0, At, B0); PG8_MMA(1, 1, At, B1); PG8_BAR; PG8_SCHED;
#else
            PG8_LDB(B0, 0, 0); PG8_LDB(B1, 0, 1); PG8_SCHED; PG8_LDA(At, 0, 0); PG8_STAGE(PG8_SA(1, 1), a1, vaC[1]);
            if (stq) PG8_WAIT_VN(8 + Epi::NST); else PG8_WAIT_V(8);
            PG8_WAIT_L(0); PG8_BAR; PG8_MMA(0, 0, At, B0); PG8_MMA(0, 1, At, B1); PG8_BAR; PG8_SCHED;
            PG8_LDA(At, 0, 1); PG8_STAGE(PG8_SB(0, 0), b2, voffB); PG8_STAGE(PG8_SB(0, 1), b2 + hstepB, voffB); PG8_STAGE(PG8_SA(0, 0), a2, v2[0]);
            if (stq) PG8_WAIT_VN(8 + Epi::NST); else PG8_WAIT_V(8);
            PG8_WAIT_L(0); PG8_BAR; PG8_MMA(1, 0, At, B0); PG8_MMA(1, 1, At, B1); PG8_BAR; PG8_SCHED;
            PG8_LDB(B0, 1, 0); PG8_LDB(B1, 1, 1); PG8_SCHED; PG8_LDA(At, 1, 0); PG8_STAGE(PG8_SA(0, 1), a2, v2[1]);
            PG8_WAIT_V(8); PG8_WAIT_L(0); PG8_BAR; PG8_MMA(0, 0, At, B0); PG8_MMA(0, 1, At, B1); PG8_BAR; PG8_SCHED;
            PG8_LDA(At, 1, 1); PG8_STAGE(PG8_SB(1, 0), b3, voffB); PG8_STAGE(PG8_SB(1, 1), b3 + hstepB, voffB); PG8_STAGE(PG8_SA(1, 0), a3, v2[0]);
            PG8_WAIT_V(8); PG8_WAIT_L(0); PG8_BAR; PG8_MMA(1, 0, At, B0); PG8_MMA(1, 1, At, B1); PG8_BAR; PG8_SCHED;
#endif
        }
#ifdef KREP
        if (krep_ == 0) { krep_ = 1;
            _Pragma("unroll") for (int a = 0; a < 2; ++a) _Pragma("unroll") for (int b = 0; b < 2; ++b) _Pragma("unroll") for (int m = 0; m < 4; ++m) _Pragma("unroll") for (int n = 0; n < 2; ++n) acc[a][b][m][n] = (f32x4){0.f, 0.f, 0.f, 0.f};
            continue; }
        krep_ = 0; has_next = real_next_;
#endif
        if constexpr (ALIGN_EPI) { if (wr == 0) PG8_BAR; }
        if constexpr (F8) asm volatile("s_nop 15\n\ts_nop 15" ::: "memory");
        E(acc, cur, wr, wc, fr, fq, lds + PG8_SA(1, 1) + ldsw);
#ifdef EPI_TWICE
        asm volatile("" ::: "memory"); E(acc, cur, wr, wc, fr, fq, lds + PG8_SA(1, 1) + ldsw);
#endif
#ifdef EPI_DUMMY
        { asm volatile("" ::: "memory"); unsigned char* dp = S.dummy + ((size_t)(blockIdx.x * 8 + wid) * 16) * 1024 + lane * 16;
          const u32x4 w_ = __builtin_bit_cast(u32x4, acc[0][0][0][0]);
          _Pragma("unroll") for (int q_ = 0; q_ < 16; ++q_) { *(volatile u32x4*)(dp + q_ * 1024) = w_; } }
#endif
        if (!has_next) break;
#pragma unroll
        for (int a = 0; a < 2; ++a)
#pragma unroll
            for (int b = 0; b < 2; ++b)
#pragma unroll
                for (int m = 0; m < 4; ++m)
#pragma unroll
                    for (int n = 0; n < 2; ++n) acc[a][b][m][n] = (f32x4){0.f, 0.f, 0.f, 0.f};
        cur = nxt; cA = nA; cB = nB; ++ui;
#pragma unroll
        for (int h = 0; h < 2; ++h)
#pragma unroll
            for (int i = 0; i < 2; ++i) vaC[h][i] = vaN[h][i];
        if constexpr (ALIGN_EPI) { if (wr == 1) PG8_BAR; }
    }
    PG8_WAIT_V(0);
    if constexpr (!ALIGN_EPI) { if (wr == 0) PG8_BAR; }
    PG8_BAR;
#undef PG8_SA
#undef PG8_SB
#undef PG8_STAGE
#undef PG8_LDA
#undef PG8_LDB
#undef PG8_MMA
#undef PG8_WAIT_V
#undef PG8_WAIT_L
#undef PG8_WAIT_VN
#undef PG8_BAR
#undef PG8_SCHED
}
}

#define XB_TMO      128
#define XB_XCNT(j)  (256  + 64 * (j))
#define XB_XSUB(j)  (1280 + 64 * (j))
#define XB_XGEN(j)  (2304 + 64 * (j))
#define XB_TOP      3328
#define XB_TOPGEN   3392
#define XCD_BAR_WORDS 3456
#define XB_SPIN_CAP (1u << 18)
__device__ __forceinline__ unsigned xb_ld(unsigned* p)              { return __hip_atomic_load(p, __ATOMIC_RELAXED, __HIP_MEMORY_SCOPE_AGENT); }
__device__ __forceinline__ unsigned xb_add(unsigned* p, unsigned v) { return __hip_atomic_fetch_add(p, v, __ATOMIC_RELAXED, __HIP_MEMORY_SCOPE_AGENT); }
__device__ __forceinline__ unsigned xb_xcc_id() { return (unsigned)__builtin_amdgcn_s_getreg((3 << 11) | 20) & 0xFu; }
#define XB_SPIN(cond, bar) do { unsigned _sp = 0; while (cond) { __builtin_amdgcn_s_sleep(1); \
    if ((++_sp & 255u) == 0u) { if (xb_ld(&(bar)[XB_TMO])) break; if (_sp > XB_SPIN_CAP) { atomicAdd(&(bar)[XB_TMO], 1u); break; } } } } while (0)
struct XcdBarrier { unsigned* bar; unsigned x; volatile LAS unsigned* st; int wave; };
__device__ __forceinline__ XcdBarrier xcd_barrier_post(unsigned* bar, volatile LAS unsigned* st, int wave) {
    XcdBarrier b; b.bar = bar; b.x = xb_xcc_id(); b.st = st; b.wave = wave;
    if (tid_of(wave) == 0) (void)xb_add(&bar[XB_XCNT(b.x)], 1u);
    return b;
}
__device__ __forceinline__ void xcd_barrier_complete(unsigned* bar, unsigned x, unsigned& nloc, unsigned& nx) {
    const unsigned G = gridDim.x * gridDim.y * gridDim.z;
    unsigned sum, cnt, mine, sp = 0u;
    for (;;) {
        sum = 0u; cnt = 0u; mine = 0u;
#pragma unroll
        for (unsigned j = 0; j < 16; ++j) { const unsigned c = xb_ld(&bar[XB_XCNT(j)]); sum += c; cnt += (c > 0u) ? 1u : 0u; mine = (j == x) ? c : mine; }
        if (sum == G) break;
        __builtin_amdgcn_s_sleep(1);
        if ((++sp & 255u) == 0u) { if (xb_ld(&bar[XB_TMO])) break; if (sp > XB_SPIN_CAP) { atomicAdd(&bar[XB_TMO], 1u); break; } }
    }
    nloc = mine > 0u ? mine : 1u; nx = cnt > 0u ? cnt : 1u;
}
__device__ __forceinline__ void xcd_barrier(const XcdBarrier& b) {
    asm volatile("s_waitcnt vmcnt(0)" ::: "memory");
    __syncthreads();
    if (tid_of(b.wave) == 0) {
        unsigned* bar = b.bar;
        __builtin_amdgcn_s_waitcnt(0);
        unsigned nloc = b.st[0], nx = b.st[1];
        if (nloc == 0u) { xcd_barrier_complete(bar, b.x, nloc, nx); b.st[0] = nloc; b.st[1] = nx; }
        const unsigned old = xb_add(&bar[XB_XSUB(b.x)], 1u);
        const unsigned gen = old / nloc;
        if (old + 1u == (gen + 1u) * nloc) {
            __builtin_amdgcn_fence(__ATOMIC_RELEASE, "agent");
            asm volatile("s_waitcnt vmcnt(0)" ::: "memory");
            const unsigned og = xb_add(&bar[XB_TOP], 1u);
            const unsigned tg = og / nx;
            if (og + 1u == (tg + 1u) * nx) xb_add(&bar[XB_TOPGEN], 1u);
            else XB_SPIN(xb_ld(&bar[XB_TOPGEN]) == tg, bar);
            __builtin_amdgcn_fence(__ATOMIC_ACQUIRE, "agent");
            xb_add(&bar[XB_XGEN(b.x)], 1u);
            asm volatile("s_waitcnt vmcnt(0)" ::: "memory");
        } else {
            XB_SPIN(xb_ld(&bar[XB_XGEN(b.x)]) == gen, bar);
            __builtin_amdgcn_fence(__ATOMIC_ACQUIRE, "agent");
            asm volatile("s_waitcnt vmcnt(0)" ::: "memory");
        }
    }
    __syncthreads();
}

struct MkArgs {
    const float *x, *g_mix, *w_in, *conv_w, *sinks, *g_ao, *g_co, *w_out, *g_ffn, *w_router, *b_router, *w1, *b1, *w2, *b2, *g_final;
    float* out; unsigned char* ws; int ph_lo, ph_hi;
};
struct Frame {
    LAS unsigned char* lds; int tid, lane, wave, G, bx;
};

__device__ __forceinline__ void phase_stagger(const Frame& F, int nwg, unsigned half_unit_ticks) {
    const int rem = nwg % F.G;
    if (rem != 0 && F.bx >= rem && half_unit_ticks != 0u) {
        const unsigned long long t0 = __builtin_amdgcn_s_memrealtime();
        while (__builtin_amdgcn_s_memrealtime() - t0 < (unsigned long long)half_unit_ticks) __builtin_amdgcn_s_sleep(32);
    }
    __syncthreads();
}
__device__ __forceinline__ int win_srccol(int n) {
    if (n < 1280) return n;
    const int t = (n - 1280) >> 8, c = (n - 1280) & 255, g16 = c >> 4, w = c & 15, bj = w >> 3, k8 = w & 7;
    return (bj ? 1792 : 1280) + t * 128 + g16 * 8 + k8;
}
__device__ __forceinline__ void p0_transpose_item(const float* W, int K, int N, bf16_t* WT, const float* g0, const float* g1, int split, LAS unsigned char* scr, int item, int lane, bool cperm = false) {
    const int nblk = N / 64, kb = item / nblk, nb = item % nblk, k0 = 64 * kb, n = cperm ? win_srccol(64 * nb + lane) : 64 * nb + lane;
    const float* src = W + (size_t)k0 * N + n;
    float v[64];
#pragma unroll
    for (int i = 0; i < 64; ++i) v[i] = __builtin_nontemporal_load(src + (size_t)i * N);
#pragma unroll
    for (int q = 0; q < 8; ++q) {
        float w[8];
#pragma unroll
        for (int i = 0; i < 8; ++i) { const int k = k0 + 8 * q + i; const float gg = g0 ? (k < split ? g0[k] : g1[k - split]) : 1.f; w[i] = v[8 * q + i] * gg; }
        u32x4 o; o.x = cvtpk(w[0], w[1]); o.y = cvtpk(w[2], w[3]); o.z = cvtpk(w[4], w[5]); o.w = cvtpk(w[6], w[7]);
        *(LAS u32x4*)(scr + lane * 128 + ((q ^ (lane & 7)) * 16)) = o;
    }
    LDS_WAIT(); asm volatile("" ::: "memory");
#pragma unroll
    for (int j = 0; j < 8; ++j) {
        const int nl = 8 * j + (lane >> 3), ch = lane & 7;
        const u32x4 o = *(const LAS u32x4*)(scr + nl * 128 + ((ch ^ (nl & 7)) * 16));
        *(u32x4*)(WT + (size_t)(64 * nb + nl) * K + k0 + 8 * ch) = o;
    }
    LDS_WAIT(); asm volatile("" ::: "memory");
}
__device__ __forceinline__ void p0_transpose_item8(const float* W, int K, int N, unsigned char* WT, const float* g0, LAS unsigned char* scr, int item, int lane) {
    const int nblk = N / 64, kb = item / nblk, nb = item % nblk, k0 = 128 * kb, n = 64 * nb + lane;
    const float* src = W + (size_t)k0 * N + n;
    float v[128];
#pragma unroll
    for (int i = 0; i < 128; ++i) v[i] = __builtin_nontemporal_load(src + (size_t)i * N);
    constexpr float SC = (float)(1 << W8_SHIFT);
#pragma unroll
    for (int q = 0; q < 8; ++q) {
        float w[16];
#pragma unroll
        for (int i = 0; i < 16; ++i) { const int k = k0 + 16 * q + i; const float gg = g0 ? g0[k] * SC : SC; w[i] = v[16 * q + i] * gg; }
        u32x4 o; o.x = pg8::pack4_fp8(w[0], w[1], w[2], w[3]); o.y = pg8::pack4_fp8(w[4], w[5], w[6], w[7]); o.z = pg8::pack4_fp8(w[8], w[9], w[10], w[11]); o.w = pg8::pack4_fp8(w[12], w[13], w[14], w[15]);
        *(LAS u32x4*)(scr + lane * 128 + ((q ^ (lane & 7)) * 16)) = o;
    }
    LDS_WAIT(); asm volatile("" ::: "memory");
#pragma unroll
    for (int j = 0; j < 8; ++j) {
        const int nl = 8 * j + (lane >> 3), ch = lane & 7;
        const u32x4 o = *(const LAS u32x4*)(scr + nl * 128 + ((ch ^ (nl & 7)) * 16));
        __builtin_nontemporal_store(o, (u32x4*)(WT + (size_t)(64 * nb + nl) * K + k0 + 16 * ch));
    }
    LDS_WAIT(); asm volatile("" ::: "memory");
}
__device__ __forceinline__ void p0_prologue(const Frame& F, const MkArgs& a, int item_lo, int item_hi, int gw, int NGW, bool rows) {
    unsigned char* ws = a.ws;
    bf16_t* Win_t = (bf16_t*)(ws + WS_WIN); bf16_t* Wout_t = (bf16_t*)(ws + WS_WOUT); float* WR = (float*)(ws + WS_WR);
    bf16_t* W1_t = (bf16_t*)(ws + WS_W1); bf16_t* W2_t = (bf16_t*)(ws + WS_W2); bf16_t* XN = (bf16_t*)(ws + WS_XN);
    LAS unsigned char* scr = F.lds + RING_OFF + F.wave * 8192;
    constexpr int I_IN = (DM / 64) * (INC / 64), I_OUT = (DM / 64) * (DM / 64), I_W1E = (DM / (MOE_FP8 ? 128 : 64)) * (2048 / 64), I_W2E = (DFF / (MOE_FP8 ? 128 : 64)) * (DM / 64);
    constexpr int NITEMS = I_IN + I_OUT + NE * I_W1E + NE * I_W2E;
    if (item_hi > NITEMS) item_hi = NITEMS;
    for (int it = item_lo + gw; it < item_hi; it += NGW) {
        int r = it;
        if (r < I_IN) { p0_transpose_item(a.w_in, DM, INC, Win_t, a.g_mix, a.g_mix, DM, scr, r, F.lane, true); continue; } r -= I_IN;
        if (r < I_OUT) { p0_transpose_item(a.w_out, DM, DM, Wout_t, a.g_ao, a.g_co, 512, scr, r, F.lane); continue; } r -= I_OUT;
#if MOE_FP8
        if (r < NE * I_W1E) { const int e = r / I_W1E; p0_transpose_item8(a.w1 + (size_t)e * DM * 2048, DM, 2048, (unsigned char*)W1_t + (size_t)e * 2048 * DM, nullptr, scr, r % I_W1E, F.lane); continue; } r -= NE * I_W1E;
        { const int e = r / I_W2E; p0_transpose_item8(a.w2 + (size_t)e * DFF * DM, DFF, DM, (unsigned char*)W2_t + (size_t)e * DM * DFF, nullptr, scr, r % I_W2E, F.lane); }
#else
        if (r < NE * I_W1E) { const int e = r / I_W1E; p0_transpose_item(a.w1 + (size_t)e * DM * 2048, DM, 2048, W1_t + (size_t)e * 2048 * DM, a.g_ffn, a.g_ffn, DM, scr, r % I_W1E, F.lane); continue; } r -= NE * I_W1E;
        { const int e = r / I_W2E; p0_transpose_item(a.w2 + (size_t)e * DFF * DM, DFF, DM, W2_t + (size_t)e * DM * DFF, nullptr, nullptr, 0, scr, r % I_W2E, F.lane); }
#endif
    }
    if (!rows) return;
    for (int i = (F.bx * NTHREADS + F.tid); i < DM * NE; i += F.G * NTHREADS) WR[i] = a.w_router[i] * a.g_ffn[i >> 5];
    for (int m0 = 8 * gw; m0 < NTOK; m0 += 8 * NGW) {
        f32x4 v[8][4];
#pragma unroll
        for (int r = 0; r < 8; ++r) { const f32x4* xr = (const f32x4*)(a.x + (size_t)(m0 + r) * DM) + F.lane;
#pragma unroll
            for (int j = 0; j < 4; ++j) v[r][j] = __builtin_nontemporal_load(xr + 64 * j); }
#pragma unroll
        for (int r = 0; r < 8; ++r) {
            float s2 = 0.f;
#pragma unroll
            for (int j = 0; j < 4; ++j) s2 += (v[r][j].x * v[r][j].x + v[r][j].y * v[r][j].y) + (v[r][j].z * v[r][j].z + v[r][j].w * v[r][j].w);
            const float ms = wave_sum(s2) * (1.f / DM) + EPS, rstd = rsqrtf(ms);
            if (F.lane == 0) ((float*)(ws + WS_RSXI))[m0 + r] = ms * rstd;
            u32x2* o8 = (u32x2*)(XN + (size_t)(m0 + r) * DM) + F.lane;
#pragma unroll
            for (int j = 0; j < 4; ++j) { u32x2 w; w.x = cvtpk(v[r][j].x * rstd, v[r][j].y * rstd); w.y = cvtpk(v[r][j].z * rstd, v[r][j].w * rstd); o8[64 * j] = w; }
        }
    }
}

constexpr int A_KOFF = 0, A_VOFF = 32768, A_HK = 65536, A_WSF = 131072, A_OST = A_WSF + 2048, A_SSQ = A_OST + 16384;
static_assert(A_SSQ + 1024 <= MISC_OFF, "P2 LDS map");
__device__ __forceinline__ int crow(int r, int hi) { return (r & 3) + 8 * (r >> 2) + 4 * hi; }
typedef short v4i16_t __attribute__((ext_vector_type(4)));
__device__ __forceinline__ s16x4 vtr(const LAS unsigned char* p) { return __builtin_bit_cast(s16x4, __builtin_amdgcn_ds_read_tr16_b64_v4i16((LAS v4i16_t*)p)); }

__device__ __forceinline__ void attn_core(const Frame& F, bf16x8 (&qr)[4], const bf16_t* qnext, int nb, int hk, int qt, float slope2, float sink2, f32x16 (&o)[2], float& l_out) {
    LAS unsigned char* L = F.lds;
    const int lane = F.lane, r32 = lane & 31, hi = lane >> 5;
    f32x16 p[5];
    const LAS unsigned char* kb = L + hk * A_HK + A_KOFF + hi * 4096 + r32 * 16 + qt * 512;
#pragma unroll
    for (int j = 0; j < 5; ++j) {
#pragma unroll
        for (int r = 0; r < 16; ++r) p[j][r] = 0.f;
#pragma unroll
        for (int d0 = 0; d0 < 4; ++d0) { const bf16x8 kf = *(const LAS bf16x8*)(kb + d0 * 8192 + j * 512); p[j] = __builtin_amdgcn_mfma_f32_32x32x16_bf16(kf, qr[d0], p[j], 0, 0, 0); }
        __builtin_amdgcn_sched_barrier(0);
    }
#pragma unroll
    for (int d0 = 0; d0 < 4; ++d0) qr[d0] = *(const bf16x8*)(qnext + d0 * 16);
    __builtin_amdgcn_sched_barrier(0);
    int dl = r32 - 4 * hi; asm volatile("" : "+v"(dl));
    const float basef = slope2 * (float)dl;
    float mx = sink2;
#pragma unroll
    for (int j = 0; j < 5; ++j) {
        const bool dead = (nb == 0) && (qt + j < 4);
#pragma unroll
        for (int r = 0; r < 16; ++r) {
            const int cc = (r & 3) + 8 * (r >> 2);
            bool ok = (j == 0) ? (dl < cc) : ((j == 4) ? (cc <= dl) : true);
            ok = ok && !dead;
            const float v = ok ? ((p[j][r] - basef) - slope2 * (float)(128 - 32 * j - cc)) : -INFINITY;
            p[j][r] = v; mx = fmaxf(mx, v);
        }
    }
    { float lo_, hi_; wave_halves(mx, lo_, hi_); mx = fmaxf(lo_, hi_); }
    float sum = 0.f;
    u32x4 pk[5][2];
#pragma unroll
    for (int j = 0; j < 5; ++j) {
#pragma unroll
        for (int s = 0; s < 2; ++s) {
            float e[8];
#pragma unroll
            for (int i = 0; i < 8; ++i) { e[i] = __builtin_amdgcn_exp2f(p[j][8 * s + i] - mx); sum += e[i]; }
            pk[j][s].x = cvtpk(e[0], e[1]); pk[j][s].y = cvtpk(e[2], e[3]); pk[j][s].z = cvtpk(e[4], e[5]); pk[j][s].w = cvtpk(e[6], e[7]);
        }
        __builtin_amdgcn_sched_barrier(0);
    }
    { float lo_, hi_; wave_halves(sum, lo_, hi_); sum = lo_ + hi_; }
    const float l = sum + __builtin_amdgcn_exp2f(sink2 - mx);
#pragma unroll
    for (int r = 0; r < 16; ++r) { o[0][r] = 0.f; o[1][r] = 0.f; }
    const LAS unsigned char* vb = L + hk * A_HK + A_VOFF + ((lane >> 4) & 1) * 32 + (lane & 3) * 8 + (4 * hi + ((lane & 15) >> 2)) * 64 + qt * 2048;
#pragma unroll
    for (int j = 0; j < 5; ++j)
#pragma unroll
        for (int s = 0; s < 2; ++s) {
            const bf16x8 pa = __builtin_bit_cast(bf16x8, pk[j][s]);
#pragma unroll
            for (int d0 = 0; d0 < 2; ++d0) {
                const LAS unsigned char* ap = vb + d0 * 16384 + (2 * j + s) * 1024;
                const s16x4 lo = vtr(ap), hh = vtr(ap + 512);
                const bf16x8 vf = (bf16x8){lo[0], lo[1], lo[2], lo[3], hh[0], hh[1], hh[2], hh[3]};
                o[d0] = __builtin_amdgcn_mfma_f32_32x32x16_bf16(pa, vf, o[d0], 0, 0, 0);
            }
            if (s == 1) __builtin_amdgcn_sched_barrier(0);
        }
    l_out = l;
}
__device__ __forceinline__ void attn_store(const Frame& F, const f32x16 (&o)[2], float l, bf16_t* MIX, int row0, int h, int qt, float (&sq)[4]) {
    LAS unsigned char* L = F.lds;
    const int lane = F.lane, r32 = lane & 31, hi = lane >> 5;
    LAS float* wsf = (LAS float*)(L + A_WSF) + F.wave * 64;
    if (hi == 0) wsf[r32] = l;
    LDS_WAIT();
    LAS bf16_t* stg = (LAS bf16_t*)(L + A_OST) + F.wave * 1024;
#pragma unroll
    for (int R = 0; R < 2; ++R) {
#pragma unroll
        for (int rr = 0; rr < 8; ++rr) { const int r = 8 * R + rr, c = crow(r, hi); const float rl = __builtin_amdgcn_rcpf(wsf[c]); const int cl = (rr & 3) + 8 * (rr >> 2) + 4 * hi;
            const unsigned pk_ = cvtpk(o[0][r] * rl, o[1][r] * rl);
            stg[cl * 64 + r32] = (bf16_t)(pk_ & 0xffffu); stg[cl * 64 + 32 + r32] = (bf16_t)(pk_ >> 16); }
        LDS_WAIT();
#pragma unroll
        for (int i = 0; i < 2; ++i) {
            const int row = i * 8 + (lane >> 3), ch = lane & 7;
            const u32x4 v = *(const LAS u32x4*)(stg + row * 64 + ch * 8);
            *(u32x4*)(MIX + (size_t)(row0 + qt * 32 + 16 * R + row) * DM + h * 64 + ch * 8) = v;
            float s2 = 0.f;
#pragma unroll
            for (int q = 0; q < 4; ++q) { const float a = __uint_as_float(v[q] << 16), b = __uint_as_float(v[q] & 0xffff0000u); s2 += a * a + b * b; }
            s2 = sum8(s2);
            sq[2 * R + i] += s2;
        }
        LDS_WAIT();
    }
}

struct ConvRegs { u32x4 uu[4], bb[4]; };
struct ConvHalo { u32x4 uu[2]; f32x4 w[3][2]; };
__device__ __forceinline__ void conv_issue(ConvRegs& R, const bf16_t* P, int row0, int rl0, int lane) {
    const int c0 = lane * 8;
    const bf16_t* pr = P + (size_t)(row0 + rl0) * INCP;
#pragma unroll
    for (int i = 0; i < 4; ++i) { const bf16_t* q = pr + (size_t)i * INCP;
        R.bb[i] = __builtin_nontemporal_load((const u32x4*)(q + 768 + c0));
        if (i < 2) R.uu[i] = __builtin_nontemporal_load((const u32x4*)(q + 1280 + c0));
        else R.uu[i] = *(const u32x4*)(q + 1280 + c0); }
}
__device__ __forceinline__ void conv_halo(ConvHalo& H, const MkArgs& a, const bf16_t* P, int row0, int nb, int rl0, int lane) {
    const int c0 = lane * 8;
    const float* cwp = a.conv_w; asm volatile("" : "+s"(cwp));
    const bf16_t* pr = P + (size_t)(row0 + rl0 - 2) * INCP;
    const bool halo = (nb > 0) || (rl0 > 0);
#pragma unroll
    for (int i = 0; i < 2; ++i) { H.uu[i] = (u32x4){0u, 0u, 0u, 0u};
        if (halo) H.uu[i] = *(const u32x4*)(pr + (size_t)i * INCP + 1280 + c0); }
#pragma unroll
    for (int d = 0; d < 3; ++d) { H.w[d][0] = *(const f32x4*)(cwp + d * CONVW + c0); H.w[d][1] = *(const f32x4*)(cwp + d * CONVW + c0 + 4); }
}
__device__ __forceinline__ void conv_finish(const ConvRegs& R, const ConvHalo& H, bf16_t* MIX, int row0, int rl0, int lane) {
    const int c0 = lane * 8;
    float cw[3][8];
#pragma unroll
    for (int d = 0; d < 3; ++d) { const f32x4 w0 = H.w[d][0], w1 = H.w[d][1];
        cw[d][0] = w0.x; cw[d][1] = w0.y; cw[d][2] = w0.z; cw[d][3] = w0.w; cw[d][4] = w1.x; cw[d][5] = w1.y; cw[d][6] = w1.z; cw[d][7] = w1.w; }
    float u2[8], u1[8];
#pragma unroll
    for (int q = 0; q < 4; ++q) { u2[2 * q] = __uint_as_float(H.uu[0][q] << 16); u2[2 * q + 1] = __uint_as_float(H.uu[0][q] & 0xffff0000u);
        u1[2 * q] = __uint_as_float(H.uu[1][q] << 16); u1[2 * q + 1] = __uint_as_float(H.uu[1][q] & 0xffff0000u); }
#pragma unroll
    for (int r = 0; r < 4; ++r) {
        float y[8], u0[8], s2 = 0.f;
#pragma unroll
        for (int q = 0; q < 4; ++q) {
            u0[2 * q] = __uint_as_float(R.uu[r][q] << 16); u0[2 * q + 1] = __uint_as_float(R.uu[r][q] & 0xffff0000u);
            y[2 * q] = __uint_as_float(R.bb[r][q] << 16) * (cw[0][2 * q] * u2[2 * q] + cw[1][2 * q] * u1[2 * q] + cw[2][2 * q] * u0[2 * q]);
            y[2 * q + 1] = __uint_as_float(R.bb[r][q] & 0xffff0000u) * (cw[0][2 * q + 1] * u2[2 * q + 1] + cw[1][2 * q + 1] * u1[2 * q + 1] + cw[2][2 * q + 1] * u0[2 * q + 1]);
            s2 += y[2 * q] * y[2 * q] + y[2 * q + 1] * y[2 * q + 1];
        }
        const float rc = rsqrtf(wave_sum(s2) * (1.f / CONVW) + EPS);
        u32x4 w; w.x = cvtpk(y[0] * rc, y[1] * rc); w.y = cvtpk(y[2] * rc, y[3] * rc); w.z = cvtpk(y[4] * rc, y[5] * rc); w.w = cvtpk(y[6] * rc, y[7] * rc);
        *(u32x4*)(MIX + (size_t)(row0 + rl0 + r) * DM + 512 + c0) = w;
#pragma unroll
        for (int q = 0; q < 8; ++q) { u2[q] = u1[q]; u1[q] = u0[q]; }
    }
}

__device__ __forceinline__ void p2_attn_conv(const Frame& F, const MkArgs& a) {
    const bf16_t* P = (const bf16_t*)(a.ws + WS_P); bf16_t* MIX = (bf16_t*)(a.ws + WS_MIX);
    LAS unsigned char* L = F.lds;
    const int wave = F.wave;
    for (int unit = F.bx; unit < NTOK / 128; unit += F.G) {
        const int tid = tid_of(wave);
        const int lane = tid & 63;
        Frame Fl = F; Fl.tid = tid; Fl.lane = lane;
        const int b = unit >> 7, nb = unit & 127, row0 = b * SEQ + nb * 128;
        const int qt = wave & 3, gw = wave >> 2, r32 = lane & 31, hi = lane >> 5;
        const bf16_t* Qp = P + (size_t)(row0 + qt * 32 + r32) * INCP + hi * 8;
        bf16x8 qc[4];
#pragma unroll
        for (int d0 = 0; d0 < 4; ++d0) qc[d0] = *(const bf16x8*)(Qp + gw * 64 + d0 * 16);
        ConvRegs CR;
        conv_issue(CR, P, row0, wave * 16, lane);
        __syncthreads();
        {
            u32x4 kvr[8], vvr[8];
#pragma unroll
            for (int i = 0; i < 8; ++i) {
                const int idx = tid + 512 * i, hk = idx >> 11, key = (idx >> 3) & 255, ch = idx & 7;
                const bool ok = (nb > 0) || (key >= 128);
                const bf16_t* src = P + (size_t)(row0 + (ok ? key - 128 : 0)) * INCP + 512 + hk * 64 + ch * 8;
                kvr[i] = *(const u32x4*)src; vvr[i] = *(const u32x4*)(src + 128);
            }
#pragma unroll
            for (int i = 0; i < 8; ++i) {
                const int idx = tid + 512 * i, hk = idx >> 11, key = (idx >> 3) & 255, ch = idx & 7;
                const bool ok = (nb > 0) || (key >= 128);
                const u32x4 z = (u32x4){0u, 0u, 0u, 0u};
                *(LAS u32x4*)(L + hk * A_HK + A_KOFF + ch * 4096 + key * 16) = ok ? kvr[i] : z;
                *(LAS u32x4*)(L + hk * A_HK + A_VOFF + (ch >> 2) * 16384 + (key >> 4) * 1024 + (key & 15) * 64 + (ch & 3) * 16) = ok ? vvr[i] : z;
            }
        }
        __syncthreads();
        {
            float sq[4] = {0.f, 0.f, 0.f, 0.f};
#pragma unroll 1
            for (int s = 0; s < 4; ++s) {
                const int hk = s >> 1, g = gw + 2 * (s & 1), h = hk * 4 + g;
                const float slope2 = __builtin_amdgcn_exp2f(-(float)(h + 1)) * LOG2E, sink2 = a.sinks[h] * LOG2E;
                f32x16 o[2]; float l;
                const int sn = s < 3 ? s + 1 : 3, hn = (sn >> 1) * 4 + gw + 2 * (sn & 1);
                attn_core(Fl, qc, Qp + hn * 64, nb, hk, qt, slope2, sink2, o, l);
                __builtin_amdgcn_sched_barrier(0);
                ConvHalo CH; conv_halo(CH, a, P, row0, nb, wave * 16 + s * 4, lane);
                __builtin_amdgcn_sched_barrier(0);
                attn_store(Fl, o, l, MIX, row0, h, qt, sq);
                conv_finish(CR, CH, MIX, row0, wave * 16 + s * 4, lane);
                if (s < 3) conv_issue(CR, P, row0, wave * 16 + (s + 1) * 4, lane);
            }
            const int l2 = tid_of(wave) & 63;
            if ((l2 & 7) == 0) {
                LAS float* part = (LAS float*)(L + A_SSQ) + wave * 32 + (l2 >> 3);
#pragma unroll
                for (int i = 0; i < 4; ++i) part[i * 8] = sq[i];
            }
        }
        __syncthreads();
        if (tid < 128) { const LAS float* part = (const LAS float*)(L + A_SSQ); const int qt = tid >> 5, r = tid & 31;
            const float s = part[qt * 32 + r] + part[(qt + 4) * 32 + r];
            ((float*)(a.ws + WS_RSA))[row0 + tid] = rsqrtf(s * (1.f / ATTW) + EPS); }
    }
    __syncthreads();
}

constexpr int R_XT = 0, R_PITCH = 4112, R_PART = 32 * R_PITCH, R_RSTD = R_PART + 128 * 33 * 4, R_HIST = R_RSTD + 512, R_BASE = R_HIST + 128;
static_assert(R_BASE + 128 <= MISC_OFF, "P4 LDS map");
__device__ __forceinline__ void split_bf16x8(const float (&a)[8], bf16x8& hi, bf16x8& lo) {
    u32x4 h, l;
#pragma unroll
    for (int q = 0; q < 4; ++q) { const unsigned pk = cvtpk(a[2 * q], a[2 * q + 1]); h[q] = pk;
        l[q] = cvtpk(a[2 * q] - __uint_as_float(pk << 16), a[2 * q + 1] - __uint_as_float(pk & 0xffff0000u)); }
    hi = __builtin_bit_cast(bf16x8, h); lo = __builtin_bit_cast(bf16x8, l);
}
__device__ __forceinline__ void p4_router(const Frame& F, const MkArgs& a, bool dummy) {
    const bf16_t* XNp = (const bf16_t*)(a.ws + WS_XN); const float* RSXI = (const float*)(a.ws + WS_RSXI); const bf16_t* MO = (const bf16_t*)(a.ws + WS_MO); bf16_t* X1B = (bf16_t*)(a.ws + WS_X1B); const float* WR = (const float*)(a.ws + WS_WR); bf16_t* H2 = (bf16_t*)(a.ws + WS_H2);
    unsigned* gcnt = (unsigned*)(a.ws + WS_CTL) + CW_CNT + (dummy ? 64 : 0); int* list = (int*)(a.ws + (dummy ? WS_DUMMY : WS_LIST));
    int* TE = (int*)(a.ws + (dummy ? WS_DUMMY + 8 * MiB : WS_TE)); int* TP = (int*)(a.ws + (dummy ? WS_DUMMY + 9 * MiB : WS_TP)); float* TG = (float*)(a.ws + (dummy ? WS_DUMMY + 10 * MiB : WS_TG));
    LAS unsigned char* L = F.lds;
    LAS float* part = (LAS float*)(L + R_PART); LAS float* rsl = (LAS float*)(L + R_RSTD); LAS unsigned* hist = (LAS unsigned*)(L + R_HIST); LAS unsigned* gb = (LAS unsigned*)(L + R_BASE);
    const int wave = F.wave;
    bf16x8 whi[8], wlo[8];
    { const int lane = F.lane; const float* wrp = WR + (size_t)(128 * wave + 8 * (lane >> 5)) * NE + (lane & 31);
#pragma unroll
      for (int s8 = 0; s8 < 8; ++s8) { float w8[8];
#pragma unroll
          for (int e = 0; e < 8; ++e) w8[e] = wrp[(16 * s8 + e) * NE];
          split_bf16x8(w8, whi[s8], wlo[s8]); } }
    for (int chunk = F.bx; chunk < NTOK / 128; chunk += F.G) {
        const int tid = tid_of(wave), lane = tid & 63;
        const int rowbase = chunk * 128;
        __syncthreads();
        if (tid < 32) hist[tid] = 0u;
        f32x4 v[4][4]; u32x2 mo[4][4], xn[4][4]; float irs[4];
#define P4_LOADROWS(t_) do { _Pragma("unroll") for (int r = 0; r < 4; ++r) { const size_t row_ = (size_t)(rowbase + 32 * (t_) + wave * 4 + r); \
            const u32x2* xr_ = (const u32x2*)(XNp + row_ * DM) + lane; const u32x2* mr_ = (const u32x2*)(MO + row_ * DM) + lane; irs[r] = RSXI[row_]; \
            _Pragma("unroll") for (int j = 0; j < 4; ++j) { xn[r][j] = xr_[64 * j]; mo[r][j] = mr_[64 * j]; } } } while (0)
        P4_LOADROWS(0);
#pragma unroll 1
        for (int t = 0; t < 4; ++t) {
            f32x4 gfn[4];
#pragma unroll
            for (int j = 0; j < 4; ++j) gfn[j] = *(const f32x4*)(a.g_ffn + 256 * j + 4 * lane);
#pragma unroll
            for (int r = 0; r < 4; ++r) {
                const int rl = 32 * t + wave * 4 + r; float s2 = 0.f;
                u32x2* xb = (u32x2*)(X1B + (size_t)(rowbase + rl) * DM) + lane;
#pragma unroll
                for (int j = 0; j < 4; ++j) {
                    v[r][j].x = __uint_as_float(xn[r][j].x << 16) * irs[r] + __uint_as_float(mo[r][j].x << 16); v[r][j].y = __uint_as_float(xn[r][j].x & 0xffff0000u) * irs[r] + __uint_as_float(mo[r][j].x & 0xffff0000u);
                    v[r][j].z = __uint_as_float(xn[r][j].y << 16) * irs[r] + __uint_as_float(mo[r][j].y << 16); v[r][j].w = __uint_as_float(xn[r][j].y & 0xffff0000u) * irs[r] + __uint_as_float(mo[r][j].y & 0xffff0000u);
                    u32x2 w; w.x = cvtpk(v[r][j].x, v[r][j].y); w.y = cvtpk(v[r][j].z, v[r][j].w); __builtin_nontemporal_store(w, xb + 64 * j);
                    s2 += (v[r][j].x * v[r][j].x + v[r][j].y * v[r][j].y) + (v[r][j].z * v[r][j].z + v[r][j].w * v[r][j].w); }
                const float rstd = rsqrtf(wave_sum(s2) * (1.f / DM) + EPS);
#if MOE_FP8
                unsigned* o4 = (unsigned*)((unsigned char*)H2 + (size_t)(rowbase + rl) * DM) + lane;
#pragma unroll
                for (int j = 0; j < 4; ++j) { const f32x4 gq = gfn[j] * rstd;
                    o4[64 * j] = pg8::pack4_fp8(v[r][j].x * gq.x, v[r][j].y * gq.y, v[r][j].z * gq.z, v[r][j].w * gq.w); }
#else
                u32x2* o8 = (u32x2*)(H2 + (size_t)(rowbase + rl) * DM) + lane;
#pragma unroll
                for (int j = 0; j < 4; ++j) { u32x2 w; w.x = cvtpk(v[r][j].x * rstd, v[r][j].y * rstd); w.y = cvtpk(v[r][j].z * rstd, v[r][j].w * rstd); o8[64 * j] = w; }
#endif
                if (lane == 0) rsl[rl] = rstd;
            }
            __syncthreads();
#pragma unroll
            for (int r = 0; r < 4; ++r)
#pragma unroll
                for (int j = 0; j < 4; ++j) *(LAS f32x4*)(L + R_XT + (wave * 4 + r) * R_PITCH + (256 * j + 4 * lane) * 4) = v[r][j];
            __syncthreads();
            if (t < 3) P4_LOADROWS(t + 1);
            {
                const int i = lane & 31, h = lane >> 5;
                const LAS unsigned char* xp = L + R_XT + i * R_PITCH + (128 * wave + 8 * h) * 4;
                f32x16 acc;
#pragma unroll
                for (int r = 0; r < 16; ++r) acc[r] = 0.f;
#pragma unroll
                for (int s8 = 0; s8 < 8; ++s8) {
                    const f32x4 xa = *(const LAS f32x4*)(xp + s8 * 64), xb = *(const LAS f32x4*)(xp + s8 * 64 + 16);
                    const float a8[8] = {xa.x, xa.y, xa.z, xa.w, xb.x, xb.y, xb.z, xb.w};
                    bf16x8 ah, al; split_bf16x8(a8, ah, al);
                    acc = __builtin_amdgcn_mfma_f32_32x32x16_bf16(ah, whi[s8], acc, 0, 0, 0);
                    acc = __builtin_amdgcn_mfma_f32_32x32x16_bf16(ah, wlo[s8], acc, 0, 0, 0);
                    acc = __builtin_amdgcn_mfma_f32_32x32x16_bf16(al, whi[s8], acc, 0, 0, 0);
                }
                __syncthreads();
                LAS float* slot = (LAS float*)(L + R_XT) + wave * (32 * 33);
#pragma unroll
                for (int r = 0; r < 16; ++r) slot[crow(r, h) * 33 + (lane & 31)] = acc[r];
                __syncthreads();
#pragma unroll
                for (int q = 0; q < 2; ++q) { const int idx = tid + 512 * q, row = idx >> 5, ex = idx & 31; float sum = 0.f;
#pragma unroll
                    for (int w8 = 0; w8 < 8; ++w8) sum += ((const LAS float*)(L + R_XT))[w8 * (32 * 33) + row * 33 + ex];
                    part[(32 * t + row) * 33 + ex] = sum; }
            }
        }
#undef P4_LOADROWS
        __syncthreads();
        int ek[4] = {0, 0, 0, 0}; unsigned lp[4] = {0u, 0u, 0u, 0u}; float gk[4] = {0.f, 0.f, 0.f, 0.f};
        if (tid < 128) {
            float lg[32]; const float rstd = rsl[tid];
#pragma unroll
            for (int e = 0; e < 32; ++e) lg[e] = part[tid * 33 + e] * rstd + a.b_router[e];
            unsigned used = 0u; float val[4];
#pragma unroll
            for (int k = 0; k < 4; ++k) { float best = -INFINITY; int bi = 0;
#pragma unroll
                for (int j = 0; j < 32; ++j) { const bool take = !((used >> j) & 1u) && lg[j] > best; best = take ? lg[j] : best; bi = take ? j : bi; }
                used |= 1u << bi; ek[k] = bi; val[k] = best; }
            float es[4], sum = 0.f;
#pragma unroll
            for (int k = 0; k < 4; ++k) { es[k] = __expf(val[k] - val[0]); sum += es[k]; }
            const float inv = 1.f / sum;
#pragma unroll
            for (int k = 0; k < 4; ++k) { gk[k] = es[k] * inv; lp[k] = atomicAdd((unsigned*)&hist[ek[k]], 1u); }
        }
        __syncthreads();
        if (tid < 32) { const unsigned n = hist[tid]; gb[tid] = n ? atomicAdd(&gcnt[tid], n) : 0u; }
        __syncthreads();
        if (tid < 128) {
            const int tok = rowbase + tid;
#pragma unroll
            for (int k = 0; k < 4; ++k) { const unsigned pos = gb[ek[k]] + lp[k]; list[(size_t)ek[k] * NTOK + pos] = tok; TE[tok * 4 + k] = ek[k]; TP[tok * 4 + k] = (int)pos; TG[tok * 4 + k] = gk[k]; }
        }
    }
    __syncthreads();
}

__device__ __forceinline__ int moe_tables(const Frame& F, const MkArgs& a) {
    LAS int* cnt = (LAS int*)(F.lds + CNT_OFF); LAS int* ts = (LAS int*)(F.lds + TSTART_OFF); LAS int* te = (LAS int*)(F.lds + TILEE_OFF);
    const unsigned* gcnt = (const unsigned*)(a.ws + WS_CTL) + CW_CNT;
    __syncthreads();
    if (F.tid < 32) cnt[F.tid] = (int)__hip_atomic_load(gcnt + F.tid, RLX_AGENT);
    __syncthreads();
    if (F.tid == 0) { int s = 0; for (int e = 0; e < NE; ++e) { ts[e] = s; s += (cnt[e] + 255) >> 8; } ts[32] = s; }
    __syncthreads();
    const int total = ts[32];
    for (int t = F.tid; t < total && t < MAXTILES; t += NTHREADS) { int e = 0;
#pragma unroll 1
        for (int q = 1; q < NE; ++q) e += (ts[q] <= t) ? 1 : 0;
        te[t] = e; }
    __syncthreads();
    return total < MAXTILES ? total : MAXTILES;
}

__device__ __forceinline__ void p7_combine(const Frame& F, const MkArgs& a, bool dummy) {
    float* const dst = dummy ? (float*)(a.ws + WS_DUMMY) : a.out;
    const bf16_t* Y = (const bf16_t*)(a.ws + WS_Y); const int* TE = (const int*)(a.ws + WS_TE); const int* TP = (const int*)(a.ws + WS_TP); const float* TG = (const float*)(a.ws + WS_TG);
    LAS int* ts = (LAS int*)(F.lds + TSTART_OFF);
    const int gw = F.bx * NWAVES + F.wave, NGW = F.G * NWAVES, lane = F.lane, l7 = lane & 7;
    f32x4 gf[2][2];
#pragma unroll
    for (int j = 0; j < 2; ++j) { gf[j][0] = *(const f32x4*)(a.g_final + 512 * j + 8 * lane); gf[j][1] = *(const f32x4*)(a.g_final + 512 * j + 8 * lane + 4); }
    int t0 = 2 * gw;
    int e_c = 0, p_c = 0; float g_c = 0.f;
    if (t0 < NTOK) { e_c = TE[t0 * 4 + l7]; p_c = TP[t0 * 4 + l7]; g_c = TG[t0 * 4 + l7]; }
    for (; t0 < NTOK; t0 += 2 * NGW) {
        const int slot_l = 256 * ts[e_c & 31] + p_c; const float g_l = g_c;
        const int tn = t0 + 2 * NGW;
        if (tn < NTOK) { e_c = TE[tn * 4 + l7]; p_c = TP[tn * 4 + l7]; g_c = TG[tn * 4 + l7]; }
#if MOE_FP8
        f32x4 v[2][2][2]; u32x2 y[2][4][2]; float gk[2][4];
#else
        f32x4 v[2][2][2]; u32x4 y[2][4][2]; float gk[2][4];
#endif
#pragma unroll
        for (int tt = 0; tt < 2; ++tt) {
            const bf16_t* xr = (const bf16_t*)(a.ws + WS_X1B) + (size_t)(t0 + tt) * DM + 8 * lane;
#pragma unroll
            for (int j = 0; j < 2; ++j) { const u32x4 xb = *(const u32x4*)(xr + 512 * j);
                v[tt][j][0] = (f32x4){__uint_as_float(xb.x << 16), __uint_as_float(xb.x & 0xffff0000u), __uint_as_float(xb.y << 16), __uint_as_float(xb.y & 0xffff0000u)};
                v[tt][j][1] = (f32x4){__uint_as_float(xb.z << 16), __uint_as_float(xb.z & 0xffff0000u), __uint_as_float(xb.w << 16), __uint_as_float(xb.w & 0xffff0000u)}; }
#pragma unroll
            for (int k = 0; k < 4; ++k) {
                const int slot = __builtin_amdgcn_readlane(slot_l, tt * 4 + k);
                gk[tt][k] = __uint_as_float(__builtin_amdgcn_readlane(__float_as_uint(g_l), tt * 4 + k));
#if MOE_FP8
                const unsigned char* yr = (const unsigned char*)Y + (size_t)slot * DM + 8 * lane;
                y[tt][k][0] = *(const u32x2*)(yr); y[tt][k][1] = *(const u32x2*)(yr + 512);
#else
                const bf16_t* yr = Y + (size_t)slot * DM + 8 * lane;
                y[tt][k][0] = *(const u32x4*)(yr); y[tt][k][1] = *(const u32x4*)(yr + 512);
#endif
            }
        }
#pragma unroll
        for (int tt = 0; tt < 2; ++tt) {
#pragma unroll
            for (int k = 0; k < 4; ++k) { const float g = gk[tt][k];
#pragma unroll
#if MOE_FP8
                for (int j = 0; j < 2; ++j) { const u32x2 yy = y[tt][k][j];
                    const f32x2 a0 = __builtin_amdgcn_cvt_pk_f32_fp8((int)yy.x, false), a1 = __builtin_amdgcn_cvt_pk_f32_fp8((int)yy.x, true), a2 = __builtin_amdgcn_cvt_pk_f32_fp8((int)yy.y, false), a3 = __builtin_amdgcn_cvt_pk_f32_fp8((int)yy.y, true);
                    v[tt][j][0].x += g * a0.x; v[tt][j][0].y += g * a0.y; v[tt][j][0].z += g * a1.x; v[tt][j][0].w += g * a1.y;
                    v[tt][j][1].x += g * a2.x; v[tt][j][1].y += g * a2.y; v[tt][j][1].z += g * a3.x; v[tt][j][1].w += g * a3.y; } }
#else
                for (int j = 0; j < 2; ++j) { const u32x4 yy = y[tt][k][j];
                    v[tt][j][0].x += g * __uint_as_float(yy.x << 16); v[tt][j][0].y += g * __uint_as_float(yy.x & 0xffff0000u); v[tt][j][0].z += g * __uint_as_float(yy.y << 16); v[tt][j][0].w += g * __uint_as_float(yy.y & 0xffff0000u);
                    v[tt][j][1].x += g * __uint_as_float(yy.z << 16); v[tt][j][1].y += g * __uint_as_float(yy.z & 0xffff0000u); v[tt][j][1].z += g * __uint_as_float(yy.w << 16); v[tt][j][1].w += g * __uint_as_float(yy.w & 0xffff0000u); } }
#endif
            float s2 = 0.f;
#pragma unroll
            for (int j = 0; j < 2; ++j)
#pragma unroll
                for (int q = 0; q < 2; ++q) s2 += (v[tt][j][q].x * v[tt][j][q].x + v[tt][j][q].y * v[tt][j][q].y) + (v[tt][j][q].z * v[tt][j][q].z + v[tt][j][q].w * v[tt][j][q].w);
            const float rstd = rsqrtf(wave_sum(s2) * (1.f / DM) + EPS);
            float* xr = dst + (size_t)(t0 + tt) * DM + 8 * lane;
#pragma unroll
            for (int j = 0; j < 2; ++j)
#pragma unroll
                for (int q = 0; q < 2; ++q) *(f32x4*)(xr + 512 * j + 4 * q) = v[tt][j][q] * rstd * gf[j][q];
        }
    }
}

__global__ void __launch_bounds__(NTHREADS, 2) mk_fwd(MkArgs args) {
    extern __shared__ __attribute__((aligned(16))) unsigned char lds_raw[];
    Frame F;
    F.lds = (LAS unsigned char*)lds_raw;
    F.tid = threadIdx.x; F.lane = F.tid & 63; F.wave = __builtin_amdgcn_readfirstlane(F.tid >> 6); F.G = gridDim.x; F.bx = blockIdx.x;
    volatile LAS unsigned* MISC = (volatile LAS unsigned*)(F.lds + MISC_OFF);
    if (F.tid < 32) MISC[F.tid] = 0u;
    __syncthreads();
    const int lo = args.ph_lo, hi = args.ph_hi;
    unsigned* ctl = (unsigned*)(args.ws + WS_CTL);
    XcdBarrier bar; bar.bar = ctl + CW_BAR; bar.x = 0; bar.st = nullptr; bar.wave = F.wave;
    if (hi - lo > 1) bar = xcd_barrier_post(ctl + CW_BAR, MISC + 8, F.wave);
#ifndef PHASE_SEL
#define PHASE_SEL 0xFF
#endif
#define IN(k) (((PHASE_SEL >> (k)) & 1) && lo <= (k) && (k) < hi)
#define SEAM(k) do { if (IN(k) && IN((k) + 1)) xcd_barrier(bar); F.tid = tid_of(F.wave); F.lane = F.tid & 63; } while (0)
#ifndef REP_MASK
#define REP_MASK 0
#endif
#define REPS(k) for (int rep_ = 0; rep_ < (((REP_MASK >> (k)) & 1) ? 2 : 1); ++rep_)
    unsigned char* ws = args.ws;
    F.tid = tid_of(F.wave); F.lane = F.tid & 63;
    constexpr int P0_SMALL = (DM / 64) * (INC / 64) + (DM / 64) * (DM / 64);
    const bool split = (F.G == 256) && SPLIT_CONV;
    const int p0_hi = split ? P0_SMALL + CONV_IN_P0 : 0x7fffffff;
    if (IN(0)) REPS(0) { p0_prologue(F, args, 0, p0_hi, F.bx * NWAVES + F.wave, F.G * NWAVES, true); }
    SEAM(0);
    if (IN(1)) REPS(1) {
#if PAD1 > 0
        asm volatile("s_branch 1f\n\t.fill %0, 4, 0xbf800000\n1:" :: "n"(PAD1));
#endif
        const int grp = F.bx >> 3;
        if (split && (grp & 3) == 3) {
            const int rank = (grp >> 2) * 8 + (F.bx & 7);
            p0_prologue(F, args, p0_hi, 0x7fffffff, rank * NWAVES + F.wave, 64 * NWAVES, false);
        } else {
            const int Gg = split ? 192 : F.G, cg = split ? (grp - (grp >> 2)) * 8 + (F.bx & 7) : F.bx;
            pg8::ProbDense S{(const bf16_t*)(ws + WS_XN), (const bf16_t*)(ws + WS_WIN), NTOK / 256, INC / 256, Gg, cg, ws + WS_DUMMY};
            pg8::EpiP E{(bf16_t*)(ws + WS_P)};
            pg8::gemm_phase<pg8::ProbDense, pg8::EpiP, true>(F.lds + RING_OFF, S, E, F.wave);
        }
    }
    SEAM(1);
    if (IN(2)) REPS(2) { p2_attn_conv(F, args); }
    SEAM(2);
    if (IN(3)) REPS(3) {
#if PAD3 > 0
        asm volatile("s_branch 3f\n\t.fill %0, 4, 0xbf800000\n3:" :: "n"(PAD3));
#endif
        pg8::ProbDense S{(const bf16_t*)(ws + WS_MIX), (const bf16_t*)(ws + WS_WOUT), NTOK / 256, DM / 256, F.G, F.bx, ws + WS_DUMMY};
        pg8::EpiMo E{(bf16_t*)(ws + WS_MO), (const float*)(ws + WS_RSA)};
        pg8::gemm_phase<pg8::ProbDense, pg8::EpiMo, true>(F.lds + RING_OFF, S, E, F.wave);
    }
    SEAM(3);
    if (IN(4)) REPS(4) { p4_router(F, args, ((REP_MASK >> 4) & 1) && rep_ == 0); }
    SEAM(4);
    int nM_keep = -1;
    if (IN(5)) REPS(5) {
#if PAD5 > 0
        asm volatile("s_branch 5f\n\t.fill %0, 4, 0xbf800000\n5:" :: "n"(PAD5));
#endif
        const int nM = moe_tables(F, args); nM_keep = nM;
        LAS int* te = (LAS int*)(F.lds + TILEE_OFF); LAS int* ts = (LAS int*)(F.lds + TSTART_OFF); LAS int* cnt = (LAS int*)(F.lds + CNT_OFF); LAS unsigned* idtab = (LAS unsigned*)(F.lds + IDTAB_OFF);
        pg8::ProbG1<MOE_FP8 != 0> S{(const unsigned char*)(ws + WS_H2), (const unsigned char*)(ws + WS_W1), nM, F.G, F.bx, te, idtab, ws + WS_DUMMY};
        const int* list = (const int*)(ws + WS_LIST);
        pg8::Unit u;
        if (F.tid < 256) {
            int tokv[IDTAB_UNITS];
#pragma unroll
            for (int i = 0; i < IDTAB_UNITS; ++i) { tokv[i] = 0;
                if (S.next(i, u)) { const int rie = (u.pm - ts[u.e]) * 256 + F.tid; if (rie < cnt[u.e]) tokv[i] = list[(size_t)u.e * NTOK + rie]; } }
#pragma unroll
            for (int i = 0; i < IDTAB_UNITS; ++i) idtab[i * 256 + F.tid] = (unsigned)tokv[i] * (unsigned)(pg8::ProbG1<MOE_FP8 != 0>::KB);
        }
        __syncthreads();
        phase_stagger(F, nM * 8, STG5);
#if MOE_FP8
        pg8::EpiAct8 E{(unsigned char*)(ws + WS_ACT), args.b1, (const LAS float*)(F.lds + BIAS_OFF)};
        pg8::gemm_phase<pg8::ProbG1<true>, pg8::EpiAct8, true>(F.lds + RING_OFF, S, E, F.wave);
#else
        pg8::EpiAct E{(bf16_t*)(ws + WS_ACT), args.b1};
        pg8::gemm_phase<pg8::ProbG1<false>, pg8::EpiAct, true>(F.lds + RING_OFF, S, E, F.wave);
#endif
    }
    SEAM(5);
    if (IN(6)) REPS(6) {
#if PAD6 > 0
        asm volatile("s_branch 6f\n\t.fill %0, 4, 0xbf800000\n6:" :: "n"(PAD6));
#endif
        const int nM = (nM_keep >= 0) ? nM_keep : moe_tables(F, args);
        LAS int* te = (LAS int*)(F.lds + TILEE_OFF);
        pg8::ProbG2<MOE_FP8 != 0> S{(const unsigned char*)(ws + WS_ACT), (const unsigned char*)(ws + WS_W2), nM, F.G, F.bx, te, ws + WS_DUMMY};
#if MOE_FP8
        pg8::EpiY8 E{(unsigned char*)(ws + WS_Y), args.b2, (const LAS float*)(F.lds + BIAS_OFF)};
        pg8::gemm_phase<pg8::ProbG2<true>, pg8::EpiY8, true>(F.lds + RING_OFF, S, E, F.wave);
#else
        pg8::EpiY E{(bf16_t*)(ws + WS_Y), args.b2, (const LAS float*)(F.lds + BIAS_OFF)};
        pg8::gemm_phase<pg8::ProbG2<false>, pg8::EpiY, true>(F.lds + RING_OFF, S, E, F.wave);
#endif
    }
    SEAM(6);
    if (IN(7)) REPS(7) { if (nM_keep < 0) (void)moe_tables(F, args); p7_combine(F, args, ((REP_MASK >> 7) & 1) && rep_ == 0); }
#undef IN
#undef SEAM
}

#ifndef MK_MASK
#define MK_MASK 0xFF
#endif
#ifndef MK_ONE
#define MK_ONE 1
#endif

extern "C" void kernel_launch(void* const* d_in, const int* in_sizes, int n_in, void* d_out, int out_size, void* d_ws, size_t ws_size, hipStream_t stream) {
    if (n_in != 16 || out_size != NTOK * DM || ws_size < WS_END) { fprintf(stderr, "kernel_launch: unexpected shapes (n_in %d out %d ws %zu)\n", n_in, out_size, ws_size); return; }
    const float* x = (const float*)d_in[0]; const float* g_mix = (const float*)d_in[1]; const float* w_in = (const float*)d_in[2]; const float* conv_w = (const float*)d_in[3];
    const float* sinks = (const float*)d_in[4]; const float* g_ao = (const float*)d_in[5]; const float* g_co = (const float*)d_in[6]; const float* w_out = (const float*)d_in[7];
    const float* g_ffn = (const float*)d_in[8]; const float* w_router = (const float*)d_in[9]; const float* b_router = (const float*)d_in[10]; const float* w1 = (const float*)d_in[11];
    const float* b1 = (const float*)d_in[12]; const float* w2 = (const float*)d_in[13]; const float* b2 = (const float*)d_in[14]; const float* g_final = (const float*)d_in[15];
    unsigned char* ws = (unsigned char*)d_ws; float* out = (float*)d_out;
    static int grid = 0;
    if (grid == 0) {
        int dev = 0, cus = 0, per_cu = 0;
        if (hipGetDevice(&dev) != hipSuccess || hipDeviceGetAttribute(&cus, hipDeviceAttributeMultiprocessorCount, dev) != hipSuccess) { fprintf(stderr, "kernel_launch: device query failed\n"); grid = -1; return; }
        if (hipFuncSetAttribute((const void*)mk_fwd, hipFuncAttributeMaxDynamicSharedMemorySize, LDS_BYTES) != hipSuccess) { fprintf(stderr, "kernel_launch: hipFuncSetAttribute failed\n"); grid = -1; return; }
        if (hipOccupancyMaxActiveBlocksPerMultiprocessor(&per_cu, (const void*)mk_fwd, NTHREADS, LDS_BYTES) != hipSuccess || per_cu < 1) { fprintf(stderr, "kernel_launch: occupancy query says %d blocks per CU\n", per_cu); per_cu = 1; }
        (void)hipGetLastError();
        grid = cus;
    }
    if (grid < 0) return;
    (void)hipMemsetAsync(ws + WS_CTL, 0, CTL_BYTES, stream);
    MkArgs a{};
    a.x = x; a.g_mix = g_mix; a.w_in = w_in; a.conv_w = conv_w; a.sinks = sinks; a.g_ao = g_ao; a.g_co = g_co; a.w_out = w_out; a.g_ffn = g_ffn; a.w_router = w_router; a.b_router = b_router;
    a.w1 = w1; a.b1 = b1; a.w2 = w2; a.b2 = b2; a.g_final = g_final; a.out = out; a.ws = ws;
#if MK_ONE
    a.ph_lo = 0; a.ph_hi = 8;
    hipLaunchKernelGGL(mk_fwd, dim3(grid), dim3(NTHREADS), LDS_BYTES, stream, a);
#else
    unsigned* ctl = (unsigned*)(ws + WS_CTL);
    bf16_t* Win_t = (bf16_t*)(ws + WS_WIN); bf16_t* Wout_t = (bf16_t*)(ws + WS_WOUT); float* WR = (float*)(ws + WS_WR); int* list = (int*)(ws + WS_LIST);
    int* TE = (int*)(ws + WS_TE); int* TP = (int*)(ws + WS_TP); float* TG = (float*)(ws + WS_TG); int* tab = (int*)(ws + WS_TAB); float* gcat = (float*)(ws + WS_TAB + 16384);
    bf16_t* W1_t = (bf16_t*)(ws + WS_W1); bf16_t* W2_t = (bf16_t*)(ws + WS_W2); bf16_t* XN = (bf16_t*)(ws + WS_XN); bf16_t* P = (bf16_t*)(ws + WS_P);
    bf16_t* MIX = (bf16_t*)(ws + WS_MIX); bf16_t* ACT = (bf16_t*)(ws + WS_ACT); bf16_t* Y = (bf16_t*)(ws + WS_Y); float* ATT = (float*)(ws + WS_ATT);
    for (int p = 0; p < 8; ++p) {
        if ((MK_MASK >> p) & 1) { a.ph_lo = p; a.ph_hi = p + 1; hipLaunchKernelGGL(mk_fwd, dim3(grid), dim3(NTHREADS), LDS_BYTES, stream, a); continue; }
        switch (p) {
        case 0:
            n_gcat<<<4, 256, 0, stream>>>(g_ao, g_co, gcat);
            n_transpose<<<dim3(DM / 32, INC / 32, 1), dim3(32, 8), 0, stream>>>(w_in, Win_t, DM, INC, g_mix);
            n_transpose<<<dim3(DM / 32, DM / 32, 1), dim3(32, 8), 0, stream>>>(w_out, Wout_t, DM, DM, gcat);
            n_transpose<<<dim3(DM / 32, 2048 / 32, NE), dim3(32, 8), 0, stream>>>(w1, W1_t, DM, 2048, g_ffn);
            n_transpose<<<dim3(DFF / 32, DM / 32, NE), dim3(32, 8), 0, stream>>>(w2, W2_t, DFF, DM, nullptr);
            n_wr<<<DM * NE / 256, 256, 0, stream>>>(w_router, g_ffn, WR);
            n_xn<<<NTOK, 256, 0, stream>>>(x, XN); break;
        case 1: { NG g{}; g.A = XN; g.Bt = Win_t; g.Ob = P; n_gemm<0><<<dim3(NTOK / 128, INC / 128), 256, 0, stream>>>(g); } break;
        case 2: n_attn<<<NTOK * NQH / 4, 256, 0, stream>>>(P, sinks, ATT); n_mix<<<NTOK, 256, 0, stream>>>(P, ATT, conv_w, MIX); break;
        case 3: { NG g{}; g.A = MIX; g.Bt = Wout_t; g.Of = out; g.X = x; n_gemm<1><<<dim3(NTOK / 128, DM / 128), 256, 0, stream>>>(g); } break;
        case 4: n_router<<<NTOK, 256, 0, stream>>>(out, WR, b_router, XN, ctl + CW_CNT, list, TE, TP, TG); break;
        case 5: n_tables<<<1, 64, 0, stream>>>(ctl + CW_CNT, tab);
            { NG g{}; g.A = XN; g.Bt = W1_t; g.Ob = ACT; g.bias = b1; g.list = list; g.cnt = ctl + CW_CNT; g.tab = tab; n_gemm<2><<<dim3(PADROWS / 128, DFF / 128), 256, 0, stream>>>(g); } break;
        case 6: n_tables<<<1, 64, 0, stream>>>(ctl + CW_CNT, tab);
            { NG g{}; g.A = ACT; g.Bt = W2_t; g.Ob = Y; g.bias = b2; g.list = list; g.cnt = ctl + CW_CNT; g.tab = tab; n_gemm<3><<<dim3(PADROWS / 128, DM / 128), 256, 0, stream>>>(g); } break;
        case 7: n_tables<<<1, 64, 0, stream>>>(ctl + CW_CNT, tab); n_combine<<<NTOK, 256, 0, stream>>>(out, Y, TE, TP, TG, tab, g_final, out); break;
        }
    }
#endif
}
```
